# Optimizing an MI355X kernel written in HIP

```python
import math
import jax
import jax.numpy as jnp
from jax import lax
import numpy as np

D_MODEL = 2048
BATCH = 1
SEQ = 8192
DEPTH = 4

CHUNK = 64
Q_BLOCK = 128
N_HEADS = 8
HEAD_DIM = 64
MIX_W = N_HEADS * HEAD_DIM
N_BRANCH = 4
D_FF = 256 * ((8 * D_MODEL // 3 + 255) // 256)
RWKV_W_LORA = 64
RWKV_A_LORA = 64
RWKV_G_LORA = 128
CONV_W = 4
ROPE_BASE = 10000.0
NORM_EPS = 1e-6
RWKV_GN_EPS = 64e-5
FGATE_BIAS_LO = 3.0
FGATE_BIAS_HI = 6.0

FOX_SIZES = (MIX_W, MIX_W, MIX_W, MIX_W, N_HEADS)
RWKV_SIZES = (MIX_W, MIX_W, MIX_W, RWKV_W_LORA, RWKV_A_LORA, RWKV_G_LORA)
RET_SIZES = (MIX_W, MIX_W, MIX_W, MIX_W)
MLSTM_SIZES = (2 * MIX_W, MIX_W, MIX_W, N_HEADS, N_HEADS)
FOX_W = sum(FOX_SIZES)
RWKV_W = sum(RWKV_SIZES)
RET_W = sum(RET_SIZES)
MLSTM_W = sum(MLSTM_SIZES)
D_IN = FOX_W + RWKV_W + RET_W + MLSTM_W

kernel_name = 'hybrid_chunk_causal_encoder_trunk'


def _split(z, sizes):
    outs, off = [], 0
    for s in sizes:
        outs.append(z[..., off:off + s])
        off += s
    return outs


def _rms(t, eps=NORM_EPS):
    tf = t.astype(jnp.float32)
    return tf * lax.rsqrt(jnp.mean(tf * tf, axis=-1, keepdims=True) + eps)


def rmsnorm(t, gain):
    return (_rms(t) * gain).astype(t.dtype)


def _head_rmsnorm(t, gain):
    b, s, _ = t.shape
    th = _rms(t.reshape(b, s, N_HEADS, HEAD_DIM))
    return (th.reshape(b, s, MIX_W) * gain).astype(t.dtype)


def _to_heads(t):
    b, s, _ = t.shape
    return t.reshape(b, s, N_HEADS, HEAD_DIM).transpose(0, 2, 1, 3)


def _from_heads(t):
    b, h, s, d = t.shape
    return t.transpose(0, 2, 1, 3).reshape(b, s, h * d)


def swiglu_half(x, gain, w1, w3, w2):
    h = rmsnorm(x, gain)
    return 0.5 * ((jax.nn.silu(h @ w1) * (h @ w3)) @ w2)


def rotary_tables(positions):
    inv_freq = ROPE_BASE ** (-jnp.arange(0, HEAD_DIM, 2, dtype=jnp.float32) / HEAD_DIM)
    ang = positions.astype(jnp.float32)[..., None] * inv_freq
    return jnp.cos(ang)[:, None], jnp.sin(ang)[:, None]


def apply_rotary(t, cos, sin):
    half = HEAD_DIM // 2
    t1, t2 = t[..., :half], t[..., half:]
    return jnp.concatenate([t1 * cos - t2 * sin, t1 * sin + t2 * cos], axis=-1).astype(t.dtype)


def causal_depthwise_conv(t, w, bias):
    c = t.shape[-1]
    out = lax.conv_general_dilated(t, w[:, None, :].astype(t.dtype), window_strides=(1,),
                                   padding=((CONV_W - 1, 0),),
                                   dimension_numbers=('NWC', 'WIO', 'NWC'),
                                   feature_group_count=c)
    return out + bias


def fox_attention(q, k, v, f_logit, q_gain, k_gain):
    b, h, s, d = q.shape
    nb = s // Q_BLOCK
    q = rmsnorm(q, q_gain) * (d ** -0.5)
    k = rmsnorm(k, k_gain)
    cum_f = jnp.cumsum(jax.nn.log_sigmoid(f_logit.astype(jnp.float32)), axis=1).transpose(0, 2, 1)
    q_blocks = q.reshape(b, h, nb, Q_BLOCK, d).transpose(2, 0, 1, 3, 4)
    f_blocks = cum_f.reshape(b, h, nb, Q_BLOCK).transpose(2, 0, 1, 3)
    k_pos = jnp.arange(s)

    def one_block(args):
        qb, fb, start = args
        logits = jnp.einsum('bhqd,bhkd->bhqk', qb, k).astype(jnp.float32)
        logits = logits + fb[..., :, None] - cum_f[..., None, :]
        q_pos = start + jnp.arange(Q_BLOCK)
        logits = jnp.where(k_pos[None, :] <= q_pos[:, None], logits, -jnp.inf)
        p = jax.nn.softmax(logits, axis=-1)
        return jnp.einsum('bhqk,bhkd->bhqd', p.astype(v.dtype), v)

    out = lax.map(one_block, (q_blocks, f_blocks, jnp.arange(nb, dtype=jnp.int32) * Q_BLOCK))
    return out.transpose(1, 2, 0, 3, 4).reshape(b, h, s, d)


def rwkv7_time_mix(r, k, v, w_lora, a_lora, g_lora, w0, w2, a0, a2, g2, k_k, k_a, r_k, gn_w, gn_b):
    f32 = jnp.float32
    b, s, _ = r.shape
    u = (w0 + jnp.tanh(w_lora) @ w2).astype(f32)
    decay = jnp.exp(-jnp.exp(-jax.nn.softplus(-u) - 0.5))
    a = jax.nn.sigmoid(a0 + a_lora @ a2)
    g = jax.nn.sigmoid(g_lora) @ g2

    def hd(t):
        return t.astype(f32).reshape(b, s, N_HEADS, HEAD_DIM)

    kk = hd(k * k_k)
    kk = kk * lax.rsqrt(jnp.maximum(jnp.sum(kk * kk, axis=-1, keepdims=True), 1e-12))
    k = k * (1.0 + (a - 1.0) * k_a)
    rh, kh, vh, ah, wh = hd(r), hd(k), hd(v), hd(a), hd(decay)

    def step(state, inp):
        r_t, w_t, k_t, v_t, kk_t, a_t = inp
        sa = jnp.einsum('bhvk,bhk->bhv', state, -kk_t)
        state = (state * w_t[:, :, None, :] + sa[..., :, None] * (kk_t * a_t)[:, :, None, :]
                 + v_t[..., :, None] * k_t[:, :, None, :])
        return state, jnp.einsum('bhvk,bhk->bhv', state, r_t)

    def tm(t):
        return t.transpose(1, 0, 2, 3)

    state0 = jnp.zeros((b, N_HEADS, HEAD_DIM, HEAD_DIM), f32)
    _, y = lax.scan(step, state0, (tm(rh), tm(wh), tm(kh), tm(vh), tm(kk), tm(ah)))
    y = tm(y)
    mu = jnp.mean(y, axis=-1, keepdims=True)
    var = jnp.mean(jnp.square(y - mu), axis=-1, keepdims=True)
    yn = ((y - mu) * lax.rsqrt(var + RWKV_GN_EPS)).reshape(b, s, MIX_W) * gn_w + gn_b
    bonus = jnp.sum(rh * kh * r_k, axis=-1, keepdims=True) * vh
    return ((yn + bonus.reshape(b, s, MIX_W)) * g).astype(r.dtype)


def retention(q, k, v):
    f32 = jnp.float32
    b, h, s, d = q.shape
    nc = s // CHUNK
    log_gamma = jnp.log1p(-jnp.exp2(-5.0 - jnp.arange(h, dtype=f32)))
    idx = jnp.arange(CHUNK, dtype=f32)
    intra = jnp.exp(log_gamma[:, None, None] * jnp.abs(idx[:, None] - idx[None, :]))
    q_decay = jnp.exp(log_gamma[:, None] * (idx + 1.0))
    k_decay = jnp.exp(log_gamma[:, None] * (CHUNK - 1.0 - idx))
    chunk_decay = jnp.exp(log_gamma * CHUNK)

    def chunks(t):
        return t.astype(f32).reshape(b, h, nc, CHUNK, d).transpose(2, 0, 1, 3, 4)

    def step(state, inp):
        qc, kc, vc = inp
        scores = jnp.einsum('bhid,bhjd->bhij', qc, kc) * intra
        out = (jnp.einsum('bhij,bhjv->bhiv', scores, vc)
               + jnp.einsum('bhid,bhdv->bhiv', qc * q_decay[:, :, None], state))
        state = state * chunk_decay[:, None, None] + jnp.einsum('bhjd,bhjv->bhdv', kc * k_decay[:, :, None], vc)
        return state, out

    state0 = jnp.zeros((b, h, d, d), f32)
    _, out = lax.scan(step, state0, (chunks(q), chunks(k), chunks(v)))
    return out.transpose(1, 2, 0, 3, 4).reshape(b, h, s, d)


def mlstm(q, k, v, i_logit, f_logit):
    f32 = jnp.float32
    b, h, s, d = q.shape
    nc = s // CHUNK

    def chunks(t):
        return t.astype(f32).reshape(b, h, nc, CHUNK, d).transpose(2, 0, 1, 3, 4)

    def gate_chunks(t):
        return t.astype(f32).transpose(0, 2, 1).reshape(b, h, nc, CHUNK).transpose(2, 0, 1, 3)

    log_f = gate_chunks(jax.nn.log_sigmoid(f_logit.astype(f32)))
    log_i = gate_chunks(i_logit)
    causal = jnp.tril(jnp.ones((CHUNK, CHUNK), dtype=bool))

    def step(carry, inp):
        c_mat, n_vec, m_prev = carry
        qc, kc, vc, lf, li = inp
        b_cum = jnp.cumsum(lf, axis=-1)
        log_d = jnp.where(causal, b_cum[..., :, None] - b_cum[..., None, :] + li[..., None, :], -jnp.inf)
        log_inter = b_cum + m_prev[..., None]
        m_t = jnp.maximum(log_inter, jnp.max(log_d, axis=-1))
        d_mat = jnp.exp(log_d - m_t[..., None])
        inter = jnp.exp(log_inter - m_t)
        scores = jnp.einsum('bhid,bhjd->bhij', qc, kc) * d_mat
        num = (jnp.einsum('bhij,bhjv->bhiv', scores, vc)
               + inter[..., None] * jnp.einsum('bhvk,bhik->bhiv', c_mat, qc))
        den = jnp.sum(scores, axis=-1) + inter * jnp.einsum('bhk,bhik->bhi', n_vec, qc)
        h_out = num / jnp.maximum(jnp.abs(den), jnp.exp(-m_t))[..., None]
        b_last = b_cum[..., -1]
        log_w = b_last[..., None] - b_cum + li
        m_new = jnp.maximum(b_last + m_prev, jnp.max(log_w, axis=-1))
        w = jnp.exp(log_w - m_new[..., None])
        dec = jnp.exp(b_last + m_prev - m_new)
        c_mat = dec[..., None, None] * c_mat + jnp.einsum('bhj,bhjv,bhjk->bhvk', w, vc, kc)
        n_vec = dec[..., None] * n_vec + jnp.einsum('bhj,bhjk->bhk', w, kc)
        return (c_mat, n_vec, m_new), h_out

    carry0 = (jnp.zeros((b, h, d, d), f32), jnp.zeros((b, h, d), f32), jnp.zeros((b, h), f32))
    _, out = lax.scan(step, carry0, (chunks(q), chunks(k), chunks(v), log_f, log_i))
    return out.transpose(1, 2, 0, 3, 4).reshape(b, h, s, d)


def hybrid_mixer(x, cos, sin, mix_norm, w_in, fox_f_bias, fox_q_gain, fox_k_gain,
                 rwkv_shift_mu, rwkv_w0, rwkv_w2, rwkv_a0, rwkv_a2, rwkv_g2, rwkv_k_k, rwkv_k_a,
                 rwkv_r_k, rwkv_gn_w, rwkv_gn_b, ret_gn_gain, mlstm_conv_w, mlstm_conv_b,
                 mlstm_i_bias, mlstm_f_bias, mlstm_gn_gain, w_merge_gate, merge_gate_bias,
                 w_branch, w_out):
    h = rmsnorm(x, mix_norm)
    z = h @ w_in
    z_fox, z_rwkv, z_ret, z_mlstm = _split(z, (FOX_W, RWKV_W, RET_W, MLSTM_W))

    fq, fk, fv, fo, ff = _split(z_fox, FOX_SIZES)
    y_fox = _from_heads(fox_attention(_to_heads(fq), _to_heads(fk), _to_heads(fv),
                                      ff + fox_f_bias, fox_q_gain, fox_k_gain))
    y_fox = y_fox * jax.nn.sigmoid(fo)

    z_prev = jnp.pad(z_rwkv, ((0, 0), (1, 0), (0, 0)))[:, :-1]
    z_rwkv = z_rwkv + rwkv_shift_mu * (z_prev - z_rwkv)
    rr, rk, rv, rwl, ral, rgl = _split(z_rwkv, RWKV_SIZES)
    y_rwkv = rwkv7_time_mix(rr, rk, rv, rwl, ral, rgl, rwkv_w0, rwkv_w2, rwkv_a0, rwkv_a2, rwkv_g2,
                            rwkv_k_k, rwkv_k_a, rwkv_r_k, rwkv_gn_w, rwkv_gn_b)

    tq, tk, tv, tg = _split(z_ret, RET_SIZES)
    y_ret = _from_heads(retention(apply_rotary(_to_heads(tq), cos, sin),
                                  apply_rotary(_to_heads(tk), cos, sin) * (HEAD_DIM ** -0.5),
                                  _to_heads(tv)))
    y_ret = _head_rmsnorm(y_ret, ret_gn_gain) * jax.nn.silu(tg)

    mqk, mv, mo, mi, mf = _split(z_mlstm, MLSTM_SIZES)
    mq, mk = _split(jax.nn.silu(causal_depthwise_conv(mqk, mlstm_conv_w, mlstm_conv_b)), (MIX_W, MIX_W))
    y_m = _from_heads(mlstm(_to_heads(mq), _to_heads(mk) * (HEAD_DIM ** -0.5), _to_heads(mv),
                            mi + mlstm_i_bias, mf + mlstm_f_bias))
    y_m = _head_rmsnorm(y_m * jax.nn.sigmoid(mo), mlstm_gn_gain)

    ys = jnp.stack([y_fox.astype(h.dtype), y_rwkv.astype(h.dtype), y_ret.astype(h.dtype),
                    y_m.astype(h.dtype)], axis=0)
    lifted = jnp.einsum('nbsc,ncd->nbsd', ys, w_branch)
    gates = jax.nn.sigmoid(jnp.einsum('bsd,dne->nbse', h, w_merge_gate) + merge_gate_bias[:, None, None, :])
    merged = jnp.sum(gates * lifted, axis=0)
    return (merged @ w_out).astype(x.dtype)


def setup_inputs(seed: int = 0) -> dict:
    key = jax.random.key(seed)
    ks = jax.random.split(key, 40)
    f32 = jnp.float32
    L, D, H, Dh, W = DEPTH, D_MODEL, N_HEADS, HEAD_DIM, MIX_W

    def nrm(i, shape, scale):
        return scale * jax.random.normal(ks[i], shape, f32)

    def gain(i, shape):
        return 1.0 + nrm(i, shape, 0.02)

    fbias = jnp.linspace(FGATE_BIAS_LO, FGATE_BIAS_HI, H, dtype=f32)
    return {
        'x': nrm(0, (BATCH, SEQ, D), 1.0),
        'positions': jnp.broadcast_to(jnp.arange(SEQ, dtype=jnp.int32), (BATCH, SEQ)),
        'ffn1_norm': gain(1, (L, D)),
        'ffn1_w1': nrm(2, (L, D, D_FF), D ** -0.5),
        'ffn1_w3': nrm(3, (L, D, D_FF), D ** -0.5),
        'ffn1_w2': nrm(4, (L, D_FF, D), D_FF ** -0.5),
        'mix_norm': gain(5, (L, D)),
        'w_in': nrm(6, (L, D, D_IN), D ** -0.5),
        'fox_f_bias': fbias + nrm(7, (L, H), 0.1),
        'fox_q_gain': gain(8, (L, Dh)),
        'fox_k_gain': gain(9, (L, Dh)),
        'rwkv_shift_mu': jax.random.uniform(ks[10], (L, RWKV_W), f32),
        'rwkv_w0': jax.random.uniform(ks[11], (L, W), f32, -6.5, -1.5),
        'rwkv_w2': nrm(12, (L, RWKV_W_LORA, W), 0.5 * RWKV_W_LORA ** -0.5),
        'rwkv_a0': nrm(13, (L, W), 0.1),
        'rwkv_a2': nrm(14, (L, RWKV_A_LORA, W), RWKV_A_LORA ** -0.5),
        'rwkv_g2': nrm(15, (L, RWKV_G_LORA, W), RWKV_G_LORA ** -0.5),
        'rwkv_k_k': 0.85 + nrm(16, (L, W), 0.05),
        'rwkv_k_a': 1.0 + nrm(17, (L, W), 0.05),
        'rwkv_r_k': nrm(18, (L, H, Dh), 0.1),
        'rwkv_gn_w': gain(19, (L, W)),
        'rwkv_gn_b': nrm(20, (L, W), 0.02),
        'ret_gn_gain': gain(21, (L, W)),
        'mlstm_conv_w': nrm(22, (L, CONV_W, 2 * W), CONV_W ** -0.5),
        'mlstm_conv_b': nrm(23, (L, 2 * W), 0.02),
        'mlstm_i_bias': nrm(24, (L, H), 0.1),
        'mlstm_f_bias': fbias + nrm(25, (L, H), 0.1),
        'mlstm_gn_gain': gain(26, (L, W)),
        'w_merge_gate': nrm(27, (L, D, N_BRANCH, D), D ** -0.5),
        'merge_gate_bias': nrm(28, (L, N_BRANCH, D), 0.1),
        'w_branch': nrm(29, (L, N_BRANCH, W, D), W ** -0.5),
        'w_out': nrm(30, (L, D, D), D ** -0.5),
        'ffn2_norm': gain(31, (L, D)),
        'ffn2_w1': nrm(32, (L, D, D_FF), D ** -0.5),
        'ffn2_w3': nrm(33, (L, D, D_FF), D ** -0.5),
        'ffn2_w2': nrm(34, (L, D_FF, D), D_FF ** -0.5),
    }


def reference(x, positions, ffn1_norm, ffn1_w1, ffn1_w3, ffn1_w2, mix_norm, w_in, fox_f_bias,
              fox_q_gain, fox_k_gain, rwkv_shift_mu, rwkv_w0, rwkv_w2, rwkv_a0, rwkv_a2, rwkv_g2,
              rwkv_k_k, rwkv_k_a, rwkv_r_k, rwkv_gn_w, rwkv_gn_b, ret_gn_gain, mlstm_conv_w,
              mlstm_conv_b, mlstm_i_bias, mlstm_f_bias, mlstm_gn_gain, w_merge_gate,
              merge_gate_bias, w_branch, w_out, ffn2_norm, ffn2_w1, ffn2_w3, ffn2_w2):
    cos, sin = rotary_tables(positions)
    for l in range(DEPTH):
        x = x + swiglu_half(x, ffn1_norm[l], ffn1_w1[l], ffn1_w3[l], ffn1_w2[l]).astype(x.dtype)
        x = x + hybrid_mixer(x, cos, sin, mix_norm[l], w_in[l], fox_f_bias[l], fox_q_gain[l],
                             fox_k_gain[l], rwkv_shift_mu[l], rwkv_w0[l], rwkv_w2[l], rwkv_a0[l],
                             rwkv_a2[l], rwkv_g2[l], rwkv_k_k[l], rwkv_k_a[l], rwkv_r_k[l],
                             rwkv_gn_w[l], rwkv_gn_b[l], ret_gn_gain[l], mlstm_conv_w[l],
                             mlstm_conv_b[l], mlstm_i_bias[l], mlstm_f_bias[l], mlstm_gn_gain[l],
                             w_merge_gate[l], merge_gate_bias[l], w_branch[l], w_out[l])
        x = x + swiglu_half(x, ffn2_norm[l], ffn2_w1[l], ffn2_w3[l], ffn2_w2[l]).astype(x.dtype)
    return x
```

```cpp
#include <hip/hip_runtime.h>
#include <hip/hip_bf16.h>
#include <cstdio>
#include <cstdint>
#include <cmath>
#ifndef DBG
#define DBG 0
#endif
#define DBG_LAYER 0
#define DBG_LAST_PHASE 10
#define DBG_RAWGATE 0
namespace pg8 {
#define PG8_LAS __attribute__((address_space(3)))
typedef unsigned short bf16_t;
typedef short bf16x8 __attribute__((ext_vector_type(8)));
typedef float f32x4 __attribute__((ext_vector_type(4)));
typedef unsigned u32x4 __attribute__((ext_vector_type(4)));
constexpr int BM = 256, BK = 64, HALF = 128, HTB = HALF * BK * 2  , STAGE_BYTES = 8 * HTB, NXCD = 8, WGM = 8;

__host__ __device__ __forceinline__ int lds_byte(int r, int c) { const int st = (r >> 4) * 2 + (c >> 5), rr = r & 15, cc = c & 31, ob = rr * 64 + cc * 2; return st * 1024 + (ob ^ (((ob >> 9) & 1) << 5)); }
__host__ __device__ __forceinline__ void stage_rc(int b, int& R, int& C) { const int st = b / 1024, sb = b % 1024, swz = sb ^ (((sb >> 9) & 1) << 5); R = (st >> 1) * 16 + swz / 64; C = (st & 1) * 32 + (swz % 64) / 2; }
__host__ __device__ __forceinline__ int perm32(int rho) { const int n = rho >> 4, i = rho & 15; return 8 * (i >> 2) + 4 * n + (i & 3); }

struct Unit { int pm, pn; };
struct Gemm { const bf16_t* A; const bf16_t* Bt; int M, N, K; };

struct StaticOrder {
    int nM, nN, nwg, G, c;
    __host__ __device__ void init(int M, int N, int G_, int c_) { nM = M / BM; nN = N / BM; nwg = nM * nN; G = G_; c = c_; }
    __host__ __device__ bool next(int i, Unit& u) const {
        const long L = (long)i * G + c; if (L >= nwg) return false;
        int wgid = (int)L; { const int q = nwg / NXCD, r = nwg % NXCD, xcd = wgid % NXCD, off = wgid / NXCD; wgid = (xcd < r ? xcd * (q + 1) : r * (q + 1) + (xcd - r) * q) + off; }
        const int nig = WGM * nN, gid = wgid / nig, fm = gid * WGM, gsz = (nM - fm) < WGM ? (nM - fm) : WGM;
        u.pm = fm + ((wgid % nig) % gsz); u.pn = (wgid % nig) / gsz; return true;
    }
    __device__ __forceinline__ void a_ready(const Unit&) const {}
    __device__ __forceinline__ void done(const Unit&) const {}
};

__device__ __forceinline__ unsigned cvt_pk_bf16(float lo, float hi) { typedef float f2_t __attribute__((ext_vector_type(2))); typedef __bf16 b2_t __attribute__((ext_vector_type(2))); const f2_t v = {lo, hi}; return __builtin_bit_cast(unsigned, __builtin_convertvector(v, b2_t)); }
typedef float f32x2 __attribute__((ext_vector_type(2)));
__device__ __forceinline__ float bf2f_lo(unsigned p) { return __builtin_bit_cast(float, p << 16); }
__device__ __forceinline__ float bf2f_hi(unsigned p) { return __builtin_bit_cast(float, p & 0xffff0000u); }
__device__ __forceinline__ float fast_sigmoid(float x) { return __builtin_amdgcn_rcpf(1.f + __builtin_amdgcn_exp2f(-1.4426950408889634f * x)); }
struct EpiSwiglu {
    static constexpr bool PERM = true, AFTER_DRAIN = false;
    bf16_t* O; int ldc;
    __device__ __forceinline__ void operator()(const f32x4 (&acc)[2][2][4][2], const Unit& u, int wr, int wc, int fr, int fq) const {
        const int row0 = u.pm * BM + wr * 64 + fr, col0 = u.pn * HALF + wc * 32 + 8 * fq;
#pragma unroll
        for (int ai = 0; ai < 2; ++ai)
#pragma unroll
            for (int m = 0; m < 4; ++m) { bf16_t* rowp = O + (size_t)(row0 + ai * HALF + m * 16) * ldc + col0;
                float h[8];
#pragma unroll
                for (int n = 0; n < 2; ++n)
#pragma unroll
                    for (int e = 0; e < 4; ++e) { const float g = acc[ai][0][m][n][e], b = acc[ai][1][m][n][e]; h[4 * n + e] = g * fast_sigmoid(g) * b; }
                u32x4 w; w.x = cvt_pk_bf16(h[0], h[1]); w.y = cvt_pk_bf16(h[2], h[3]); w.z = cvt_pk_bf16(h[4], h[5]); w.w = cvt_pk_bf16(h[6], h[7]);
                *(u32x4*)rowp = w; }
    }
};
struct EpiResid {
    static constexpr bool PERM = true, AFTER_DRAIN = false;
    const float* res; float* out; int ldc; float scale;
    __device__ __forceinline__ void operator()(const f32x4 (&acc)[2][2][4][2], const Unit& u, int wr, int wc, int fr, int fq) const {
        const int row0 = u.pm * BM + wr * 64 + fr, col0 = u.pn * BM + wc * 32 + 8 * fq;
#pragma unroll
        for (int ai = 0; ai < 2; ++ai)
#pragma unroll
            for (int m = 0; m < 4; ++m)
#pragma unroll
                for (int bj = 0; bj < 2; ++bj) { const size_t p = (size_t)(row0 + ai * HALF + m * 16) * ldc + col0 + bj * HALF;
                    const f32x4 r0 = *(const f32x4*)(res + p), r1 = *(const f32x4*)(res + p + 4);
                    *(f32x4*)(out + p) = r0 + acc[ai][bj][m][0] * scale; *(f32x4*)(out + p + 4) = r1 + acc[ai][bj][m][1] * scale; }
    }
};
template <int ACT> struct EpiStore {
    static constexpr bool PERM = true, AFTER_DRAIN = false;
    bf16_t* O; int ldc; const float* bias;
    __device__ __forceinline__ void operator()(const f32x4 (&acc)[2][2][4][2], const Unit& u, int wr, int wc, int fr, int fq) const {
        const int row0 = u.pm * BM + wr * 64 + fr, col0 = u.pn * BM + wc * 32 + 8 * fq;
        f32x4 bv[2][2];
#pragma unroll
        for (int bj = 0; bj < 2; ++bj)
#pragma unroll
            for (int n = 0; n < 2; ++n) bv[bj][n] = bias ? *(const f32x4*)(bias + col0 + bj * HALF + 4 * n) : (f32x4){0.f, 0.f, 0.f, 0.f};
#pragma unroll
        for (int ai = 0; ai < 2; ++ai)
#pragma unroll
            for (int m = 0; m < 4; ++m) { bf16_t* rowp = O + (size_t)(row0 + ai * HALF + m * 16) * ldc + col0;
#pragma unroll
                for (int bj = 0; bj < 2; ++bj) { f32x4 v0 = acc[ai][bj][m][0] + bv[bj][0], v1 = acc[ai][bj][m][1] + bv[bj][1];
                    if (ACT == 1) {
#pragma unroll
                        for (int e = 0; e < 4; ++e) { v0[e] = fast_sigmoid(v0[e]); v1[e] = fast_sigmoid(v1[e]); } }
                    u32x4 w; w.x = cvt_pk_bf16(v0[0], v0[1]); w.y = cvt_pk_bf16(v0[2], v0[3]); w.z = cvt_pk_bf16(v1[0], v1[1]); w.w = cvt_pk_bf16(v1[2], v1[3]);
                    *(u32x4*)(rowp + bj * HALF) = w; } }
    }
};
template <int MODE> struct EpiMerge {
    static constexpr bool PERM = true, AFTER_DRAIN = false;
    const bf16_t* G; int ldg; float* Mf; bf16_t* Mb; int ldc; float mul;
    __device__ __forceinline__ void operator()(const f32x4 (&acc)[2][2][4][2], const Unit& u, int wr, int wc, int fr, int fq) const {
        const int row0 = u.pm * BM + wr * 64 + fr, col0 = u.pn * BM + wc * 32 + 8 * fq;
#pragma unroll
        for (int ai = 0; ai < 2; ++ai)
#pragma unroll
            for (int m = 0; m < 4; ++m)
#pragma unroll
                for (int bj = 0; bj < 2; ++bj) { const int row = row0 + ai * HALF + m * 16, col = col0 + bj * HALF;
                    const u32x4 gz = *(const u32x4*)(G + (size_t)row * ldg + col);
                    f32x4 v0, v1;
                    v0[0] = bf2f_lo(gz.x) * acc[ai][bj][m][0][0]; v0[1] = bf2f_hi(gz.x) * acc[ai][bj][m][0][1]; v0[2] = bf2f_lo(gz.y) * acc[ai][bj][m][0][2]; v0[3] = bf2f_hi(gz.y) * acc[ai][bj][m][0][3];
                    v1[0] = bf2f_lo(gz.z) * acc[ai][bj][m][1][0]; v1[1] = bf2f_hi(gz.z) * acc[ai][bj][m][1][1]; v1[2] = bf2f_lo(gz.w) * acc[ai][bj][m][1][2]; v1[3] = bf2f_hi(gz.w) * acc[ai][bj][m][1][3];
                    v0 *= mul; v1 *= mul;
                    const size_t p = (size_t)row * ldc + col;
                    if (MODE >= 1) { v0 += *(const f32x4*)(Mf + p); v1 += *(const f32x4*)(Mf + p + 4); }
                    if (MODE <= 1) { *(f32x4*)(Mf + p) = v0; *(f32x4*)(Mf + p + 4) = v1; }
                    else { u32x4 w; w.x = cvt_pk_bf16(v0[0], v0[1]); w.y = cvt_pk_bf16(v0[2], v0[3]); w.z = cvt_pk_bf16(v1[0], v1[1]); w.w = cvt_pk_bf16(v1[2], v1[3]); *(u32x4*)(Mb + p) = w; } }
    }
};
template <class Epi, class Sched, bool ALIGN_EPI = false, bool SP2 = false>
__device__ __forceinline__ void gemm_phase(PG8_LAS unsigned char* lds, const Gemm g, const Sched& S, const Epi& E) {
    const int tid = threadIdx.x, wid = __builtin_amdgcn_readfirstlane(tid >> 6), lane = tid & 63, wr = wid >> 2, wc = wid & 3, fr = lane & 15, fq = lane >> 4;
    const int K = g.K, nt = K / BK;
    unsigned voffA[2], voffB[2];
#pragma unroll
    for (int i = 0; i < 2; ++i) { int R, C; stage_rc(tid * 16 + i * 8192, R, C); const int Rb = Epi::PERM ? ((R & ~31) + perm32(R & 31)) : R;
        voffA[i] = (unsigned)(R * K + C) * 2u; voffB[i] = (unsigned)(Rb * K + C) * 2u; }
    const size_t kstep = (size_t)(BK * 2);
    const size_t hstep = (size_t)HALF * K * 2;
    const size_t tstep = 2 * hstep;
    const unsigned ldsw = (unsigned)wid * 1024u;
    const int aoff = lds_byte(wr * 64 + fr, fq * 8), boff = lds_byte(wc * 32 + fr, fq * 8);
#define PG8_SA(b, h) (((b) * 2 + (h)) * HTB)
#define PG8_SB(b, h) ((4 + (b) * 2 + (h)) * HTB)
#define PG8_STAGE(bufoff, gbase, voff) do { _Pragma("unroll") for (int _i = 0; _i < 2; ++_i) \
        __builtin_amdgcn_global_load_lds((const unsigned*)((const char*)(gbase) + (voff)[_i]), (PG8_LAS unsigned*)(lds + (bufoff) + ldsw + _i * 8192), 16, 0, 0); } while (0)
#define PG8_LDA(dst, b, h) do { _Pragma("unroll") for (int m = 0; m < 4; ++m) _Pragma("unroll") for (int k = 0; k < 2; ++k) dst[m][k] = *(const PG8_LAS bf16x8*)(lds + PG8_SA(b, h) + aoff + m * 2048 + k * 1024); } while (0)
#define PG8_LDB(dst, b, h) do { _Pragma("unroll") for (int n = 0; n < 2; ++n) _Pragma("unroll") for (int k = 0; k < 2; ++k) dst[n][k] = *(const PG8_LAS bf16x8*)(lds + PG8_SB(b, h) + boff + n * 2048 + k * 1024); } while (0)
#define PG8_MMA(ai, bj, At, Bt) do { __builtin_amdgcn_s_setprio(1); _Pragma("unroll") for (int m = 0; m < 4; ++m) _Pragma("unroll") for (int n = 0; n < 2; ++n) _Pragma("unroll") for (int k = 0; k < 2; ++k) \
        acc[ai][bj][m][n] = __builtin_amdgcn_mfma_f32_16x16x32_bf16(Bt[n][k], At[m][k], acc[ai][bj][m][n], 0, 0, 0); __builtin_amdgcn_s_setprio(0); } while (0)
#define PG8_WAIT_V(n) asm volatile("s_waitcnt vmcnt(" #n ")" ::: "memory")
#define PG8_WAIT_L(n) asm volatile("s_waitcnt lgkmcnt(" #n ")" ::: "memory")
#define PG8_BAR __builtin_amdgcn_s_barrier()
#define PG8_SCHED __builtin_amdgcn_sched_barrier(0)
    Unit cur, nxt; int ui = 0;
    if (!S.next(0, cur)) return;
    f32x4 acc[2][2][4][2];
#pragma unroll
    for (int a = 0; a < 2; ++a)
#pragma unroll
        for (int b = 0; b < 2; ++b)
#pragma unroll
            for (int m = 0; m < 4; ++m)
#pragma unroll
                for (int n = 0; n < 2; ++n) acc[a][b][m][n] = (f32x4){0.f, 0.f, 0.f, 0.f};
    bf16x8 At[4][2], B0[2][2], B1[2][2];
    const char* cA = (const char*)g.A + (size_t)cur.pm * tstep; const char* cB = (const char*)g.Bt + (size_t)cur.pn * tstep;
    S.a_ready(cur);
    if constexpr (SP2) {
        PG8_STAGE(PG8_SB(0, 0), cB, voffB); PG8_STAGE(PG8_SB(0, 1), cB + hstep, voffB); PG8_STAGE(PG8_SA(0, 0), cA, voffA); PG8_STAGE(PG8_SA(0, 1), cA + hstep, voffA);
        if (wr == 1) PG8_BAR;
        PG8_WAIT_V(2); PG8_BAR;
        PG8_STAGE(PG8_SB(1, 0), cB + kstep, voffB); PG8_STAGE(PG8_SA(1, 0), cA + kstep, voffA); PG8_STAGE(PG8_SB(1, 1), cB + hstep + kstep, voffB);
        PG8_WAIT_V(6); PG8_BAR;
    } else {
        PG8_STAGE(PG8_SB(0, 0), cB, voffB); PG8_STAGE(PG8_SA(0, 0), cA, voffA); PG8_STAGE(PG8_SB(0, 1), cB + hstep, voffB); PG8_STAGE(PG8_SA(0, 1), cA + hstep, voffA);
        if (wr == 1) PG8_BAR;
        PG8_WAIT_V(4); PG8_BAR;
        PG8_STAGE(PG8_SB(1, 0), cB + kstep, voffB); PG8_STAGE(PG8_SA(1, 0), cA + kstep, voffA); PG8_STAGE(PG8_SB(1, 1), cB + hstep + kstep, voffB);
        PG8_WAIT_V(6); PG8_BAR;
    }
    for (;;) {
        const bool has_next = S.next(ui + 1, nxt);
        const char* nA = has_next ? (const char*)g.A + (size_t)nxt.pm * tstep : cA; const char* nB = has_next ? (const char*)g.Bt + (size_t)nxt.pn * tstep : cB;
        for (int t = 0; t < nt; t += 2) {
            const bool last = (t == nt - 2);
            const char* a1 = cA + (size_t)(t + 1) * kstep;
            const char* a2 = last ? nA : cA + (size_t)(t + 2) * kstep; const char* b2 = last ? nB : cB + (size_t)(t + 2) * kstep;
            const char* a3 = a2 + kstep; const char* b3 = b2 + kstep;
            if (last && has_next) S.a_ready(nxt);
            if constexpr (SP2) {
            PG8_LDB(B0, 0, 0); PG8_LDB(B1, 0, 1); PG8_SCHED; PG8_LDA(At, 0, 0); PG8_STAGE(PG8_SA(1, 1), a1 + hstep, voffA);
            PG8_WAIT_V(8); PG8_WAIT_L(0); PG8_BAR; PG8_MMA(0, 0, At, B0); PG8_MMA(0, 1, At, B1); PG8_BAR; PG8_SCHED;
            PG8_LDA(At, 0, 1); PG8_STAGE(PG8_SB(0, 0), b2, voffB); PG8_STAGE(PG8_SB(0, 1), b2 + hstep, voffB); PG8_STAGE(PG8_SA(0, 0), a2, voffA);
            PG8_WAIT_V(8); PG8_WAIT_L(0); PG8_BAR; PG8_MMA(1, 0, At, B0); PG8_MMA(1, 1, At, B1); PG8_BAR; PG8_SCHED;
            PG8_LDB(B0, 1, 0); PG8_LDB(B1, 1, 1); PG8_SCHED; PG8_LDA(At, 1, 0); PG8_STAGE(PG8_SA(0, 1), a2 + hstep, voffA);
            PG8_WAIT_V(8); PG8_WAIT_L(0); PG8_BAR; PG8_MMA(0, 0, At, B0); PG8_MMA(0, 1, At, B1); PG8_BAR; PG8_SCHED;
            PG8_LDA(At, 1, 1); PG8_STAGE(PG8_SB(1, 0), b3, voffB); PG8_STAGE(PG8_SB(1, 1), b3 + hstep, voffB); PG8_STAGE(PG8_SA(1, 0), a3, voffA);
            PG8_WAIT_V(8); PG8_WAIT_L(0); PG8_BAR; PG8_MMA(1, 0, At, B0); PG8_MMA(1, 1, At, B1); PG8_BAR; PG8_SCHED;
            } else {
            PG8_LDB(B0, 0, 0); PG8_SCHED; PG8_LDA(At, 0, 0); PG8_STAGE(PG8_SA(1, 1), a1 + hstep, voffA);
            PG8_WAIT_L(8); PG8_BAR; PG8_WAIT_L(0); PG8_MMA(0, 0, At, B0); PG8_BAR; PG8_SCHED;
            PG8_LDB(B1, 0, 1); PG8_STAGE(PG8_SB(0, 0), b2, voffB);
            PG8_BAR; PG8_WAIT_L(0); PG8_MMA(0, 1, At, B1); PG8_BAR;
            PG8_LDA(At, 0, 1); PG8_STAGE(PG8_SA(0, 0), a2, voffA);
            PG8_BAR; PG8_WAIT_L(0); PG8_MMA(1, 0, At, B0); PG8_BAR; PG8_SCHED;
            PG8_STAGE(PG8_SB(0, 1), b2 + hstep, voffB);
            PG8_WAIT_V(6); PG8_BAR; PG8_MMA(1, 1, At, B1); PG8_BAR;
            PG8_LDB(B0, 1, 0); PG8_SCHED; PG8_LDA(At, 1, 0); PG8_STAGE(PG8_SA(0, 1), a2 + hstep, voffA);
            PG8_WAIT_L(8); PG8_BAR; PG8_WAIT_L(0); PG8_MMA(0, 0, At, B0); PG8_BAR; PG8_SCHED;
            PG8_LDB(B1, 1, 1); PG8_STAGE(PG8_SB(1, 0), b3, voffB);
            PG8_BAR; PG8_WAIT_L(0); PG8_MMA(0, 1, At, B1); PG8_BAR;
            PG8_LDA(At, 1, 1); PG8_STAGE(PG8_SA(1, 0), a3, voffA);
            PG8_BAR; PG8_WAIT_L(0); PG8_MMA(1, 0, At, B0); PG8_BAR; PG8_SCHED;
            PG8_STAGE(PG8_SB(1, 1), b3 + hstep, voffB);
            PG8_WAIT_V(6); PG8_BAR; PG8_MMA(1, 1, At, B1); PG8_BAR;
            }
        }
        if constexpr (ALIGN_EPI) { if (wr == 0) PG8_BAR; }
        if constexpr (!Epi::AFTER_DRAIN) { E(acc, cur, wr, wc, fr, fq); S.done(cur); }
        if (!has_next) break;
#pragma unroll
        for (int a = 0; a < 2; ++a)
#pragma unroll
            for (int b = 0; b < 2; ++b)
#pragma unroll
                for (int m = 0; m < 4; ++m)
#pragma unroll
                    for (int n = 0; n < 2; ++n) acc[a][b][m][n] = (f32x4){0.f, 0.f, 0.f, 0.f};
        cur = nxt; cA = nA; cB = nB; ++ui;
        if constexpr (ALIGN_EPI) { if (wr == 1) PG8_BAR; }
    }
    PG8_WAIT_V(0);
    if constexpr (!ALIGN_EPI) { if (wr == 0) PG8_BAR; }
    PG8_BAR;
    if constexpr (Epi::AFTER_DRAIN) { E.fused(acc, cur, wr, wc, fr, fq, lds, wid, lane); S.done(cur); }
#undef PG8_SA
#undef PG8_SB
#undef PG8_STAGE
#undef PG8_LDA
#undef PG8_LDB
#undef PG8_MMA
#undef PG8_WAIT_V
#undef PG8_WAIT_L
#undef PG8_BAR
#undef PG8_SCHED
}
}
namespace attn_body {
using bf16=__hip_bfloat16;
using bf16x8=__attribute__((ext_vector_type(8)))short;
using s16x4=__attribute__((ext_vector_type(4)))short;
using f32x16=__attribute__((ext_vector_type(16)))float;
using u32x4=__attribute__((ext_vector_type(4)))unsigned;
constexpr int BATCH=1,NHEAD=8,SEQ=8192,D=64,DM=NHEAD*D,VP=8192;
constexpr int NW=8,QBLK=32,QB=QBLK*NW,KVBLK=64,NQB=SEQ/QB;
constexpr int ATTN_PITCH=DM, ATTN_UNIT_ROWS=QB;
__device__ __forceinline__ int crow(int r,int hi){return (r&3)+8*(r>>2)+4*hi;}
#define SBAR() __builtin_amdgcn_sched_barrier(0)
__device__ __forceinline__ void cmask(f32x16&p0,f32x16&p1,int jb,int qrel,int hi){
  const float NEG=-INFINITY; int kb=64*jb+4*hi;
  #pragma unroll
  for(int r=0;r<16;++r){int kv=kb+(r&3)+8*(r>>2); if(kv>qrel)p0[r]=NEG; if(kv+32>qrel)p1[r]=NEG;}
}

constexpr int NSLOT=3, SLOTB=8192;
constexpr int LDS_K=0, LDS_V=NSLOT*SLOTB, LDS_WS=2*NSLOT*SLOTB, LDS_OST=LDS_WS+NW*64*4, LDS_BYTES0=LDS_OST+NW*4096, LDS_BT=LDS_BYTES0, LDS_E=LDS_BT+32768, LDS_BYTES=LDS_E+512;
constexpr float C2=0.125f*1.4426950408889634f;
__device__ __forceinline__ void glds16(const void*gsrc,unsigned lds_dst){unsigned keep;
  asm volatile("s_mov_b32 %0, m0\n\ts_mov_b32 m0, %2\n\ts_nop 0\n\tglobal_load_lds_dwordx4 %1, off\n\ts_mov_b32 m0, %0":"=&s"(keep):"v"(gsrc),"s"(lds_dst):"memory");}
__device__ __forceinline__ float max3f(float a,float b,float c){float r;asm("v_max3_f32 %0, %1, %2, %3":"=v"(r):"v"(a),"v"(b),"v"(c));return r;}
__device__ __forceinline__ float max2f(float a,float b){float r;asm("v_max_f32_e32 %0, %1, %2":"=v"(r):"v"(a),"v"(b));return r;}
__device__ __forceinline__ float fadd_s(float a,float b){float r;asm("v_add_f32_e32 %0, %1, %2":"=v"(r):"v"(a),"v"(b));return r;}
__device__ __forceinline__ float fsub_s(float a,float b){float r;asm("v_sub_f32_e32 %0, %1, %2":"=v"(r):"v"(a),"v"(b));return r;}
typedef float f32x2_t __attribute__((ext_vector_type(2))); typedef __bf16 bf16x2_t __attribute__((ext_vector_type(2)));
__device__ __forceinline__ unsigned cvtpk_s(float lo,float hi){f32x2_t v={lo,hi};bf16x2_t b=__builtin_convertvector(v,bf16x2_t);return __builtin_bit_cast(unsigned,b);}
typedef float f32x4_t __attribute__((ext_vector_type(4)));
__device__ __forceinline__ float sigm(float x){return __builtin_amdgcn_rcpf(1.f+__builtin_amdgcn_exp2f(-1.4426950408889634f*x));}
#define WAIT_BAR(N) asm volatile("s_waitcnt vmcnt(" #N ") lgkmcnt(0)\n\ts_barrier":::"memory")

__device__ __forceinline__ void qkt(f32x16&p0,f32x16&p1,const char*Kslot,const bf16x8*qr,const f32x16&negm,int r32,int hi){
  const char*kb=Kslot+hi*1024+r32*16;
  #pragma unroll
  for(int d0=0;d0<4;++d0){
    const bf16x8 b0=*reinterpret_cast<const bf16x8*>(kb+d0*2048);
    const bf16x8 b1=*reinterpret_cast<const bf16x8*>(kb+d0*2048+512);
    if(d0==0){p0=__builtin_amdgcn_mfma_f32_32x32x16_bf16(b0,qr[0],negm,0,0,0);p1=__builtin_amdgcn_mfma_f32_32x32x16_bf16(b1,qr[0],negm,0,0,0);}
    else{p0=__builtin_amdgcn_mfma_f32_32x32x16_bf16(b0,qr[d0],p0,0,0,0);p1=__builtin_amdgcn_mfma_f32_32x32x16_bf16(b1,qr[d0],p1,0,0,0);}}
}
typedef __attribute__((address_space(3))) const char* lds_cptr;
typedef short v4i16_t __attribute__((ext_vector_type(4)));
__device__ __forceinline__ void kload8(bf16x8*kf,lds_cptr kp){
  kf[0]=*(const __attribute__((address_space(3))) bf16x8*)(kp);      kf[1]=*(const __attribute__((address_space(3))) bf16x8*)(kp+512);
  kf[2]=*(const __attribute__((address_space(3))) bf16x8*)(kp+2048); kf[3]=*(const __attribute__((address_space(3))) bf16x8*)(kp+2560);
  kf[4]=*(const __attribute__((address_space(3))) bf16x8*)(kp+4096); kf[5]=*(const __attribute__((address_space(3))) bf16x8*)(kp+4608);
  kf[6]=*(const __attribute__((address_space(3))) bf16x8*)(kp+6144); kf[7]=*(const __attribute__((address_space(3))) bf16x8*)(kp+6656);
}
__device__ __forceinline__ void kload2(bf16x8*kf,lds_cptr kp,int j){ kf[2*j]=*(const __attribute__((address_space(3))) bf16x8*)(kp+j*2048); kf[2*j+1]=*(const __attribute__((address_space(3))) bf16x8*)(kp+j*2048+512); }
__device__ __forceinline__ s16x4 vtr(lds_cptr p){ return __builtin_bit_cast(s16x4,__builtin_amdgcn_ds_read_tr16_b64_v4i16((__attribute__((address_space(3))) v4i16_t*)p)); }
__device__ __forceinline__ float rowmax(const f32x16&p0,const f32x16&p1){
  float a=max3f(p0[0],p0[1],p1[0]),b=max3f(p0[2],p0[3],p1[1]);a=max3f(a,p1[2],p1[3]);
  #pragma unroll
  for(int r=4;r<16;r+=4){a=max3f(a,p0[r],p0[r+1]);b=max3f(b,p0[r+2],p0[r+3]);a=max3f(a,p1[r],p1[r+1]);b=max3f(b,p1[r+2],p1[r+3]);}
  const float m=max2f(a,b);
  auto rr=__builtin_amdgcn_permlane32_swap(__float_as_uint(m),__float_as_uint(m),false,false);
  return max2f(__uint_as_float(rr[0]),__uint_as_float(rr[1]));
}
__device__ __forceinline__ void pv(f32x16*o,int vb,bf16x8 pa0,bf16x8 pa1,bf16x8 pa2,bf16x8 pa3){
  #pragma unroll
  for(int d0=0;d0<2;++d0){s16x4 lo[4],hi[4];
    #pragma unroll
    for(int ks=0;ks<4;++ks){
      asm volatile("ds_read_b64_tr_b16 %0,%1 offset:%c2":"=&v"(lo[ks]):"v"(vb),"i"(d0*4096+ks*1024):"memory");
      asm volatile("ds_read_b64_tr_b16 %0,%1 offset:%c2":"=&v"(hi[ks]):"v"(vb),"i"(d0*4096+ks*1024+512):"memory");}
    asm volatile("s_waitcnt lgkmcnt(0)":::"memory");SBAR();
    #define PK(k) (bf16x8){lo[k][0],lo[k][1],lo[k][2],lo[k][3],hi[k][0],hi[k][1],hi[k][2],hi[k][3]}
    o[d0]=__builtin_amdgcn_mfma_f32_32x32x16_bf16(pa0,PK(0),o[d0],0,0,0);
    o[d0]=__builtin_amdgcn_mfma_f32_32x32x16_bf16(pa1,PK(1),o[d0],0,0,0);
    o[d0]=__builtin_amdgcn_mfma_f32_32x32x16_bf16(pa2,PK(2),o[d0],0,0,0);
    o[d0]=__builtin_amdgcn_mfma_f32_32x32x16_bf16(pa3,PK(3),o[d0],0,0,0);
    #undef PK
  }
}

#ifndef ATTN_STORE16
#define ATTN_STORE16(p,v) (*(u32x4*)(p)=(v))
#endif
template<int THRL> __device__ __forceinline__ void attn_unit(int b,int h,int qb,const bf16*Q,const bf16*__restrict__ K,const bf16*__restrict__ V,bf16*O,const float*__restrict__ FP,const float*__restrict__ FT,const bf16*__restrict__ GZ,char*shm){
  int tid_=threadIdx.x; asm volatile("; OPAQUE_TID":"+v"(tid_)); const int tid=tid_,lane=tid&63,r32=lane&31,hi=lane>>5; const int wid=__builtin_amdgcn_readfirstlane(tid>>6);
  const long rowbase=(long)b*SEQ; const int q0=qb*QB;
  const bf16*Qw=Q+(rowbase+q0+wid*QBLK)*DM+h*D;
  const bf16*Kh=K+rowbase*DM+h*D,*Vh=V+rowbase*VP+h*D;
  const unsigned lds0=(unsigned)(uintptr_t)shm;
  float*wsf=(float*)(shm+LDS_WS)+wid*64;
  const bf16*ksrc=Kh+(long)lane*DM+wid*8;
  const bf16*vsrc=Vh+(long)(16*(wid&3)+(lane>>2))*VP+(wid>>2)*32+(lane&3)*8;
  const unsigned kdst=lds0+LDS_K+wid*1024, vdst=lds0+LDS_V+wid*1024;
  #define DMA_K(t,slot) glds16(ksrc+(long)(t)*KVBLK*DM,(unsigned)__builtin_amdgcn_readfirstlane(kdst+(slot)))
  #define DMA_V(t,slot) glds16(vsrc+(long)(t)*KVBLK*VP,(unsigned)__builtin_amdgcn_readfirstlane(vdst+(slot)))
  const int vb0=(int)(lds0+LDS_V)+((lane>>4)&1)*32+(lane&3)*8+(4*hi+((lane&15)>>2))*64;
  const char*Kbase=shm+LDS_K; bf16x8 kf[8];
  const lds_cptr shm3=(lds_cptr)shm; const lds_cptr kp0=shm3+LDS_K+hi*1024+r32*16; const lds_cptr vp0=shm3+LDS_V+((lane>>4)&1)*32+(lane&3)*8+(4*hi+((lane&15)>>2))*64;
  const int NT=(q0+QB)/KVBLK;
  { float*Ef=(float*)(shm+LDS_E); float*bt=(float*)(shm+LDS_BT);
    if(wid==0){ const float a0=(2*lane<NT)?FT[h*128+2*lane]:0.f, a1=(2*lane+1<NT)?FT[h*128+2*lane+1]:0.f; float sc=a0+a1;
      _Pragma("unroll") for(int o=1;o<64;o<<=1){ const float u=__shfl_up(sc,o); if(lane>=o)sc+=u; }
      const float ex=sc-(a0+a1); Ef[2*lane]=ex; Ef[2*lane+1]=ex+a0; }
    asm volatile("s_waitcnt lgkmcnt(0)\n\ts_barrier":::"memory");
    const float fref=Ef[q0>>6];
    for(int s=tid;s<q0+QB;s+=NW*64){ const float bv=(fref-(Ef[s>>6]+FP[h*SEQ+s]))*1.4426950408889634f; unsigned ub=__float_as_uint(bv); const unsigned hb=(ub+0x7fffu+((ub>>16)&1u))>>16;
      const float rr_=bv-__uint_as_float(hb<<16); unsigned ur=__float_as_uint(rr_); const unsigned lb=(ur+0x7fffu+((ur>>16)&1u))>>16; ((unsigned*)bt)[s]=hb|(lb<<16); }
    asm volatile("s_waitcnt vmcnt(0) lgkmcnt(0)\n\ts_barrier":::"memory"); }
  const __attribute__((address_space(3))) unsigned* bt3=(const __attribute__((address_space(3))) unsigned*)(shm3+LDS_BT)+r32;
  #define BIAS(P0,P1,t) do{ const unsigned w0_=bt3[64*(t)], w1_=bt3[64*(t)+32]; \
    const u32x4 a0_={hi?0u:w0_,0u,0u,0u}, a1_={hi?0u:w1_,0u,0u,0u}; const u32x4 one_={0x3F803F80u,0u,0u,0u}; \
    P0=__builtin_amdgcn_mfma_f32_32x32x16_bf16(__builtin_bit_cast(bf16x8,a0_),__builtin_bit_cast(bf16x8,one_),P0,0,0,0); \
    P1=__builtin_amdgcn_mfma_f32_32x32x16_bf16(__builtin_bit_cast(bf16x8,a1_),__builtin_bit_cast(bf16x8,one_),P1,0,0,0); }while(0)
  DMA_K(0,0);DMA_V(0,0);DMA_K(1,SLOTB);
  bf16x8 qr[4];
  #pragma unroll
  for(int d0=0;d0<4;++d0)qr[d0]=*reinterpret_cast<const bf16x8*>(&Qw[(long)r32*DM+d0*16+hi*8]);
  float mhat=0.f,l_reg=0.f;f32x16 o[2];o[0]=f32x16{};o[1]=f32x16{};f32x16 negm=f32x16{};asm volatile("":"+v"(negm));
  const int qrel=wid*QBLK+r32;
  #define CMASK(P0,P1,t) do{int jb_=(t)-(NT-4); if(jb_>=0)cmask(P0,P1,jb_,qrel,hi);}while(0)
  bool resc=false;
  #define START(P0,P1) do{ const float rm=rowmax(P0,P1); resc=false; \
    { const float dl=rm; mhat=fadd_s(mhat,dl); \
      _Pragma("unroll") for(int r=0;r<16;++r){P0[r]=fsub_s(P0[r],dl);P1[r]=fsub_s(P1[r],dl);} \
      _Pragma("unroll") for(int r=0;r<16;++r)negm[r]=-mhat; asm volatile("":"+v"(negm)); } \
    _Pragma("unroll") for(int r=0;r<16;++r)P0[r]=__builtin_amdgcn_exp2f(P0[r]); }while(0)
  #define RESC() do{ if(resc){ asm volatile("s_waitcnt lgkmcnt(0)":::"memory"); \
      _Pragma("unroll") for(int d_=0;d_<2;++d_) _Pragma("unroll") for(int r=0;r<16;++r)o[d_][r]*=wsf[crow(r,hi)]; } }while(0)
  f32x16 pA0,pA1,pB0,pB1;
  int sl_prev=0,sl_cur=0,sl_next=SLOTB;
  #define ROT() do{sl_prev=sl_cur;sl_cur=sl_next;sl_next=(sl_next==(NSLOT-1)*SLOTB)?0:sl_next+SLOTB;}while(0)
  DMA_K(2,2*SLOTB);
  WAIT_BAR(3);
  qkt(pA0,pA1,Kbase,qr,negm,r32,hi);BIAS(pA0,pA1,0);asm volatile("s_nop 15\n\ts_nop 7":"+v"(pA0),"+v"(pA1));CMASK(pA0,pA1,0);
  START(pA0,pA1);
  _Pragma("unroll") for(int r=0;r<16;++r)pA1[r]=__builtin_amdgcn_exp2f(pA1[r]);
  WAIT_BAR(0);
  DMA_K(3,0);DMA_V(1,SLOTB);
  ROT();
  kload8(kf,kp0+sl_cur);
  WAIT_BAR(2);
  s16x4 vlo[8],vhi[8]; u32x4 pw0,pw1,pw2,pw3;
  #define PKW(P,B) cvtpk_s(P[B],P[B+1])
  #define PAF(k) __builtin_bit_cast(bf16x8,pw##k)
  #define VFR(i) (bf16x8){vlo[i][0],vlo[i][1],vlo[i][2],vlo[i][3],vhi[i][0],vhi[i][1],vhi[i][2],vhi[i][3]}
  #define PIN(x) asm volatile("":"+v"(x))
  #define MX3(a,b,c) __builtin_fmaxf(__builtin_fmaxf((a),(b)),(c))
  #define GAPA(MF,A0,A1,A2,A3,W0,W1,PW) do{ MF; sacc+=A0; sacc+=A1; sacc+=A2; sacc+=A3; PIN(sacc); W0; W1; PIN(PW); SBAR(); }while(0)
  #define EX(v) __builtin_amdgcn_exp2f(v)
  #define GAPB(MF,X,B) do{ MF; X[B]=EX(X[B]); X[B+1]=EX(X[B+1]); X[B+2]=EX(X[B+2]); X[B+3]=EX(X[B+3]); PIN(X); SBAR(); }while(0)
  #define VRD(i) do{ vlo[i]=vtr(vp_+(((i)>>2)*4096+((i)&3)*1024)); vhi[i]=vtr(vp_+(((i)>>2)*4096+((i)&3)*1024+512)); }while(0)
  #define KRD(G,j) do{ if(G){ kload2(kf,kp0+sl_next,j); SBAR(); } }while(0)
  #define STEP(C0,C1,P0,P1,t,GK,GV,GL) do{ SBAR(); \
    const lds_cptr vp_=vp0+sl_prev; \
    VRD(0); SBAR(); float sacc=(P0[0]+P0[1]); \
    GAPA(C0=__builtin_amdgcn_mfma_f32_32x32x16_bf16(kf[0],qr[0],negm,0,0,0), P0[2],P0[3],P0[4],P0[5],     pw0[0]=PKW(P0,0), pw0[1]=PKW(P0,2), pw0); \
    VRD(4); SBAR(); GAPA(C1=__builtin_amdgcn_mfma_f32_32x32x16_bf16(kf[1],qr[0],negm,0,0,0), P0[6],P0[7],P0[8],P0[9],     pw0[2]=PKW(P0,4), pw0[3]=PKW(P0,6), pw0); \
    VRD(1); SBAR(); GAPA(C0=__builtin_amdgcn_mfma_f32_32x32x16_bf16(kf[2],qr[1],C0,0,0,0),   P0[10],P0[11],P0[12],P0[13], pw1[0]=PKW(P0,8), pw1[1]=PKW(P0,10), pw1); \
    VRD(5); SBAR(); GAPA(C1=__builtin_amdgcn_mfma_f32_32x32x16_bf16(kf[3],qr[1],C1,0,0,0),   P0[14],P0[15],P1[0],P1[1],   pw1[2]=PKW(P0,12),pw1[3]=PKW(P0,14), pw1); \
    VRD(2); SBAR(); GAPA(C0=__builtin_amdgcn_mfma_f32_32x32x16_bf16(kf[4],qr[2],C0,0,0,0),   P1[2],P1[3],P1[4],P1[5],     pw2[0]=PKW(P1,0), pw2[1]=PKW(P1,2), pw2); \
    VRD(6); SBAR(); GAPA(C1=__builtin_amdgcn_mfma_f32_32x32x16_bf16(kf[5],qr[2],C1,0,0,0),   P1[6],P1[7],P1[8],P1[9],     pw2[2]=PKW(P1,4), pw2[3]=PKW(P1,6), pw2); \
    VRD(3); SBAR(); GAPA(C0=__builtin_amdgcn_mfma_f32_32x32x16_bf16(kf[6],qr[3],C0,0,0,0),   P1[10],P1[11],P1[12],P1[13], pw3[0]=PKW(P1,8), pw3[1]=PKW(P1,10), pw3); \
    VRD(7); SBAR(); GAPA(C1=__builtin_amdgcn_mfma_f32_32x32x16_bf16(kf[7],qr[3],C1,0,0,0),   P1[14],P1[15],0.f,0.f,       pw3[2]=PKW(P1,12),pw3[3]=PKW(P1,14), pw3); \
    l_reg+=sacc; \
    if(GK){DMA_K((t)+3,sl_cur);} if(GV){DMA_V((t)+1,sl_next);} \
    BIAS(C0,C1,t); CMASK(C0,C1,t); \
    { float a=MX3(C0[0],C0[1],C1[0]),b=MX3(C0[2],C0[3],C1[1]); a=MX3(a,C1[2],C1[3]); \
      _Pragma("unroll") for(int r=4;r<16;r+=4){a=MX3(a,C0[r],C0[r+1]);b=MX3(b,C0[r+2],C0[r+3]);a=MX3(a,C1[r],C1[r+1]);b=MX3(b,C1[r+2],C1[r+3]);} \
      float rm=__builtin_fmaxf(a,b); { auto rr=__builtin_amdgcn_permlane32_swap(__float_as_uint(rm),__float_as_uint(rm),false,false); rm=__builtin_fmaxf(__uint_as_float(rr[0]),__uint_as_float(rr[1])); } \
      resc=false; \
      if(__builtin_expect(__any(rm>(float)THRL),0)){ const float dl=__builtin_fmaxf(rm,0.f); mhat+=dl; \
        _Pragma("unroll") for(int r=0;r<16;++r){C0[r]-=dl;C1[r]-=dl;} \
        _Pragma("unroll") for(int r=0;r<16;++r)negm[r]=-mhat; asm volatile("":"+v"(negm)); \
        const float f=__builtin_amdgcn_exp2f(-dl); l_reg*=f; if(hi==0)wsf[r32]=f; resc=true; } } \
    SBAR(); \
    GAPB(o[0]=__builtin_amdgcn_mfma_f32_32x32x16_bf16(PAF(0),VFR(0),o[0],0,0,0), C0,0); \
    GAPB(o[1]=__builtin_amdgcn_mfma_f32_32x32x16_bf16(PAF(0),VFR(4),o[1],0,0,0), C0,4); \
    KRD(GL,0); GAPB(o[0]=__builtin_amdgcn_mfma_f32_32x32x16_bf16(PAF(1),VFR(1),o[0],0,0,0), C0,8); \
    KRD(GL,1); GAPB(o[1]=__builtin_amdgcn_mfma_f32_32x32x16_bf16(PAF(1),VFR(5),o[1],0,0,0), C0,12); \
    KRD(GL,2); GAPB(o[0]=__builtin_amdgcn_mfma_f32_32x32x16_bf16(PAF(2),VFR(2),o[0],0,0,0), C1,0); \
    KRD(GL,3); GAPB(o[1]=__builtin_amdgcn_mfma_f32_32x32x16_bf16(PAF(2),VFR(6),o[1],0,0,0), C1,4); \
    GAPB(o[0]=__builtin_amdgcn_mfma_f32_32x32x16_bf16(PAF(3),VFR(3),o[0],0,0,0), C1,8); \
    GAPB(o[1]=__builtin_amdgcn_mfma_f32_32x32x16_bf16(PAF(3),VFR(7),o[1],0,0,0), C1,12); \
    }while(0)
  int t=1;
  #undef CMASK
  #define CMASK(P0,P1,t) do{}while(0)
  for(;t+5<NT;t+=2){
    STEP(pB0,pB1,pA0,pA1,t,true,true,true);     WAIT_BAR(2); RESC(); ROT();
    STEP(pA0,pA1,pB0,pB1,t+1,true,true,true);   WAIT_BAR(2); RESC(); ROT();
  }
  #undef CMASK
  #define CMASK(P0,P1,t) do{int jb_=(t)-(NT-4); if(jb_>=0)cmask(P0,P1,jb_,qrel,hi);}while(0)
  #define ENDW(tt) do{ if((tt)+3<NT){WAIT_BAR(2);} else if((tt)+2<NT){WAIT_BAR(1);} else {WAIT_BAR(0);} }while(0)
  for(;t+1<NT;t+=2){
    STEP(pB0,pB1,pA0,pA1,t,(t+3<NT),(t+1<NT),(t+1<NT));       ENDW(t);   RESC(); ROT();
    STEP(pA0,pA1,pB0,pB1,t+1,(t+4<NT),(t+2<NT),(t+2<NT));     ENDW(t+1); RESC(); ROT();
  }
  STEP(pB0,pB1,pA0,pA1,NT-1,false,false,false); RESC();
  { float sacc=pB0[0]+pB0[1]; _Pragma("unroll") for(int r=2;r<16;++r)sacc+=pB0[r]; _Pragma("unroll") for(int r=0;r<16;++r)sacc+=pB1[r]; l_reg+=sacc;
    pw0=(u32x4){PKW(pB0,0),PKW(pB0,2),PKW(pB0,4),PKW(pB0,6)};pw1=(u32x4){PKW(pB0,8),PKW(pB0,10),PKW(pB0,12),PKW(pB0,14)};pw2=(u32x4){PKW(pB1,0),PKW(pB1,2),PKW(pB1,4),PKW(pB1,6)};pw3=(u32x4){PKW(pB1,8),PKW(pB1,10),PKW(pB1,12),PKW(pB1,14)};
    SBAR(); pv(o,vb0+sl_cur,PAF(0),PAF(1),PAF(2),PAF(3)); }
  #undef PKW
  #undef PAF
  #undef VFR
  #undef PIN
  #undef MX3
  #undef GAPA
  #undef GAPB
  #undef EX
  #undef VRD
  #undef KRD
  #undef STEP
  #undef ENDW
  {auto rr=__builtin_amdgcn_permlane32_swap(__float_as_uint(l_reg),__float_as_uint(l_reg),false,false);l_reg=__uint_as_float(rr[0])+__uint_as_float(rr[1]);}
  if(hi==0)wsf[32+r32]=l_reg;asm volatile("s_waitcnt lgkmcnt(0)":::"memory");
  float rli[16];
  #pragma unroll
  for(int r=0;r<16;++r)rli[r]=__builtin_amdgcn_rcpf(wsf[32+crow(r,hi)]);
  bf16*Ow=O+(rowbase+q0+wid*QBLK)*DM+h*D;
  { bf16*stg=(bf16*)(shm+LDS_OST)+wid*2048;
    #pragma unroll
    for(int r=0;r<16;++r){const int orow=crow(r,hi);
      #pragma unroll
      for(int d0=0;d0<2;++d0)stg[orow*64+d0*32+r32]=__float2bfloat16(o[d0][r]*rli[r]);}
    asm volatile("s_waitcnt lgkmcnt(0)":::"memory");
    #pragma unroll
    for(int i=0;i<4;++i){const int row=i*8+(lane>>3),ch=lane&7; const u32x4 v=*(const u32x4*)(stg+row*64+ch*8);
      const u32x4 gz=*(const u32x4*)(GZ+(rowbase+q0+wid*QBLK+row)*VP+h*D+ch*8); u32x4 w;
      #define GM(a,g) cvtpk_s(__uint_as_float((a)<<16)*sigm(__uint_as_float((g)<<16)), __uint_as_float((a)&0xffff0000u)*sigm(__uint_as_float((g)&0xffff0000u)))
      w.x=GM(v.x,gz.x); w.y=GM(v.y,gz.y); w.z=GM(v.z,gz.z); w.w=GM(v.w,gz.w);
      #undef GM
      ATTN_STORE16(Ow+(long)row*DM+ch*8,w);} }
  asm volatile("s_waitcnt lgkmcnt(0)\n\ts_barrier":::"memory");
  #undef DMA_K
  #undef DMA_V
  #undef BIAS
  #undef CMASK
  #undef START
  #undef RESC
  #undef ROT
}
constexpr int ATTN_LDS_BYTES=LDS_BYTES;
#undef SBAR
#undef WAIT_BAR
}
#define GAS __attribute__((address_space(1)))
#define LAS __attribute__((address_space(3)))
typedef unsigned short bf16;
typedef unsigned v4u __attribute__((ext_vector_type(4)));
typedef float f32x4 __attribute__((ext_vector_type(4)));
typedef short bf16x8 __attribute__((ext_vector_type(8)));
typedef GAS unsigned gu32;
typedef GAS unsigned long long gu64;
#define RLX_AGENT __ATOMIC_RELAXED, __HIP_MEMORY_SCOPE_AGENT
#define LDS_WAIT() asm volatile("s_waitcnt lgkmcnt(0)" ::: "memory")
#define VM_WAIT() asm volatile("s_waitcnt vmcnt(0)" ::: "memory")
__device__ __forceinline__ unsigned long long rt() { return __builtin_amdgcn_s_memrealtime(); }
__device__ __forceinline__ unsigned f2bf(float f) { unsigned u = __builtin_bit_cast(unsigned, f); return (u + 0x7fffu + ((u >> 16) & 1u)) >> 16; }
__device__ __forceinline__ unsigned pk2(float lo, float hi) { return f2bf(lo) | (f2bf(hi) << 16); }

#define XB_TMO      128
#define XB_XCNT(j)  (256  + 64 * (j))
#define XB_XSUB(j)  (1280 + 64 * (j))
#define XB_XGEN(j)  (2304 + 64 * (j))
#define XB_TOP      3328
#define XB_TOPGEN   3392
#define XCD_BAR_WORDS 3456
#define XB_SPIN_CAP (1u << 18)

__device__ __forceinline__ unsigned xb_ld(unsigned* p)              { return __hip_atomic_load(p, __ATOMIC_RELAXED, __HIP_MEMORY_SCOPE_AGENT); }
__device__ __forceinline__ unsigned xb_add(unsigned* p, unsigned v) { return __hip_atomic_fetch_add(p, v, __ATOMIC_RELAXED, __HIP_MEMORY_SCOPE_AGENT); }
__device__ __forceinline__ unsigned xb_xcc_id() { return (unsigned)__builtin_amdgcn_s_getreg((3 << 11) | 20) & 0xFu; }
#define XB_SPIN(cond, bar) do { unsigned _sp = 0; while (cond) { __builtin_amdgcn_s_sleep(1); \
    if ((++_sp & 255u) == 0u) { if (xb_ld(&(bar)[XB_TMO])) break; if (_sp > XB_SPIN_CAP) { atomicAdd(&(bar)[XB_TMO], 1u); break; } } } } while (0)

struct XcdBarrier {
    unsigned* bar; unsigned x;
    volatile LAS unsigned* st;
};

__device__ __forceinline__ XcdBarrier xcd_barrier_post(unsigned* bar, volatile LAS unsigned* st) {
    XcdBarrier b; b.bar = bar; b.x = xb_xcc_id(); b.st = st;
    if (threadIdx.x == 0) (void)xb_add(&bar[XB_XCNT(b.x)], 1u);
    return b;
}
__device__ __forceinline__ void xcd_barrier_complete(unsigned* bar, unsigned x, unsigned& nloc, unsigned& nx) {
    const unsigned G = gridDim.x * gridDim.y * gridDim.z;
    unsigned sum, cnt, mine, sp = 0u;
    for (;;) {
        sum = 0u; cnt = 0u; mine = 0u;
#pragma unroll
        for (unsigned j = 0; j < 16; ++j) { const unsigned c = xb_ld(&bar[XB_XCNT(j)]); sum += c; cnt += (c > 0u) ? 1u : 0u; mine = (j == x) ? c : mine; }
        if (sum == G) break;
        __builtin_amdgcn_s_sleep(1);
        if ((++sp & 255u) == 0u) { if (xb_ld(&bar[XB_TMO])) break; if (sp > XB_SPIN_CAP) { atomicAdd(&bar[XB_TMO], 1u); break; } }
    }
    nloc = mine > 0u ? mine : 1u; nx = cnt > 0u ? cnt : 1u;
}

__device__ __forceinline__ void xcd_barrier(const XcdBarrier& b) {
    asm volatile("s_waitcnt vmcnt(0)" ::: "memory");
    __syncthreads();
    if (threadIdx.x == 0) {
        unsigned* bar = b.bar;
        __builtin_amdgcn_s_waitcnt(0);
        unsigned nloc = b.st[0], nx = b.st[1];
        if (nloc == 0u) { xcd_barrier_complete(bar, b.x, nloc, nx); b.st[0] = nloc; b.st[1] = nx; }
        const unsigned old = xb_add(&bar[XB_XSUB(b.x)], 1u);
        const unsigned gen = old / nloc;
        if (old + 1u == (gen + 1u) * nloc) {
            __builtin_amdgcn_fence(__ATOMIC_RELEASE, "agent");
            asm volatile("s_waitcnt vmcnt(0)" ::: "memory");
            const unsigned og = xb_add(&bar[XB_TOP], 1u);
            const unsigned tg = og / nx;
            if (og + 1u == (tg + 1u) * nx) xb_add(&bar[XB_TOPGEN], 1u);
            else XB_SPIN(xb_ld(&bar[XB_TOPGEN]) == tg, bar);
            __builtin_amdgcn_fence(__ATOMIC_ACQUIRE, "agent");
            xb_add(&bar[XB_XGEN(b.x)], 1u);
            asm volatile("s_waitcnt vmcnt(0)" ::: "memory");
        } else {
            XB_SPIN(xb_ld(&bar[XB_XGEN(b.x)]) == gen, bar);
            __builtin_amdgcn_fence(__ATOMIC_ACQUIRE, "agent");
            asm volatile("s_waitcnt vmcnt(0)" ::: "memory");
        }
    }
    __syncthreads();
}
constexpr int NWAVES = 8;
#ifndef MK_PER_PHASE
#define MK_PER_PHASE 1
#endif
constexpr int SEQ = 8192, DM = 2048, DFF = 5632, NH = 8, HD = 64, MW = 512, DEPTH = 4, ZW = 8192;
constexpr int PH_PER_LAYER = 13, N_PHASES = 1 + DEPTH * PH_PER_LAYER;
constexpr int ZC_FQ = 0, ZC_FK = 512, ZC_FV = 1024, ZC_FO = 1536, ZC_RR = 2048, ZC_RK = 2560, ZC_RV = 3072, ZC_RL = 3584;
constexpr int ZC_TQ = 3840, ZC_TK = 4352, ZC_TV = 4864, ZC_TG = 5376, ZC_MQK = 5888, ZC_MV = 6912, ZC_MO = 7424, ZC_FF = 7936, ZC_MI = 7944, ZC_MF = 7952;
enum { I_X = 0, I_POS, I_F1N, I_F1W1, I_F1W3, I_F1W2, I_MIXN, I_WIN, I_FOXFB, I_FOXQG, I_FOXKG, I_RMU, I_RW0, I_RW2, I_RA0, I_RA2, I_RG2, I_RKK, I_RKA, I_RRK, I_RGNW, I_RGNB,
       I_TGN, I_MCW, I_MCB, I_MIB, I_MFB, I_MGN, I_WG, I_WGB, I_WB, I_WO, I_F2N, I_F2W1, I_F2W3, I_F2W2, N_IN };
constexpr size_t MiB = 1u << 20;
constexpr size_t WS_CTL = 0, CTL_ZERO_BYTES = 1 * MiB;
constexpr size_t WL_W13A = 0, WL_W2A = 44 * MiB, WL_W13B = 66 * MiB, WL_W2B = 110 * MiB, WL_WIN = 132 * MiB, WL_WG = 164 * MiB, WL_WB = 196 * MiB, WL_WO = 204 * MiB, WL_BYTES = 212 * MiB;
constexpr size_t WS_W = 2 * MiB;
constexpr size_t WS_XN = WS_W + DEPTH * WL_BYTES + 2 * MiB;
constexpr size_t WS_Z = WS_XN + 32 * MiB;
constexpr size_t WS_HID = WS_Z;
constexpr size_t WS_GATES = WS_Z + 128 * MiB;
constexpr size_t WS_FQ = WS_GATES + 128 * MiB, WS_FK = WS_FQ + 8 * MiB, WS_YF = WS_FK + 8 * MiB, WS_RQ = WS_YF + 8 * MiB, WS_RK = WS_RQ + 8 * MiB, WS_YR = WS_RK + 8 * MiB;
constexpr size_t WS_MQ = WS_YR + 8 * MiB, WS_MK = WS_MQ + 8 * MiB, WS_YM = WS_MK + 8 * MiB, WS_YB = WS_YM + 8 * MiB;
constexpr size_t WS_RW = WS_YB + 8 * MiB;
constexpr size_t WS_YRAW = WS_RW + 100 * MiB;
constexpr size_t WS_RG = WS_YRAW + 16 * MiB;
constexpr size_t WS_SM = WS_RG + 8 * MiB;
constexpr size_t SM_RBON = 0, SM_FP = 256 * 1024, SM_FT = 512 * 1024, SM_MBC = 768 * 1024, SM_MA = 1024 * 1024;
constexpr size_t WS_MRGF = WS_SM + 2 * MiB;
constexpr size_t WS_MRGB = WS_MRGF + 64 * MiB;
constexpr size_t WS_END = WS_MRGB + 32 * MiB;
constexpr int CW_TMO = 0, CW_CODE = 1, CW_BAR = 4096;
constexpr int RING_OFF = 0, RING_BYTES = 131072, LDSCTL_OFF = RING_BYTES, MISC_OFF = LDSCTL_OFF + 320, LDS_BYTES = 147456;
constexpr int RREC = 400;
struct Args { const float* in[N_IN]; float* out; unsigned char* ws; int ph_lo, ph_hi, li, pad; };
struct Frame {
    LAS unsigned char* lds; volatile LAS unsigned* MISC; gu32* ctl;
    int tid, lane, wave, vcu, G;
    unsigned char* ws;
};
__device__ __forceinline__ float wave_sum(float v) {
#pragma unroll
    for (int o = 1; o < 64; o <<= 1) v += __shfl_xor(v, o);
    return v;
}
__device__ __forceinline__ float wave_incl_scan(float v, int lane) {
#pragma unroll
    for (int o = 1; o < 64; o <<= 1) { const float u = __shfl_up(v, o); if (lane >= o) v += u; }
    return v;
}
__device__ __forceinline__ float wave_incl_max(float v, int lane) {
#pragma unroll
    for (int o = 1; o < 64; o <<= 1) { const float u = __shfl_up(v, o); if (lane >= o) v = fmaxf(v, u); }
    return v;
}
__device__ __forceinline__ float lo16(unsigned p) { return __builtin_bit_cast(float, p << 16); }
__device__ __forceinline__ float hi16(unsigned p) { return __builtin_bit_cast(float, p & 0xffff0000u); }
__device__ __forceinline__ void unpack8(const v4u p, float (&f)[8]) { f[0] = lo16(p.x); f[1] = hi16(p.x); f[2] = lo16(p.y); f[3] = hi16(p.y); f[4] = lo16(p.z); f[5] = hi16(p.z); f[6] = lo16(p.w); f[7] = hi16(p.w); }
__device__ __forceinline__ unsigned cvtpk(float lo, float hi) { return pg8::cvt_pk_bf16(lo, hi); }
__device__ __forceinline__ v4u pack8(const float (&f)[8]) { v4u o; o.x = cvtpk(f[0], f[1]); o.y = cvtpk(f[2], f[3]); o.z = cvtpk(f[4], f[5]); o.w = cvtpk(f[6], f[7]); return o; }
__device__ __forceinline__ float bf1(const bf16* p) { return __builtin_bit_cast(float, (unsigned)(*p) << 16); }
__device__ __forceinline__ float sigmoidf_(float x) { return 1.f / (1.f + __expf(-x)); }
__device__ __forceinline__ float logsigf_(float x) { return fminf(x, 0.f) - log1pf(__expf(-fabsf(x))); }
__device__ __forceinline__ float siluf_(float x) { return x * sigmoidf_(x); }

__device__ __forceinline__ void tr_item(const float* W, int K, int Nsrc, int scol, bf16* WT, int k0, int drow0, LAS float* scr, int lane) {
#pragma unroll 8
    for (int i = 0; i < 32; ++i) { const int kk = 2 * i + (lane >> 5); scr[kk * 33 + (lane & 31)] = (scol >= 0) ? W[(size_t)(k0 + kk) * Nsrc + scol] : 0.f; }
    LDS_WAIT(); asm volatile("" ::: "memory");
    const int c = lane & 7;
#pragma unroll
    for (int j = 0; j < 4; ++j) { const int n = (lane >> 3) + 8 * j; const LAS float* s = scr + (8 * c) * 33 + n;
        v4u o; o.x = pk2(s[0 * 33], s[1 * 33]); o.y = pk2(s[2 * 33], s[3 * 33]); o.z = pk2(s[4 * 33], s[5 * 33]); o.w = pk2(s[6 * 33], s[7 * 33]);
        *(GAS v4u*)(WT + (size_t)(drow0 + n) * K + k0 + 8 * c) = o; }
    LDS_WAIT(); asm volatile("" ::: "memory");
}
__device__ __forceinline__ int win_src(int n) { return n < 2048 ? n : (n < 7936 ? n + 8 : (n < 7944 ? n - 5888 : (n < 7960 ? n : -1))); }
__device__ __forceinline__ void p0_prologue(Frame& F, const float* const* in) {
    LAS float* scr = (LAS float*)(F.lds + RING_OFF + F.wave * 16384);
    const int gw = F.vcu * NWAVES + F.wave, NGW = F.G * NWAVES, l5 = F.lane & 31;
    constexpr int I_13 = (DM / 64) * (2 * DFF / 32), I_2 = (DFF / 64) * (DM / 32), I_IN = (DM / 64) * (ZW / 32), I_G = (DM / 64) * (4 * DM / 32), I_B = 4 * (MW / 64) * (DM / 32), I_O = (DM / 64) * (DM / 32);
    constexpr int PER_L = 2 * (I_13 + I_2) + I_IN + I_G + I_B + I_O;
    for (int it = gw; it < DEPTH * PER_L; it += NGW) {
        const int l = it / PER_L; int r = it % PER_L;
        unsigned char* wl = F.ws + WS_W + (size_t)l * WL_BYTES;
        if (r < 2 * (I_13 + I_2)) {
            const int ffn = r / (I_13 + I_2); r %= (I_13 + I_2);
            const float* w1 = in[ffn ? I_F2W1 : I_F1W1] + (size_t)l * DM * DFF; const float* w3 = in[ffn ? I_F2W3 : I_F1W3] + (size_t)l * DM * DFF; const float* w2 = in[ffn ? I_F2W2 : I_F1W2] + (size_t)l * DFF * DM;
            if (r < I_13) { const int nblk = 2 * DFF / 32, kb = r / nblk, nb = r % nblk, n0 = nb * 32, tile = n0 >> 8, within = n0 & 255;
                tr_item(within < 128 ? w1 : w3, DM, DFF, tile * 128 + (within & 127) + l5, (bf16*)(wl + (ffn ? WL_W13B : WL_W13A)), kb * 64, n0, scr, F.lane); }
            else { r -= I_13; const int nblk = DM / 32, kb = r / nblk, nb = r % nblk; tr_item(w2, DFF, DM, nb * 32 + l5, (bf16*)(wl + (ffn ? WL_W2B : WL_W2A)), kb * 64, nb * 32, scr, F.lane); }
            continue; }
        r -= 2 * (I_13 + I_2);
        if (r < I_IN) { const int nblk = ZW / 32, kb = r / nblk, nb = r % nblk; tr_item(in[I_WIN] + (size_t)l * DM * 7960, DM, 7960, win_src(nb * 32 + l5), (bf16*)(wl + WL_WIN), kb * 64, nb * 32, scr, F.lane); continue; }
        r -= I_IN;
        if (r < I_G) { const int nblk = 4 * DM / 32, kb = r / nblk, nb = r % nblk; tr_item(in[I_WG] + (size_t)l * DM * 4 * DM, DM, 4 * DM, nb * 32 + l5, (bf16*)(wl + WL_WG), kb * 64, nb * 32, scr, F.lane); continue; }
        r -= I_G;
        if (r < I_B) { const int per = (MW / 64) * (DM / 32), n = r / per; r %= per; const int nblk = DM / 32, kb = r / nblk, nb = r % nblk;
            tr_item(in[I_WB] + ((size_t)l * 4 + n) * MW * DM, MW, DM, nb * 32 + l5, (bf16*)(wl + WL_WB) + (size_t)n * DM * MW, kb * 64, nb * 32, scr, F.lane); continue; }
        r -= I_B;
        { const int nblk = DM / 32, kb = r / nblk, nb = r % nblk; tr_item(in[I_WO] + (size_t)l * DM * DM, DM, DM, nb * 32 + l5, (bf16*)(wl + WL_WO), kb * 64, nb * 32, scr, F.lane); }
    }
}
__device__ __forceinline__ void norm_phase(Frame& F, const float* x, const float* gain, bf16* out) {
    const int gw = F.vcu * NWAVES + F.wave, NGW = F.G * NWAVES;
    f32x4 g[8];
#pragma unroll
    for (int j = 0; j < 8; ++j) g[j] = *(const f32x4*)(gain + 256 * j + 4 * F.lane);
    for (int m = gw; m < SEQ; m += NGW) {
        const GAS f32x4* xr = (const GAS f32x4*)(x + (size_t)m * DM) + F.lane; f32x4 v[8]; float s = 0.f;
#pragma unroll
        for (int j = 0; j < 8; ++j) { v[j] = xr[64 * j]; s += (v[j].x * v[j].x + v[j].y * v[j].y) + (v[j].z * v[j].z + v[j].w * v[j].w); }
        const float rstd = 1.f / sqrtf(wave_sum(s) * (1.f / DM) + 1e-6f);
        GAS unsigned long long* o8 = (GAS unsigned long long*)(out + (size_t)m * DM) + F.lane;
#pragma unroll
        for (int j = 0; j < 8; ++j) { const f32x4 w = v[j] * rstd * g[j]; o8[64 * j] = (unsigned long long)cvtpk(w.x, w.y) | ((unsigned long long)cvtpk(w.z, w.w) << 32); }
    }
}
struct PrepP {
    const bf16* Z; const int* pos;
    const float *fox_fb, *fox_qg, *fox_kg, *mu, *w0, *w2, *a0, *a2, *g2, *k_k, *k_a, *r_k, *conv_w, *conv_b, *mib, *mfb;
    bf16 *FQ, *FK, *RQ, *RK, *MQ, *MK, *RG; float *RW, *RBON, *FP, *FT, *MBC, *MA;
};
__device__ __forceinline__ void prep_phase(Frame& F, const PrepP& P) {
    const int gw = F.vcu * NWAVES + F.wave, NGW = F.G * NWAVES, lane = F.lane;
    for (int it = gw; it < 128 * NH; it += NGW) {
        const int j = it >> 3, h = it & 7, t = 64 * j + lane; const bf16* zr = P.Z + (size_t)t * ZW;
        const float lf = logsigf_(bf1(zr + ZC_FF + h) + P.fox_fb[h]);
        const float inc = wave_incl_scan(lf, lane);
        P.FP[h * SEQ + t] = inc; if (lane == 63) P.FT[h * 128 + j] = inc;
        const float li = bf1(zr + ZC_MI + h) + P.mib[h];
        const float lfm = logsigf_(bf1(zr + ZC_MF + h) + P.mfb[h]);
        const float bc = wave_incl_scan(lfm, lane);
        P.MBC[h * SEQ + t] = bc; P.MA[h * SEQ + t] = li - bc;
    }
    {
        const int o8 = 8 * (lane & 7);
        float qg[8], kg[8], ifr[8];
#pragma unroll
        for (int i = 0; i < 8; ++i) { qg[i] = P.fox_qg[o8 + i] * (0.125f * 1.4426950408889634f); kg[i] = P.fox_kg[o8 + i];
            const int f = (o8 + i) & 31; ifr[i] = powf(10000.f, -(float)(2 * f) / 64.f); }
        const bool first = (lane & 7) < 4;
        for (int t = gw; t < SEQ; t += NGW) {
            const bf16* zr = P.Z + (size_t)t * ZW;
            {
                float q[8], k[8]; unpack8(*(const v4u*)(zr + ZC_FQ + 8 * lane), q); unpack8(*(const v4u*)(zr + ZC_FK + 8 * lane), k);
                float sq = 0.f, sk = 0.f;
#pragma unroll
                for (int i = 0; i < 8; ++i) { sq += q[i] * q[i]; sk += k[i] * k[i]; }
                sq += __shfl_xor(sq, 1); sk += __shfl_xor(sk, 1); sq += __shfl_xor(sq, 2); sk += __shfl_xor(sk, 2); sq += __shfl_xor(sq, 4); sk += __shfl_xor(sk, 4);
                const float rq = 1.f / sqrtf(sq * (1.f / 64.f) + 1e-6f), rk = 1.f / sqrtf(sk * (1.f / 64.f) + 1e-6f);
#pragma unroll
                for (int i = 0; i < 8; ++i) { q[i] = q[i] * rq * qg[i]; k[i] = k[i] * rk * kg[i]; }
                *(v4u*)(P.FQ + (size_t)t * MW + 8 * lane) = pack8(q); *(v4u*)(P.FK + (size_t)t * MW + 8 * lane) = pack8(k);
            }
            {
                const float pf = (float)P.pos[t];
                float cs[8], sn[8];
#pragma unroll
                for (int i = 0; i < 8; ++i) { const float ang = pf * ifr[i]; const double rev = (double)ang * 0.15915494309189535; const float fr = (float)(rev - rint(rev));
                    sn[i] = __builtin_amdgcn_sinf(fr); cs[i] = __builtin_amdgcn_cosf(fr); }
                float q[8], k[8], qo[8], ko[8]; unpack8(*(const v4u*)(zr + ZC_TQ + 8 * lane), q); unpack8(*(const v4u*)(zr + ZC_TK + 8 * lane), k);
#pragma unroll
                for (int i = 0; i < 8; ++i) { const float qp = __shfl_xor(q[i], 4), kp = __shfl_xor(k[i], 4);
                    qo[i] = first ? (q[i] * cs[i] - qp * sn[i]) : (qp * sn[i] + q[i] * cs[i]);
                    ko[i] = 0.125f * (first ? (k[i] * cs[i] - kp * sn[i]) : (kp * sn[i] + k[i] * cs[i])); }
                *(v4u*)(P.RQ + (size_t)t * MW + 8 * lane) = pack8(qo); *(v4u*)(P.RK + (size_t)t * MW + 8 * lane) = pack8(ko);
            }
#pragma unroll
            for (int p = 0; p < 2; ++p) {
                const int ch = 512 * p + 8 * lane; float acc[8];
#pragma unroll
                for (int i = 0; i < 8; ++i) acc[i] = P.conv_b[ch + i];
#pragma unroll
                for (int j = 0; j < 4; ++j) { const int tt = t - 3 + j; if (tt >= 0) { float x[8]; unpack8(*(const v4u*)(P.Z + (size_t)tt * ZW + ZC_MQK + ch), x);
#pragma unroll
                        for (int i = 0; i < 8; ++i) acc[i] += P.conv_w[j * 1024 + ch + i] * x[i]; } }
#pragma unroll
                for (int i = 0; i < 8; ++i) acc[i] = siluf_(acc[i]) * (p ? 0.125f : 1.f);
                *(v4u*)((p ? P.MK : P.MQ) + (size_t)t * MW + 8 * lane) = pack8(acc);
            }
        }
    }
    {
        LAS float* X = (LAS float*)(F.lds + RING_OFF) + F.wave * 1024;
        const int hh = lane >> 3, c0 = 8 * lane;
        for (int tb = gw; tb < SEQ / 4; tb += NGW) {
            const int t0 = 4 * tb;
            if (lane < 32) {
                float m8[8];
#pragma unroll
                for (int i = 0; i < 8; ++i) m8[i] = P.mu[1536 + 8 * lane + i];
                float prev[8];
                if (t0 > 0) unpack8(*(const v4u*)(P.Z + (size_t)(t0 - 1) * ZW + ZC_RL + 8 * lane), prev);
                else {
#pragma unroll
                    for (int i = 0; i < 8; ++i) prev[i] = 0.f; }
#pragma unroll
                for (int tk = 0; tk < 4; ++tk) { float cur[8]; unpack8(*(const v4u*)(P.Z + (size_t)(t0 + tk) * ZW + ZC_RL + 8 * lane), cur);
#pragma unroll
                    for (int i = 0; i < 8; ++i) { float v = cur[i] + m8[i] * (prev[i] - cur[i]); v = (lane < 8) ? tanhf(v) : ((lane < 16) ? v : sigmoidf_(v)); X[tk * 256 + 8 * lane + i] = v; prev[i] = cur[i]; } }
            }
            LDS_WAIT(); asm volatile("" ::: "memory");
            float aw[4][8], aa[4][8];
#pragma unroll
            for (int tk = 0; tk < 4; ++tk)
#pragma unroll
                for (int i = 0; i < 8; ++i) { aw[tk][i] = 0.f; aa[tk][i] = 0.f; }
            for (int j = 0; j < 64; j += 4) {
                f32x4 xw[4], xa[4];
#pragma unroll
                for (int tk = 0; tk < 4; ++tk) { xw[tk] = *(const LAS f32x4*)(X + tk * 256 + j); xa[tk] = *(const LAS f32x4*)(X + tk * 256 + 64 + j); }
#pragma unroll
                for (int jj = 0; jj < 4; ++jj) { const f32x4 wa = *(const f32x4*)(P.w2 + (size_t)(j + jj) * MW + c0), wb = *(const f32x4*)(P.w2 + (size_t)(j + jj) * MW + c0 + 4);
                    const f32x4 ya = *(const f32x4*)(P.a2 + (size_t)(j + jj) * MW + c0), yb = *(const f32x4*)(P.a2 + (size_t)(j + jj) * MW + c0 + 4);
#pragma unroll
                    for (int tk = 0; tk < 4; ++tk)
#pragma unroll
                        for (int e = 0; e < 4; ++e) { aw[tk][e] += xw[tk][jj] * wa[e]; aw[tk][4 + e] += xw[tk][jj] * wb[e]; aa[tk][e] += xa[tk][jj] * ya[e]; aa[tk][4 + e] += xa[tk][jj] * yb[e]; } }
            }
            float pr[8], pk[8], pv[8];
            if (t0 > 0) { const bf16* zp = P.Z + (size_t)(t0 - 1) * ZW; unpack8(*(const v4u*)(zp + ZC_RR + c0), pr); unpack8(*(const v4u*)(zp + ZC_RK + c0), pk); unpack8(*(const v4u*)(zp + ZC_RV + c0), pv); }
            else {
#pragma unroll
                for (int i = 0; i < 8; ++i) { pr[i] = 0.f; pk[i] = 0.f; pv[i] = 0.f; } }
#pragma unroll
            for (int tk = 0; tk < 4; ++tk) {
                asm volatile("" ::: "memory");
                const int t = t0 + tk; const bf16* zc = P.Z + (size_t)t * ZW;
                float* rec = P.RW + ((size_t)hh * SEQ + t) * RREC + 8 * (lane & 7);
                float r[8], k[8];
                { float cr[8], cv[8], v[8]; unpack8(*(const v4u*)(zc + ZC_RR + c0), cr); unpack8(*(const v4u*)(zc + ZC_RV + c0), cv);
#pragma unroll
                  for (int i = 0; i < 8; ++i) { r[i] = cr[i] + P.mu[c0 + i] * (pr[i] - cr[i]); v[i] = cv[i] + P.mu[1024 + c0 + i] * (pv[i] - cv[i]); pr[i] = cr[i]; pv[i] = cv[i]; }
                  *(f32x4*)(rec + 320) = (f32x4){v[0], v[1], v[2], v[3]}; *(f32x4*)(rec + 324) = (f32x4){v[4], v[5], v[6], v[7]}; }
                { float w[8], wr[8];
#pragma unroll
                  for (int i = 0; i < 8; ++i) { const float u = P.w0[c0 + i] + aw[tk][i]; w[i] = __expf(-0.6065306597126334f * sigmoidf_(u)); wr[i] = w[i] * r[i]; }
                  *(f32x4*)(rec + 128) = (f32x4){w[0], w[1], w[2], w[3]}; *(f32x4*)(rec + 132) = (f32x4){w[4], w[5], w[6], w[7]};
                  *(f32x4*)(rec + 256) = (f32x4){wr[0], wr[1], wr[2], wr[3]}; *(f32x4*)(rec + 260) = (f32x4){wr[4], wr[5], wr[6], wr[7]}; }
                { float ck[8]; unpack8(*(const v4u*)(zc + ZC_RK + c0), ck);
#pragma unroll
                  for (int i = 0; i < 8; ++i) { k[i] = ck[i] + P.mu[512 + c0 + i] * (pk[i] - ck[i]); pk[i] = ck[i]; } }
                float a[8], kk[8]; float ss = 0.f;
#pragma unroll
                for (int i = 0; i < 8; ++i) { a[i] = sigmoidf_(P.a0[c0 + i] + aa[tk][i]); kk[i] = k[i] * P.k_k[c0 + i]; ss += kk[i] * kk[i]; }
                ss += __shfl_xor(ss, 1); ss += __shfl_xor(ss, 2); ss += __shfl_xor(ss, 4);
                const float rn = 1.f / sqrtf(fmaxf(ss, 1e-12f));
                float c1 = 0.f, c2 = 0.f, bo = 0.f; float kp[8], b[8];
#pragma unroll
                for (int i = 0; i < 8; ++i) { kk[i] *= rn; kp[i] = k[i] * (1.f + (a[i] - 1.f) * P.k_a[c0 + i]); b[i] = kk[i] * a[i]; c1 += b[i] * r[i]; c2 += kp[i] * r[i]; bo += r[i] * kp[i] * P.r_k[c0 + i]; }
                c1 += __shfl_xor(c1, 1); c2 += __shfl_xor(c2, 1); bo += __shfl_xor(bo, 1); c1 += __shfl_xor(c1, 2); c2 += __shfl_xor(c2, 2); bo += __shfl_xor(bo, 2); c1 += __shfl_xor(c1, 4); c2 += __shfl_xor(c2, 4); bo += __shfl_xor(bo, 4);
                *(f32x4*)(rec) = (f32x4){kk[0], kk[1], kk[2], kk[3]}; *(f32x4*)(rec + 4) = (f32x4){kk[4], kk[5], kk[6], kk[7]};
                *(f32x4*)(rec + 64) = (f32x4){b[0], b[1], b[2], b[3]}; *(f32x4*)(rec + 68) = (f32x4){b[4], b[5], b[6], b[7]};
                *(f32x4*)(rec + 192) = (f32x4){kp[0], kp[1], kp[2], kp[3]}; *(f32x4*)(rec + 196) = (f32x4){kp[4], kp[5], kp[6], kp[7]};
                if ((lane & 7) == 0) { float* rc = P.RW + ((size_t)hh * SEQ + t) * RREC + 384; *(f32x4*)rc = (f32x4){c1, c2, 0.f, 0.f}; P.RBON[t * 8 + hh] = bo; }
            }
            {
                float ag[4][8];
#pragma unroll
                for (int tk = 0; tk < 4; ++tk)
#pragma unroll
                    for (int i = 0; i < 8; ++i) ag[tk][i] = 0.f;
                for (int j = 0; j < 128; j += 4) {
                    f32x4 xg[4];
#pragma unroll
                    for (int tk = 0; tk < 4; ++tk) xg[tk] = *(const LAS f32x4*)(X + tk * 256 + 128 + j);
#pragma unroll
                    for (int jj = 0; jj < 4; ++jj) { const f32x4 ga = *(const f32x4*)(P.g2 + (size_t)(j + jj) * MW + c0), gb = *(const f32x4*)(P.g2 + (size_t)(j + jj) * MW + c0 + 4);
#pragma unroll
                        for (int tk = 0; tk < 4; ++tk)
#pragma unroll
                            for (int e = 0; e < 4; ++e) { ag[tk][e] += xg[tk][jj] * ga[e]; ag[tk][4 + e] += xg[tk][jj] * gb[e]; } }
                }
#pragma unroll
                for (int tk = 0; tk < 4; ++tk) *(v4u*)(P.RG + (size_t)(t0 + tk) * MW + c0) = pack8(ag[tk]);
            }
            LDS_WAIT(); asm volatile("" ::: "memory");
        }
    }
}
template <int CTRL> __device__ __forceinline__ float dpp_add(float v) {
    return v + __builtin_bit_cast(float, __builtin_amdgcn_update_dpp(0, __builtin_bit_cast(int, v), CTRL, 0xf, 0xf, true));
}
__device__ __forceinline__ float row16_sum(float v) {
    v = dpp_add<0xB1>(v);
    v = dpp_add<0x4E>(v);
    v = dpp_add<0x141>(v);
    v = dpp_add<0x140>(v);
    return v;
}
constexpr int SC_STEPS = 32, SC_BUF = SC_STEPS * RREC * 4;
__device__ __forceinline__ void rwkv_scan_role(Frame& F, const float* RW, float* YRAW, int head, int half) {
    const int tid = F.tid, lane = F.lane, j16 = lane & 15, rr = lane >> 4;
    const int row = 32 * half + 4 * F.wave + rr;
    const float* src = RW + (size_t)head * SEQ * RREC;
    LAS unsigned char* buf0 = F.lds + RING_OFF;
    constexpr int NPIECE = SC_BUF / 16, NIT = (NPIECE + 511) / 512;
    f32x4 st[NIT];
#pragma unroll
    for (int i = 0; i < NIT; ++i) { const int p = tid + 512 * i; if (p < NPIECE) *(LAS f32x4*)(buf0 + 16 * p) = *(const f32x4*)(src + 4 * p); }
    __syncthreads();
    float s0 = 0.f, s1 = 0.f, s2 = 0.f, s3 = 0.f, ybuf = 0.f;
    constexpr int NCH = SEQ / SC_STEPS;
    for (int c = 0; c < NCH; ++c) {
        const LAS unsigned char* cur = buf0 + (c & 1) * SC_BUF; LAS unsigned char* nxt = buf0 + ((c + 1) & 1) * SC_BUF;
        if (c + 1 < NCH) {
#pragma unroll
            for (int i = 0; i < NIT; ++i) { const int p = tid + 512 * i; if (p < NPIECE) st[i] = *(const f32x4*)(src + (size_t)(c + 1) * (SC_BUF / 4) + 4 * p); }
        }
        const LAS unsigned char* rp = cur + 16 * j16;
        f32x4 kk = *(const LAS f32x4*)(rp), bb = *(const LAS f32x4*)(rp + 256), ww = *(const LAS f32x4*)(rp + 512), kp = *(const LAS f32x4*)(rp + 768), wr = *(const LAS f32x4*)(rp + 1024);
        float vv = *(const LAS float*)(cur + 1280 + 4 * row); float c1 = *(const LAS float*)(cur + 1536), c2 = *(const LAS float*)(cur + 1540);
#pragma unroll 4
        for (int s = 0; s < SC_STEPS; ++s) {
            const LAS unsigned char* np_ = cur + ((s + 1) & (SC_STEPS - 1)) * (RREC * 4) + 16 * j16; const LAS unsigned char* nb_ = cur + ((s + 1) & (SC_STEPS - 1)) * (RREC * 4);
            const f32x4 nkk = *(const LAS f32x4*)(np_), nbb = *(const LAS f32x4*)(np_ + 256), nww = *(const LAS f32x4*)(np_ + 512), nkp = *(const LAS f32x4*)(np_ + 768), nwr = *(const LAS f32x4*)(np_ + 1024);
            const float nvv = *(const LAS float*)(nb_ + 1280 + 4 * row), nc1 = *(const LAS float*)(nb_ + 1536), nc2 = *(const LAS float*)(nb_ + 1540);
            float d1 = s0 * kk[0] + s1 * kk[1] + (s2 * kk[2] + s3 * kk[3]);
            float d2 = s0 * wr[0] + s1 * wr[1] + (s2 * wr[2] + s3 * wr[3]);
            d1 = row16_sum(d1); d2 = row16_sum(d2);
            const float sa = -d1;
            s0 = fmaf(sa, bb[0], fmaf(s0, ww[0], vv * kp[0])); s1 = fmaf(sa, bb[1], fmaf(s1, ww[1], vv * kp[1]));
            s2 = fmaf(sa, bb[2], fmaf(s2, ww[2], vv * kp[2])); s3 = fmaf(sa, bb[3], fmaf(s3, ww[3], vv * kp[3]));
            const float y = d2 + sa * c1 + vv * c2;
            ybuf = (j16 == (s & 15)) ? y : ybuf;
            if ((s & 15) == 15) YRAW[(size_t)(c * SC_STEPS + (s & ~15) + j16) * MW + head * 64 + row] = ybuf;
            kk = nkk; bb = nbb; ww = nww; kp = nkp; wr = nwr; vv = nvv; c1 = nc1; c2 = nc2;
        }
        if (c + 1 < NCH) {
#pragma unroll
            for (int i = 0; i < NIT; ++i) { const int p = tid + 512 * i; if (p < NPIECE) *(LAS f32x4*)(nxt + 16 * p) = st[i]; }
        }
        __syncthreads();
    }
}
constexpr int LDT = 72;
constexpr int CK_TILE = 64 * LDT * 2;
constexpr int CK_Q = 0, CK_K = 2 * CK_TILE, CK_VT = 4 * CK_TILE, CK_KT = 6 * CK_TILE, CK_S = 8 * CK_TILE, CK_STB = 9 * CK_TILE, CK_OF = 10 * CK_TILE, CK_G = CK_OF + 64 * 68 * 4, CK_NV = CK_G + 2 * 1280, CK_END = CK_NV + 512;
__device__ __forceinline__ f32x4 mma64(f32x4 acc, const LAS bf16* A, const LAS bf16* B, int fr, int fq) {
#pragma unroll
    for (int ks = 0; ks < 2; ++ks) { const bf16x8 a = *(const LAS bf16x8*)(A + fr * LDT + ks * 32 + fq * 8), b = *(const LAS bf16x8*)(B + fr * LDT + ks * 32 + fq * 8);
        acc = __builtin_amdgcn_mfma_f32_16x16x32_bf16(a, b, acc, 0, 0, 0); }
    return acc;
}
template <int MODE> __device__ __forceinline__ void chunk_role(Frame& F, const bf16* Qp, const bf16* Kp, const bf16* Vp, const bf16* Gp, const float* gain, bf16* Y, int head, const float* MBC, const float* MA) {
    const int tid = F.tid, lane = F.lane, wave = F.wave, row = tid >> 3, seg = tid & 7, rb = wave >> 1, cb0 = 2 * (wave & 1), fr = lane & 15, fq = lane >> 4;
    LAS unsigned char* L = F.lds + RING_OFF;
    LAS bf16* Ss = (LAS bf16*)(L + CK_S); LAS bf16* STb = (LAS bf16*)(L + CK_STB); LAS float* Of = (LAS float*)(L + CK_OF); LAS float* NV = (LAS float*)(L + CK_NV);
    const float log2g = (MODE == 0) ? log2f(1.f - exp2f(-5.f - (float)head)) : 0.f;
    for (int i = tid; i < 64 * LDT / 2; i += 512) ((LAS unsigned*)STb)[i] = 0u;
    if (tid < 128) NV[tid] = 0.f;
    if (MODE == 0 && tid < 128) { LAS float* G = (LAS float*)(L + CK_G) + (tid >> 6) * 320; G[192 + (tid & 63)] = exp2f((float)(63 - (tid & 63)) * log2g); }
    f32x4 st0 = {0.f, 0.f, 0.f, 0.f}, st1 = {0.f, 0.f, 0.f, 0.f};
    const size_t gofs = (size_t)head * 64 + 8 * seg;
    v4u q8, k8, v8, g8;
    { const size_t t = row; q8 = *(const v4u*)(Qp + t * MW + gofs); k8 = *(const v4u*)(Kp + t * MW + gofs); v8 = *(const v4u*)(Vp + t * ZW + gofs); g8 = *(const v4u*)(Gp + t * ZW + gofs); }
    float gn[8];
#pragma unroll
    for (int i = 0; i < 8; ++i) gn[i] = gain[gofs + i];
    for (int c = 0; c < 128; ++c) {
        const int bsel = c & 1;
        { LAS bf16* Qs = (LAS bf16*)(L + CK_Q + bsel * CK_TILE); LAS bf16* Ks = (LAS bf16*)(L + CK_K + bsel * CK_TILE); LAS bf16* VT = (LAS bf16*)(L + CK_VT + bsel * CK_TILE); LAS bf16* KT = (LAS bf16*)(L + CK_KT + bsel * CK_TILE);
          *(LAS v4u*)(Qs + row * LDT + 8 * seg) = q8; *(LAS v4u*)(Ks + row * LDT + 8 * seg) = k8;
          const unsigned kw[4] = {k8.x, k8.y, k8.z, k8.w}, vw[4] = {v8.x, v8.y, v8.z, v8.w};
#pragma unroll
          for (int i = 0; i < 4; ++i) { KT[(8 * seg + 2 * i) * LDT + row] = (bf16)(kw[i] & 0xffffu); KT[(8 * seg + 2 * i + 1) * LDT + row] = (bf16)(kw[i] >> 16);
              VT[(8 * seg + 2 * i) * LDT + row] = (bf16)(vw[i] & 0xffffu); VT[(8 * seg + 2 * i + 1) * LDT + row] = (bf16)(vw[i] >> 16); }
          if (MODE == 1 && wave == 0) { LAS float* G = (LAS float*)(L + CK_G) + bsel * 320; const LAS float* Gp_ = (const LAS float*)(L + CK_G) + (bsel ^ 1) * 320;
              const float a = MA[(size_t)head * SEQ + 64 * c + lane], bc = MBC[(size_t)head * SEQ + 64 * c + lane];
              const float mp = (c == 0) ? 0.f : Gp_[256];
              const float Mi = fmaxf(mp, wave_incl_max(a, lane)); const float M63 = __shfl(Mi, 63);
              G[lane] = a; G[64 + lane] = Mi; G[128 + lane] = bc; G[192 + lane] = __expf(a - M63);
              if (lane == 63) { G[256] = bc + Mi; G[257] = mp; } }
        }
        const v4u gcur = g8;
        if (c + 1 < 128) { const size_t t = (size_t)64 * (c + 1) + row; q8 = *(const v4u*)(Qp + t * MW + gofs); k8 = *(const v4u*)(Kp + t * MW + gofs); v8 = *(const v4u*)(Vp + t * ZW + gofs); g8 = *(const v4u*)(Gp + t * ZW + gofs); }
        __syncthreads();
        const LAS bf16* Qs = (const LAS bf16*)(L + CK_Q + bsel * CK_TILE); const LAS bf16* Ks = (const LAS bf16*)(L + CK_K + bsel * CK_TILE); const LAS bf16* VT = (const LAS bf16*)(L + CK_VT + bsel * CK_TILE); const LAS bf16* KT = (const LAS bf16*)(L + CK_KT + bsel * CK_TILE);
        const LAS float* G = (const LAS float*)(L + CK_G) + bsel * 320;
        const float mp = (MODE == 1) ? G[257] : 0.f;
        f32x4 o0, o1;
        {
            const f32x4 z4 = {0.f, 0.f, 0.f, 0.f};
#pragma unroll
            for (int ct = 0; ct < 2; ++ct) { const int cb = cb0 + ct; f32x4 sc = mma64(z4, Qs + 16 * rb * LDT, Ks + 16 * cb * LDT, fr, fq);
                const int j = 16 * cb + fr; const float aj = (MODE == 1) ? G[j] : 0.f;
#pragma unroll
                for (int e = 0; e < 4; ++e) { const int i = 16 * rb + 4 * fq + e; float d;
                    if (MODE == 0) d = exp2f((float)(i > j ? i - j : j - i) * log2g); else d = (j <= i) ? __expf(aj - G[64 + i]) : 0.f;
                    Ss[i * LDT + j] = (bf16)f2bf(sc[e] * d); } }
            o0 = mma64(z4, Qs + 16 * rb * LDT, STb + 16 * cb0 * LDT, fr, fq); o1 = mma64(z4, Qs + 16 * rb * LDT, STb + 16 * (cb0 + 1) * LDT, fr, fq);
#pragma unroll
            for (int e = 0; e < 4; ++e) { const int i = 16 * rb + 4 * fq + e; const float sc = (MODE == 0) ? exp2f((float)(i + 1) * log2g) : __expf(mp - G[64 + i]); o0[e] *= sc; o1[e] *= sc; }
            const float dec = (MODE == 0) ? exp2f(64.f * log2g) : __expf(mp - G[64 + 63]);
            st0 *= dec; st1 *= dec;
#pragma unroll
            for (int ks = 0; ks < 2; ++ks) { float a8[8]; unpack8(*(const LAS v4u*)(VT + (16 * rb + fr) * LDT + ks * 32 + fq * 8), a8);
                const f32x4 w0 = *(const LAS f32x4*)(G + 192 + ks * 32 + fq * 8), w1 = *(const LAS f32x4*)(G + 192 + ks * 32 + fq * 8 + 4);
                a8[0] *= w0[0]; a8[1] *= w0[1]; a8[2] *= w0[2]; a8[3] *= w0[3]; a8[4] *= w1[0]; a8[5] *= w1[1]; a8[6] *= w1[2]; a8[7] *= w1[3];
                const bf16x8 a = __builtin_bit_cast(bf16x8, pack8(a8));
                const bf16x8 b0 = *(const LAS bf16x8*)(KT + (16 * cb0 + fr) * LDT + ks * 32 + fq * 8), b1 = *(const LAS bf16x8*)(KT + (16 * (cb0 + 1) + fr) * LDT + ks * 32 + fq * 8);
                st0 = __builtin_amdgcn_mfma_f32_16x16x32_bf16(a, b0, st0, 0, 0, 0); st1 = __builtin_amdgcn_mfma_f32_16x16x32_bf16(a, b1, st1, 0, 0, 0); }
        }
        __syncthreads();
        o0 = mma64(o0, Ss + 16 * rb * LDT, VT + 16 * cb0 * LDT, fr, fq); o1 = mma64(o1, Ss + 16 * rb * LDT, VT + 16 * (cb0 + 1) * LDT, fr, fq);
#pragma unroll
        for (int e = 0; e < 4; ++e) { const int r_ = 16 * rb + 4 * fq + e;
            STb[r_ * LDT + 16 * cb0 + fr] = (bf16)f2bf(st0[e]); STb[r_ * LDT + 16 * (cb0 + 1) + fr] = (bf16)f2bf(st1[e]);
            Of[r_ * 68 + 16 * cb0 + fr] = o0[e]; Of[r_ * 68 + 16 * (cb0 + 1) + fr] = o1[e]; }
        __syncthreads();
        {
            float o[8]; { const f32x4 a = *(const LAS f32x4*)(Of + row * 68 + 8 * seg), b = *(const LAS f32x4*)(Of + row * 68 + 8 * seg + 4); o[0] = a[0]; o[1] = a[1]; o[2] = a[2]; o[3] = a[3]; o[4] = b[0]; o[5] = b[1]; o[6] = b[2]; o[7] = b[3]; }
            float gz[8]; unpack8(gcur, gz);
            if (MODE == 1) {
                float s8[8], q8f[8]; unpack8(*(const LAS v4u*)(Ss + row * LDT + 8 * seg), s8); unpack8(*(const LAS v4u*)(Qs + row * LDT + 8 * seg), q8f);
                const LAS float* nv = NV + bsel * 64 + 8 * seg; float ds = 0.f, nq = 0.f;
#pragma unroll
                for (int i = 0; i < 8; ++i) { ds += s8[i]; nq += nv[i] * q8f[i]; }
                ds += __shfl_xor(ds, 1); nq += __shfl_xor(nq, 1); ds += __shfl_xor(ds, 2); nq += __shfl_xor(nq, 2); ds += __shfl_xor(ds, 4); nq += __shfl_xor(nq, 4);
                const float Mi = G[64 + row], den = ds + __expf(mp - Mi) * nq, dn = fmaxf(fabsf(den), __expf(-(G[128 + row] + Mi))), inv = 1.f / dn;
#pragma unroll
                for (int i = 0; i < 8; ++i) o[i] = o[i] * inv * sigmoidf_(gz[i]);
                float k8f[8]; unpack8(*(const LAS v4u*)(KT + row * LDT + 8 * seg), k8f); float ns = 0.f;
#pragma unroll
                for (int i = 0; i < 8; ++i) ns += k8f[i] * G[192 + 8 * seg + i];
                ns += __shfl_xor(ns, 1); ns += __shfl_xor(ns, 2); ns += __shfl_xor(ns, 4);
                if (seg == 0) NV[(bsel ^ 1) * 64 + row] = __expf(mp - G[64 + 63]) * NV[bsel * 64 + row] + ns;
            }
            float ss = 0.f;
#pragma unroll
            for (int i = 0; i < 8; ++i) ss += o[i] * o[i];
            ss += __shfl_xor(ss, 1); ss += __shfl_xor(ss, 2); ss += __shfl_xor(ss, 4);
            const float rs = 1.f / sqrtf(ss * (1.f / 64.f) + 1e-6f);
#pragma unroll
            for (int i = 0; i < 8; ++i) { o[i] = o[i] * rs * gn[i]; if (MODE == 0) o[i] *= siluf_(gz[i]); }
            *(v4u*)(Y + ((size_t)64 * c + row) * MW + gofs) = pack8(o);
        }
    }
    __syncthreads();
}
#if DBG
__device__ __forceinline__ unsigned dh(unsigned x) { x ^= x >> 16; x *= 0x7feb352du; x ^= x >> 15; x *= 0x846ca68bu; x ^= x >> 16; return x; }
__device__ __forceinline__ float b2f(bf16 v) { return __builtin_bit_cast(float, (unsigned)v << 16); }
__device__ __forceinline__ float rbf(float f) { return __builtin_bit_cast(float, f2bf(f) << 16); }
__device__ __forceinline__ void dflag(unsigned* flags, int idx, float err, float tol) { if (!(err <= tol)) { atomicOr(&flags[idx], 1u); atomicMax(&flags[32 + idx], __float_as_uint(fminf(fabsf(err), 1e30f))); } }
__device__ __forceinline__ float ddot(const bf16* a, const bf16* b, int K) { float s = 0.f; for (int k = 0; k < K; ++k) s += b2f(a[k]) * b2f(b[k]); return s; }
__global__ void k_check(Args args, int which, int l) {
    const int sid = blockIdx.x * blockDim.x + threadIdx.x; unsigned char* ws = args.ws; unsigned* flags = (unsigned*)(ws + WS_CTL) + 2048;
    const unsigned h1 = dh(sid * 2654435761u + which * 97u), h2 = dh(h1 + 12345u);
    const int row = h1 % SEQ; unsigned char* wl = ws + WS_W + (size_t)l * WL_BYTES;
    const bf16* XN = (const bf16*)(ws + WS_XN); const bf16* Z = (const bf16*)(ws + WS_Z); const bf16* HID = (const bf16*)(ws + WS_HID); const bf16* GATES = (const bf16*)(ws + WS_GATES);
    const float* SNAP = (const float*)(ws + WS_END);
    if (which == 1) {
        const int n = h1 % (2 * DFF), k = h2 % DM, tile = n >> 8, within = n & 255; const float* w = args.in[within < 128 ? I_F1W1 : I_F1W3] + (size_t)l * DM * DFF;
        const float ref = rbf(w[(size_t)k * DFF + tile * 128 + (within & 127)]); const float got = b2f(((const bf16*)(wl + WL_W13A))[(size_t)n * DM + k]);
        dflag(flags, which, fabsf(ref - got), 0.f);
        const int n2 = h1 % ZW; const int sc = win_src(n2); const float r2 = sc >= 0 ? rbf((args.in[I_WIN] + (size_t)l * DM * 7960)[(size_t)k * 7960 + sc]) : 0.f; dflag(flags, which, fabsf(r2 - b2f(((const bf16*)(wl + WL_WIN))[(size_t)n2 * DM + k])), 0.f);
        const int k2 = h2 % DFF, n3 = h1 % DM; dflag(flags, which, fabsf(rbf((args.in[I_F1W2] + (size_t)l * DFF * DM)[(size_t)k2 * DM + n3]) - b2f(((const bf16*)(wl + WL_W2A))[(size_t)n3 * DFF + k2])), 0.f);
        const int nb = h2 % 4, kb = h1 % MW; dflag(flags, which, fabsf(rbf((args.in[I_WB] + ((size_t)l * 4 + nb) * MW * DM)[(size_t)kb * DM + n3]) - b2f(((const bf16*)(wl + WL_WB))[((size_t)nb * DM + n3) * MW + kb])), 0.f);
        dflag(flags, which, fabsf(rbf((args.in[I_WO] + (size_t)l * DM * DM)[(size_t)k * DM + n3]) - b2f(((const bf16*)(wl + WL_WO))[(size_t)n3 * DM + k])), 0.f);
        const int n4 = h1 % (4 * DM); dflag(flags, which, fabsf(rbf((args.in[I_WG] + (size_t)l * DM * 4 * DM)[(size_t)k * 4 * DM + n4]) - b2f(((const bf16*)(wl + WL_WG))[(size_t)n4 * DM + k])), 0.f);
    }
    if (which == 2 || which == 5) {
        const float* x = (which == 2) ? args.in[I_X] : args.out; const float* g = args.in[which == 2 ? I_F1N : I_MIXN] + (size_t)l * DM;
        float ss = 0.f; for (int k = 0; k < DM; ++k) { const float v = x[(size_t)row * DM + k]; ss += v * v; }
        const float rs = 1.f / sqrtf(ss / DM + 1e-6f); const int c = h2 % DM; const float ref = x[(size_t)row * DM + c] * rs * g[c];
        dflag(flags, which, fabsf(ref - b2f(XN[(size_t)row * DM + c])), 0.02f * fabsf(ref) + 0.01f);
    }
    if (which == 3) {
        const int c = h2 % DFF, tile = c >> 7, w_ = c & 127; const bf16* B = (const bf16*)(wl + WL_W13A);
        const float a = ddot(XN + (size_t)row * DM, B + (size_t)(tile * 256 + w_) * DM, DM), b = ddot(XN + (size_t)row * DM, B + (size_t)(tile * 256 + 128 + w_) * DM, DM);
        const float ref = a / (1.f + expf(-a)) * b; dflag(flags, which, fabsf(ref - b2f(HID[(size_t)row * DFF + c])), 0.02f * fabsf(ref) + 0.02f);
    }
    if (which == 4) {
        const int c = h2 % DM; const float ref = args.in[I_X][(size_t)row * DM + c] + 0.5f * ddot(HID + (size_t)row * DFF, (const bf16*)(wl + WL_W2A) + (size_t)c * DFF, DFF);
        dflag(flags, which, fabsf(ref - args.out[(size_t)row * DM + c]), 0.01f * fabsf(ref) + 0.01f);
    }
    if (which == 6) {
        const int c = (sid & 1) ? (7936 + h2 % 24) : (h2 % ZW); const float ref = ddot(XN + (size_t)row * DM, (const bf16*)(wl + WL_WIN) + (size_t)c * DM, DM);
        dflag(flags, which, fabsf(ref - b2f(Z[(size_t)row * ZW + c])), 0.02f * fabsf(ref) + 0.02f);
    }
    if (which == 7) {
        const int c = h2 % (4 * DM); const float a = ddot(XN + (size_t)row * DM, (const bf16*)(wl + WL_WG) + (size_t)c * DM, DM) + (args.in[I_WGB] + (size_t)l * 4 * DM)[c];
#if DBG_RAWGATE
        const float ref = a - ((DBG_RAWGATE == 2) ? 0.f : (args.in[I_WGB] + (size_t)l * 4 * DM)[c]); dflag(flags, which, fabsf(ref - b2f(GATES[(size_t)row * 4 * DM + c])), 0.02f * fabsf(ref) + 0.02f);
#else
        const float ref = 1.f / (1.f + expf(-a)); dflag(flags, which, fabsf(ref - b2f(GATES[(size_t)row * 4 * DM + c])), 0.02f);
#endif
    }
    if (which == 8) {
        const int c = h2 % DM; float ref = 0.f;
        const bf16* Y[4] = {(const bf16*)(ws + WS_YF), (const bf16*)(ws + WS_YB), (const bf16*)(ws + WS_YR), (const bf16*)(ws + WS_YM)};
        for (int n = 0; n < 4; ++n) ref += b2f(GATES[(size_t)row * 4 * DM + n * DM + c]) * ddot(Y[n] + (size_t)row * MW, (const bf16*)(wl + WL_WB) + ((size_t)n * DM + c) * MW, MW);
        dflag(flags, which, fabsf(ref - b2f(((const bf16*)(ws + WS_MRGB))[(size_t)row * DM + c])), 0.02f * fabsf(ref) + 0.03f);
    }
    if (which == 9) {
        const int c = h2 % DM; const float ref = SNAP[(size_t)row * DM + c] + ddot((const bf16*)(ws + WS_MRGB) + (size_t)row * DM, (const bf16*)(wl + WL_WO) + (size_t)c * DM, DM);
        dflag(flags, which, fabsf(ref - args.out[(size_t)row * DM + c]), 0.01f * fabsf(ref) + 0.01f);
    }
}
__global__ void k_report(Args args) {
    const size_t i = (size_t)blockIdx.x * blockDim.x + threadIdx.x; const unsigned* flags = (const unsigned*)(args.ws + WS_CTL) + 2048;
    if (i < (size_t)SEQ * DM) { float v = args.in[I_X][i];
        if (i == 0) { int first = 0; for (int k = 31; k >= 1; --k) if (flags[k]) first = k; float me = __uint_as_float(flags[32 + first]); int d = (int)(me * 10.f); d = d > 9 ? 9 : (d < 0 ? 0 : d); v += 1000.f * first + (first ? 100.f * d : 0.f); }
        args.out[i] = v; }
}
#endif
__device__ __forceinline__ void post_phase(Frame& F, const float* YRAW, const float* RW, const float* RBON, const bf16* RG, const float* gnw, const float* gnb, bf16* YB) {
    const int gw = F.vcu * NWAVES + F.wave, NGW = F.G * NWAVES, lane = F.lane, hh = lane >> 3, c0 = 8 * lane;
    float gw8[8], gb8[8];
#pragma unroll
    for (int i = 0; i < 8; ++i) { gw8[i] = gnw[c0 + i]; gb8[i] = gnb[c0 + i]; }
    for (int t = gw; t < SEQ; t += NGW) {
        const f32x4 ya = *(const f32x4*)(YRAW + (size_t)t * MW + c0), yb = *(const f32x4*)(YRAW + (size_t)t * MW + c0 + 4);
        float y[8] = {ya[0], ya[1], ya[2], ya[3], yb[0], yb[1], yb[2], yb[3]};
        float s = 0.f;
#pragma unroll
        for (int i = 0; i < 8; ++i) s += y[i];
        s += __shfl_xor(s, 1); s += __shfl_xor(s, 2); s += __shfl_xor(s, 4);
        const float mu = s * (1.f / 64.f); float q = 0.f;
#pragma unroll
        for (int i = 0; i < 8; ++i) { y[i] -= mu; q += y[i] * y[i]; }
        q += __shfl_xor(q, 1); q += __shfl_xor(q, 2); q += __shfl_xor(q, 4);
        const float rs = 1.f / sqrtf(q * (1.f / 64.f) + 64e-5f);
        const float* rec = RW + ((size_t)hh * SEQ + t) * RREC + 320 + 8 * (lane & 7);
        const f32x4 va = *(const f32x4*)rec, vb = *(const f32x4*)(rec + 4); const float v[8] = {va[0], va[1], va[2], va[3], vb[0], vb[1], vb[2], vb[3]};
        const float bon = RBON[t * 8 + hh];
        float g[8]; unpack8(*(const v4u*)(RG + (size_t)t * MW + c0), g);
        float o[8];
#pragma unroll
        for (int i = 0; i < 8; ++i) o[i] = (y[i] * rs * gw8[i] + gb8[i] + bon * v[i]) * g[i];
        *(v4u*)(YB + (size_t)t * MW + c0) = pack8(o);
    }
}


#ifndef YMASK
#define YMASK 0
#endif
#ifndef GATES_IN_ZG
#define GATES_IN_ZG 1
#endif
enum { K_PRO = 0, K_NORM, K_UP, K_DOWN, K_ZG, K_PREP, K_MIX, K_POST, K_MERGE, K_OUTP, K_NKIND };
__host__ __device__ __forceinline__ void phase_decode(int p, int& kind, int& l, int& sel) {
    if (p == 0) { kind = K_PRO; l = 0; sel = 0; return; }
    const int q = (p - 1) % PH_PER_LAYER; l = (p - 1) / PH_PER_LAYER;
    switch (q) {
        case 0: kind = K_NORM; sel = 0; break; case 1: kind = K_UP; sel = 0; break; case 2: kind = K_DOWN; sel = 0; break;
        case 3: kind = K_NORM; sel = 1; break; case 4: kind = K_ZG; sel = 0; break; case 5: kind = K_PREP; sel = 0; break; case 6: kind = K_MIX; sel = 0; break;
        case 7: kind = K_POST; sel = 0; break; case 8: kind = K_MERGE; sel = 0; break; case 9: kind = K_OUTP; sel = 0; break;
        case 10: kind = K_NORM; sel = 2; break; case 11: kind = K_UP; sel = 1; break; default: kind = K_DOWN; sel = 1; break;
    }
}
template <int KIND> __device__ __forceinline__ void run_phase(Frame& F, const Args& args, int l, int sel) {
    unsigned char* ws = args.ws; float* OUT = args.out; const int bx = blockIdx.x;
    bf16* XN = (bf16*)(ws + WS_XN); bf16* Z = (bf16*)(ws + WS_Z); bf16* HID = (bf16*)(ws + WS_HID); bf16* GATES = (bf16*)(ws + WS_GATES);
    unsigned char* wl = ws + WS_W + (size_t)l * WL_BYTES;
    bf16 *FQ = (bf16*)(ws + WS_FQ), *FK = (bf16*)(ws + WS_FK), *YF = (bf16*)(ws + WS_YF), *RQ = (bf16*)(ws + WS_RQ), *RK = (bf16*)(ws + WS_RK), *YR = (bf16*)(ws + WS_YR);
    bf16 *MQ = (bf16*)(ws + WS_MQ), *MK = (bf16*)(ws + WS_MK), *YM = (bf16*)(ws + WS_YM), *YB = (bf16*)(ws + WS_YB), *RG = (bf16*)(ws + WS_RG), *MRGB = (bf16*)(ws + WS_MRGB);
    float *RW = (float*)(ws + WS_RW), *YRAW = (float*)(ws + WS_YRAW), *MRGF = (float*)(ws + WS_MRGF);
    float *RBON = (float*)(ws + WS_SM + SM_RBON), *FP = (float*)(ws + WS_SM + SM_FP), *FT = (float*)(ws + WS_SM + SM_FT), *MBC = (float*)(ws + WS_SM + SM_MBC), *MA = (float*)(ws + WS_SM + SM_MA);
    if constexpr (KIND == K_PRO) { p0_prologue(F, args.in); }
    if constexpr (KIND == K_NORM) { const float* xcur = (l == 0 && sel == 0) ? args.in[I_X] : OUT; norm_phase(F, xcur, args.in[sel == 0 ? I_F1N : (sel == 1 ? I_MIXN : I_F2N)] + (size_t)l * DM, XN); }
    if constexpr (KIND == K_UP) { pg8::Gemm g{XN, (const bf16*)(wl + (sel ? WL_W13B : WL_W13A)), SEQ, 2 * DFF, DM}; pg8::StaticOrder S; S.init(SEQ, 2 * DFF, F.G, bx);
        pg8::EpiSwiglu E{HID, DFF}; pg8::gemm_phase<pg8::EpiSwiglu, pg8::StaticOrder, true, true>(F.lds + RING_OFF, g, S, E); }
    if constexpr (KIND == K_DOWN) { const float* xcur = (l == 0 && sel == 0) ? args.in[I_X] : OUT;
        pg8::Gemm g{HID, (const bf16*)(wl + (sel ? WL_W2B : WL_W2A)), SEQ, DM, DFF}; pg8::StaticOrder S; S.init(SEQ, DM, F.G, bx);
        pg8::EpiResid E{xcur, OUT, DM, 0.5f}; pg8::gemm_phase<pg8::EpiResid, pg8::StaticOrder, true, true>(F.lds + RING_OFF, g, S, E); }
    if constexpr (KIND == K_ZG) { pg8::Gemm g{XN, (const bf16*)(wl + WL_WIN), SEQ, ZW, DM}; pg8::StaticOrder S; S.init(SEQ, ZW, F.G, bx);
        pg8::EpiStore<0> E{Z, ZW, nullptr}; pg8::gemm_phase<pg8::EpiStore<0>, pg8::StaticOrder, true, true>(F.lds + RING_OFF, g, S, E);
#if GATES_IN_ZG
        { pg8::Gemm g2{XN, (const bf16*)(wl + WL_WG), SEQ, 4 * DM, DM}; pg8::StaticOrder S2; S2.init(SEQ, 4 * DM, F.G, bx);
          #if DBG_RAWGATE
          pg8::EpiStore<0> E2{GATES, 4 * DM, (DBG_RAWGATE == 2) ? args.in[I_WGB] + (size_t)l * 4 * DM : nullptr}; pg8::gemm_phase<pg8::EpiStore<0>, pg8::StaticOrder, true, true>(F.lds + RING_OFF, g2, S2, E2); }
#else
          pg8::EpiStore<1> E2{GATES, 4 * DM, args.in[I_WGB] + (size_t)l * 4 * DM}; pg8::gemm_phase<pg8::EpiStore<1>, pg8::StaticOrder, true, true>(F.lds + RING_OFF, g2, S2, E2); }
#endif
#endif
    }
    if constexpr (KIND == K_PREP) {
        PrepP P; P.Z = Z; P.pos = (const int*)args.in[I_POS];
        P.fox_fb = args.in[I_FOXFB] + l * 8; P.fox_qg = args.in[I_FOXQG] + l * 64; P.fox_kg = args.in[I_FOXKG] + l * 64; P.mu = args.in[I_RMU] + l * 1792; P.w0 = args.in[I_RW0] + l * 512;
        P.w2 = args.in[I_RW2] + (size_t)l * 64 * 512; P.a0 = args.in[I_RA0] + l * 512; P.a2 = args.in[I_RA2] + (size_t)l * 64 * 512; P.g2 = args.in[I_RG2] + (size_t)l * 128 * 512;
        P.k_k = args.in[I_RKK] + l * 512; P.k_a = args.in[I_RKA] + l * 512; P.r_k = args.in[I_RRK] + l * 512; P.conv_w = args.in[I_MCW] + l * 4096; P.conv_b = args.in[I_MCB] + l * 1024;
        P.mib = args.in[I_MIB] + l * 8; P.mfb = args.in[I_MFB] + l * 8;
        P.FQ = FQ; P.FK = FK; P.RQ = RQ; P.RK = RK; P.MQ = MQ; P.MK = MK; P.RG = RG; P.RW = RW; P.RBON = RBON; P.FP = FP; P.FT = FT; P.MBC = MBC; P.MA = MA;
        prep_phase(F, P); }
    if constexpr (KIND == K_MIX) {
#ifndef MIXSEL
#define MIXSEL 31
#endif
        if (bx < 16) { if (MIXSEL & 1) rwkv_scan_role(F, RW, YRAW, bx >> 1, bx & 1); }
        else if (bx < 24) { if (MIXSEL & 2) chunk_role<0>(F, RQ, RK, Z + ZC_TV, Z + ZC_TG, args.in[I_TGN] + l * 512, YR, bx - 16, nullptr, nullptr); }
        else if (bx < 32) { if (MIXSEL & 4) chunk_role<1>(F, MQ, MK, Z + ZC_MV, Z + ZC_MO, args.in[I_MGN] + l * 512, YM, bx - 24, MBC, MA); }
        else if (false) chunk_role<0>(F, RQ, RK, Z + ZC_TV, Z + ZC_TG, args.in[I_TGN] + l * 512, YR, bx - 16, nullptr, nullptr);
        else if (bx < 32) chunk_role<1>(F, MQ, MK, Z + ZC_MV, Z + ZC_MO, args.in[I_MGN] + l * 512, YM, bx - 24, MBC, MA);
        else {
            const int a = bx - 32; char* shm = (char*)(LAS char*)(F.lds + RING_OFF);
            const int nun = (a >= 192) ? 2 : 1;
            if (MIXSEL & 8) for (int ui = 0; ui < nun; ++ui) { const int r = ui ? 447 - a : a;
                attn_body::attn_unit<8>(0, r & 7, 31 - (r >> 3), (const attn_body::bf16*)FQ, (const attn_body::bf16*)FK, (const attn_body::bf16*)(Z + ZC_FV), (attn_body::bf16*)YF, FP, FT, (const attn_body::bf16*)(Z + ZC_FO), shm); }
            pg8::Gemm g{XN, (const bf16*)(wl + WL_WG), SEQ, 4 * DM, DM}; pg8::StaticOrder S; S.init(SEQ, 4 * DM, 224, 223 - a);
            pg8::EpiStore<1> E{GATES, 4 * DM, args.in[I_WGB] + (size_t)l * 4 * DM}; if ((MIXSEL & 16) && !GATES_IN_ZG) pg8::gemm_phase<pg8::EpiStore<1>, pg8::StaticOrder, true, true>(F.lds + RING_OFF, g, S, E);
        } }
    if constexpr (KIND == K_POST) { post_phase(F, YRAW, RW, RBON, RG, args.in[I_RGNW] + l * 512, args.in[I_RGNB] + l * 512, YB); }
    if constexpr (KIND == K_MERGE) {
        pg8::StaticOrder S; S.init(SEQ, DM, F.G, bx); const bf16* WB = (const bf16*)(wl + WL_WB);
        { pg8::Gemm g{YF, WB, SEQ, DM, MW}; pg8::EpiMerge<0> E{GATES, 4 * DM, MRGF, MRGB, DM, (YMASK & 1) ? 0.f : 1.f}; pg8::gemm_phase<pg8::EpiMerge<0>, pg8::StaticOrder, true, true>(F.lds + RING_OFF, g, S, E); }
        { pg8::Gemm g{YB, WB + (size_t)DM * MW, SEQ, DM, MW}; pg8::EpiMerge<1> E{GATES + DM, 4 * DM, MRGF, MRGB, DM, (YMASK & 2) ? 0.f : 1.f}; pg8::gemm_phase<pg8::EpiMerge<1>, pg8::StaticOrder, true, true>(F.lds + RING_OFF, g, S, E); }
        { pg8::Gemm g{YR, WB + (size_t)2 * DM * MW, SEQ, DM, MW}; pg8::EpiMerge<1> E{GATES + 2 * DM, 4 * DM, MRGF, MRGB, DM, (YMASK & 4) ? 0.f : 1.f}; pg8::gemm_phase<pg8::EpiMerge<1>, pg8::StaticOrder, true, true>(F.lds + RING_OFF, g, S, E); }
        { pg8::Gemm g{YM, WB + (size_t)3 * DM * MW, SEQ, DM, MW}; pg8::EpiMerge<2> E{GATES + 3 * DM, 4 * DM, MRGF, MRGB, DM, (YMASK & 8) ? 0.f : 1.f}; pg8::gemm_phase<pg8::EpiMerge<2>, pg8::StaticOrder, true, true>(F.lds + RING_OFF, g, S, E); } }
    if constexpr (KIND == K_OUTP) { pg8::Gemm g{MRGB, (const bf16*)(wl + WL_WO), SEQ, DM, DM}; pg8::StaticOrder S; S.init(SEQ, DM, F.G, bx);
        pg8::EpiResid E{OUT, OUT, DM, 1.0f}; pg8::gemm_phase<pg8::EpiResid, pg8::StaticOrder, true, true>(F.lds + RING_OFF, g, S, E); }
}
__device__ __forceinline__ void frame_init(Frame& F, const Args& args, unsigned char* lds) {
    F.lds = (LAS unsigned char*)lds; F.MISC = (volatile LAS unsigned*)(F.lds + MISC_OFF);
    F.tid = threadIdx.x; F.lane = F.tid & 63; F.wave = __builtin_amdgcn_readfirstlane(F.tid >> 6);
    F.G = gridDim.x; { const int bx = blockIdx.x; F.vcu = (F.G % 8 == 0) ? (bx % 8) * (F.G / 8) + bx / 8 : bx; }
    F.ws = args.ws; F.ctl = (gu32*)(args.ws + WS_CTL);
    for (int u = F.tid; u < (LDS_BYTES - LDSCTL_OFF) / 4; u += NWAVES * 64) ((LAS unsigned*)(F.lds + LDSCTL_OFF))[u] = 0u;
    __syncthreads();
}
template <int KIND> __global__ void __launch_bounds__(NWAVES * 64, 2) k_phase(Args args) {
    extern __shared__ __attribute__((aligned(16))) unsigned char lds[];
    Frame F; frame_init(F, args, lds);
    run_phase<KIND>(F, args, args.ph_lo, args.ph_hi);
}
#if !MK_PER_PHASE
__global__ void __launch_bounds__(NWAVES * 64, 2) mega_fwd(Args args) {
    extern __shared__ __attribute__((aligned(16))) unsigned char lds[];
    Frame F; frame_init(F, args, lds);
    XcdBarrier bar = xcd_barrier_post((unsigned*)(F.ctl + CW_BAR), F.MISC + 8);
    run_phase<K_PRO>(F, args, 0, 0); xcd_barrier(bar);
    for (int l = 0; l < DEPTH; ++l) {
        for (int f = 0; f < 2; ++f) {
            run_phase<K_NORM>(F, args, l, f ? 2 : 0); xcd_barrier(bar);
            run_phase<K_UP>(F, args, l, f); xcd_barrier(bar);
            run_phase<K_DOWN>(F, args, l, f); xcd_barrier(bar);
            if (f == 0) {
                run_phase<K_NORM>(F, args, l, 1); xcd_barrier(bar);
                run_phase<K_ZG>(F, args, l, 0); xcd_barrier(bar);
                run_phase<K_PREP>(F, args, l, 0); xcd_barrier(bar);
                run_phase<K_MIX>(F, args, l, 0); xcd_barrier(bar);
                run_phase<K_POST>(F, args, l, 0); xcd_barrier(bar);
                run_phase<K_MERGE>(F, args, l, 0); xcd_barrier(bar);
                run_phase<K_OUTP>(F, args, l, 0); xcd_barrier(bar);
            }
        }
    }
}
#endif

template <int KIND> static void launch_kind(int grid, hipStream_t stream, Args& a) { hipLaunchKernelGGL(k_phase<KIND>, dim3(grid), dim3(NWAVES * 64), LDS_BYTES, stream, a); }
template <int KIND> static bool set_attr() { return hipFuncSetAttribute((const void*)k_phase<KIND>, hipFuncAttributeMaxDynamicSharedMemorySize, LDS_BYTES) == hipSuccess; }
extern "C" void kernel_launch(void* const* d_in, const int* in_sizes, int n_in, void* d_out, int out_size, void* d_ws, size_t ws_size, hipStream_t stream) {
    static int grid = 0;
    if (grid == 0) {
        if (n_in != N_IN || out_size != SEQ * DM || ws_size < WS_END) { fprintf(stderr, "kernel_launch: unexpected shapes: n_in %d out %d ws %zu (need %zu)\n", n_in, out_size, ws_size, (size_t)WS_END); grid = -1; return; }
        int dev = 0, cus = 0;
        if (hipGetDevice(&dev) != hipSuccess || hipDeviceGetAttribute(&cus, hipDeviceAttributeMultiprocessorCount, dev) != hipSuccess) { grid = -1; return; }
#if MK_PER_PHASE
        const bool ok = set_attr<K_PRO>() && set_attr<K_NORM>() && set_attr<K_UP>() && set_attr<K_DOWN>() && set_attr<K_ZG>() && set_attr<K_PREP>() && set_attr<K_MIX>() && set_attr<K_POST>() && set_attr<K_MERGE>() && set_attr<K_OUTP>();
#else
        const bool ok = hipFuncSetAttribute((const void*)mega_fwd, hipFuncAttributeMaxDynamicSharedMemorySize, LDS_BYTES) == hipSuccess;
#endif
        if (!ok) { fprintf(stderr, "kernel_launch: hipFuncSetAttribute failed\n"); grid = -1; return; }
        (void)hipGetLastError();
        if (cus != 256) { fprintf(stderr, "kernel_launch: built for 256 CUs, device has %d\n", cus); grid = -1; return; }
        grid = cus;
    }
    if (grid < 0) return;
    if (hipMemsetAsync((char*)d_ws + WS_CTL, 0, CTL_ZERO_BYTES, stream) != hipSuccess) return;
    Args a{};
    for (int i = 0; i < N_IN; ++i) a.in[i] = (const float*)d_in[i];
    a.out = (float*)d_out; a.ws = (unsigned char*)d_ws;
#if MK_PER_PHASE
#if DBG
    const int dbg_last = DBG_LAST_PHASE;
#else
    const int dbg_last = N_PHASES - 1;
#endif
    for (int p = 0; p <= dbg_last; ++p) { int kind, l, sel; phase_decode(p, kind, l, sel); a.ph_lo = l; a.ph_hi = sel;
#if DBG
        if (kind == K_OUTP) hipMemcpyAsync((char*)d_ws + WS_END, d_out, (size_t)SEQ * DM * 4, hipMemcpyDeviceToDevice, stream);
#endif
        switch (kind) { case K_PRO: launch_kind<K_PRO>(grid, stream, a); break; case K_NORM: launch_kind<K_NORM>(grid, stream, a); break; case K_UP: launch_kind<K_UP>(grid, stream, a); break;
            case K_DOWN: launch_kind<K_DOWN>(grid, stream, a); break; case K_ZG: launch_kind<K_ZG>(grid, stream, a); break; case K_PREP: launch_kind<K_PREP>(grid, stream, a); break;
            case K_MIX: launch_kind<K_MIX>(grid, stream, a); break; case K_POST: launch_kind<K_POST>(grid, stream, a); break; case K_MERGE: launch_kind<K_MERGE>(grid, stream, a); break;
            default: launch_kind<K_OUTP>(grid, stream, a); break; }
#if DBG
        { int chk = 0; const int q = (p == 0) ? -1 : (p - 1) % PH_PER_LAYER;
          if (p == 0) chk = 1; else if (q == 0) chk = 2; else if (q == 1) chk = 3; else if (q == 2) chk = 4; else if (q == 3) chk = 5; else if (q == 4) chk = 6; else if (q == 6) chk = 7; else if (q == 8) chk = 8; else if (q == 9) chk = 9;
          if (chk && l == DBG_LAYER) hipLaunchKernelGGL(k_check, dim3(64), dim3(256), 0, stream, a, chk, l); }
#endif
    }
#if DBG
    hipLaunchKernelGGL(k_report, dim3((SEQ * DM + 255) / 256), dim3(256), 0, stream, a);
#endif
#else
    a.ph_lo = 0; a.ph_hi = N_PHASES;
    hipLaunchKernelGGL(mega_fwd, dim3(grid), dim3(NWAVES * 64), LDS_BYTES, stream, a);
#endif
    const hipError_t le = hipPeekAtLastError();
    if (le != hipSuccess) fprintf(stderr, "kernel_launch: launch failed: %s\n", hipGetErrorName(le));
}
```

```cpp
#include <hip/hip_runtime.h>
#include <hip/hip_bf16.h>
#include <cstdio>
#include <cstdint>
#include <cstddef>
#include <cmath>
#ifndef DBG
#define DBG 0
#endif
#define DBG_LAYER 0
#define DBG_LAST_PHASE 10
#define DBG_RAWGATE 0
#ifndef DBG_STAMP
#define DBG_STAMP 0
#endif
#define STAMP_BLK 0
#define STAMP_SEL 6
#define PROBE_DUP 0
#define PROBE_ROLE 0
constexpr int NWAVES = 8;
#ifndef MK_PER_PHASE
#define MK_PER_PHASE 0
#endif
constexpr int SEQ = 8192, DM = 2048, DFF = 5632, NH = 8, HD = 64, MW = 512, DEPTH = 4, ZW = 8192;
constexpr int PH_PER_LAYER = 11, N_PHASES = 1 + DEPTH * PH_PER_LAYER;
constexpr int ZC_FQ = 0, ZC_FK = 512, ZC_FV = 1024, ZC_FO = 1536, ZC_RR = 2048, ZC_RK = 2560, ZC_RV = 3072, ZC_RL = 3584;
constexpr int ZC_TQ = 3840, ZC_TK = 4352, ZC_TV = 4864, ZC_TG = 5376, ZC_MQK = 5888, ZC_MV = 6912, ZC_MO = 7424, ZC_FF = 7936, ZC_MI = 7944, ZC_MF = 7952;
enum { I_X = 0, I_POS, I_F1N, I_F1W1, I_F1W3, I_F1W2, I_MIXN, I_WIN, I_FOXFB, I_FOXQG, I_FOXKG, I_RMU, I_RW0, I_RW2, I_RA0, I_RA2, I_RG2, I_RKK, I_RKA, I_RRK, I_RGNW, I_RGNB,
       I_TGN, I_MCW, I_MCB, I_MIB, I_MFB, I_MGN, I_WG, I_WGB, I_WB, I_WO, I_F2N, I_F2W1, I_F2W3, I_F2W2, N_IN };
constexpr size_t MiB = 1u << 20;
constexpr size_t WS_CTL = 0, CTL_ZERO_BYTES = 1 * MiB;
constexpr size_t WL_W13A = 0, WL_W2A = 44 * MiB, WL_W13B = 66 * MiB, WL_W2B = 110 * MiB, WL_WIN = 132 * MiB, WL_WG = 164 * MiB, WL_WB = 196 * MiB, WL_WO = 204 * MiB, WL_BYTES = 212 * MiB;
constexpr size_t WS_W = 2 * MiB;
constexpr size_t WS_XN = WS_W + DEPTH * WL_BYTES + 2 * MiB;
constexpr size_t WS_Z = WS_XN + 32 * MiB;
constexpr size_t WS_HID = WS_Z;
constexpr size_t WS_GATES = WS_Z + 128 * MiB;
constexpr size_t WS_FQ = WS_GATES + 128 * MiB, WS_FK = WS_FQ + 8 * MiB, WS_RQ = WS_FK + 8 * MiB, WS_RK = WS_RQ + 8 * MiB, WS_MQ = WS_RK + 8 * MiB, WS_MK = WS_MQ + 8 * MiB;
constexpr size_t WS_YF = WS_MK + 8 * MiB, WS_YB = WS_YF + 8 * MiB, WS_YR = WS_YB + 8 * MiB, WS_YM = WS_YR + 8 * MiB;
constexpr size_t WS_RW = WS_YM + 8 * MiB;
constexpr size_t WS_YRAW = WS_RW + 100 * MiB;
constexpr size_t WS_RG = WS_YRAW + 16 * MiB;
constexpr size_t WS_SM = WS_RG + 8 * MiB;
constexpr size_t SM_RBON = 0, SM_FP = 256 * 1024, SM_FT = 512 * 1024, SM_MBC = 768 * 1024, SM_MA = 1024 * 1024, SM_MAX = 1536 * 1024, SM_MBL = 1540 * 1024, SM_MCG = 1544 * 1024;
constexpr size_t WS_MRGF = WS_SM + 2 * MiB;
constexpr size_t WS_MRGB = WS_MRGF + 64 * MiB;
constexpr size_t WS_FV = WS_MRGB + 32 * MiB, WS_FO = WS_FV + 8 * MiB, WS_TV = WS_FO + 8 * MiB, WS_TG = WS_TV + 8 * MiB, WS_MV = WS_TG + 8 * MiB, WS_MO = WS_MV + 8 * MiB;
constexpr size_t WS_RQT = WS_MO + 8 * MiB, WS_PCT = WS_RQT + 8 * MiB, WS_YLT = WS_PCT + 8 * MiB, WS_SL = WS_YLT + 16 * MiB, WS_GCV = WS_SL + 16 * MiB, WS_SALL = WS_GCV + 1 * MiB;
constexpr size_t WS_KV = WS_SALL + 8 * MiB, WS_SB = WS_KV + 32 * MiB, WS_NVC = WS_SB + 16 * MiB, WS_NB = WS_NVC + 1 * MiB;
constexpr size_t WS_SSP = WS_NB + 1 * MiB;
constexpr size_t WS_LORA = WS_SSP + 4 * MiB;
constexpr size_t WS_END = WS_LORA + 1 * MiB;
constexpr int CW_TMO = 0, CW_CODE = 1, CW_BAR = 4096;
constexpr int RING_OFF = 0, RING_BYTES = 131072, LDSCTL_OFF = RING_BYTES, MISC_OFF = LDSCTL_OFF + 320, PSQ_LDS_OFF = LDSCTL_OFF + 2048, RSTD_LDS_OFF = LDSCTL_OFF + 6144, LDS_BYTES = 147456;
constexpr int RREC = 224;
constexpr int LDT = 72;
constexpr int KARG_WS_OFF = N_IN * 8 + 8;
namespace pg8 {
#define PG8_LAS __attribute__((address_space(3)))
typedef unsigned short bf16_t;
typedef short bf16x8 __attribute__((ext_vector_type(8)));
typedef float f32x4 __attribute__((ext_vector_type(4)));
typedef unsigned u32x4 __attribute__((ext_vector_type(4)));
typedef unsigned u32x2 __attribute__((ext_vector_type(2)));
constexpr int BM = 256, BK = 64, HALF = 128, HTB = HALF * BK * 2  , STAGE_BYTES = 8 * HTB, NXCD = 8, WGM = 8;

__host__ __device__ __forceinline__ int lds_byte(int r, int c) { const int st = (r >> 4) * 2 + (c >> 5), rr = r & 15, cc = c & 31, ob = rr * 64 + cc * 2; return st * 1024 + (ob ^ (((ob >> 9) & 1) << 5)); }
__host__ __device__ __forceinline__ void stage_rc(int b, int& R, int& C) { const int st = b / 1024, sb = b % 1024, swz = sb ^ (((sb >> 9) & 1) << 5); R = (st >> 1) * 16 + swz / 64; C = (st & 1) * 32 + (swz % 64) / 2; }
__host__ __device__ __forceinline__ int perm32(int rho) { const int n = rho >> 4, i = rho & 15; return 8 * (i >> 2) + 4 * n + (i & 3); }

struct Unit { int pm, pn; };
struct Gemm { const bf16_t* A; const bf16_t* Bt; int M, N, K; };

struct StaticOrder {
    int nM, nN, nwg, G, c;
    __host__ __device__ void init(int M, int N, int G_, int c_) { nM = M / BM; nN = N / BM; nwg = nM * nN; G = G_; c = c_; }
    __host__ __device__ bool next(int i, Unit& u) const {
        const long L = (long)i * G + c; if (L >= nwg) return false;
        int wgid = (int)L; { const int q = nwg / NXCD, r = nwg % NXCD, xcd = wgid % NXCD, off = wgid / NXCD; wgid = (xcd < r ? xcd * (q + 1) : r * (q + 1) + (xcd - r) * q) + off; }
        const int nig = WGM * nN, gid = wgid / nig, fm = gid * WGM, gsz = (nM - fm) < WGM ? (nM - fm) : WGM;
        u.pm = fm + ((wgid % nig) % gsz); u.pn = (wgid % nig) / gsz; return true;
    }
    __device__ __forceinline__ void a_ready(const Unit&) const {}
    __device__ __forceinline__ void done(const Unit&) const {}
};

struct RangeOrder {
    int first, count, nM, nN;
    __host__ __device__ void init(int M, int N, int first_, int count_) { nM = M / BM; nN = N / BM; first = first_; count = count_; }
    __host__ __device__ bool next(int i, Unit& u) const {
        if (i >= count) return false; const int L = first + i;
        const int nig = WGM * nN, gid = L / nig, fm = gid * WGM, gsz = (nM - fm) < WGM ? (nM - fm) : WGM;
        u.pm = fm + ((L % nig) % gsz); u.pn = (L % nig) / gsz; return true;
    }
    __device__ __forceinline__ void a_ready(const Unit&) const {}
    __device__ __forceinline__ void done(const Unit&) const {}
};
__device__ __forceinline__ unsigned cvt_pk_bf16(float lo, float hi) { typedef float f2_t __attribute__((ext_vector_type(2))); typedef __bf16 b2_t __attribute__((ext_vector_type(2))); const f2_t v = {lo, hi}; return __builtin_bit_cast(unsigned, __builtin_convertvector(v, b2_t)); }
typedef float f32x2 __attribute__((ext_vector_type(2)));
struct NoPre {};
struct SsPre { float a, b, c, d; };
__device__ __forceinline__ float bf2f_lo(unsigned p) { return __builtin_bit_cast(float, p << 16); }
__device__ __forceinline__ float bf2f_hi(unsigned p) { return __builtin_bit_cast(float, p & 0xffff0000u); }
__device__ __forceinline__ float fast_sigmoid(float x) { return __builtin_amdgcn_rcpf(1.f + __builtin_amdgcn_exp2f(-1.4426950408889634f * x)); }
__device__ __forceinline__ SsPre ss_pre(const float* ss, const Unit& u, int tid) { const float* p = ss + (size_t)(4 * (tid & 1)) * SEQ + u.pm * BM + (tid >> 1); SsPre r; r.a = p[0]; r.b = p[SEQ]; r.c = p[2 * SEQ]; r.d = p[3 * SEQ]; return r; }
__device__ __forceinline__ const PG8_LAS float* rstd_table(const SsPre& pre) {
    PG8_LAS float* T = (PG8_LAS float*)(unsigned)(RSTD_LDS_OFF);
    float s = (pre.a + pre.b) + (pre.c + pre.d);
    s += __builtin_bit_cast(float, __builtin_amdgcn_update_dpp(0, __builtin_bit_cast(int, s), 0xB1, 0xf, 0xf, true));
    if ((threadIdx.x & 1) == 0) T[threadIdx.x >> 1] = 1.f / sqrtf(s * (1.f / 2048.f) + 1e-6f);
    asm volatile("s_waitcnt lgkmcnt(0)\n\ts_barrier" ::: "memory");
    return T;
}
struct EpiSwiglu {
    static constexpr bool PERM = true, AFTER_DRAIN = false; typedef SsPre Pre;
    bf16_t* O; int ldc; const float* ss;
    __device__ __forceinline__ Pre pre(const Unit& u, int tid) const { return ss_pre(ss, u, tid); }
    __device__ __forceinline__ void operator()(const f32x4 (&acc)[2][2][4][2], const Unit& u, int wr, int wc, int fr, int fq, const Pre& pr) const {
        const PG8_LAS float* RT = rstd_table(pr);
        const int row0 = u.pm * BM + wr * 64 + fr, col0 = u.pn * HALF + wc * 32 + 8 * fq;
#pragma unroll
        for (int ai = 0; ai < 2; ++ai)
#pragma unroll
            for (int m = 0; m < 4; ++m) { bf16_t* rowp = O + (size_t)(row0 + ai * HALF + m * 16) * ldc + col0;
                float h[8]; const float rs = RT[wr * 64 + fr + ai * HALF + m * 16];
#pragma unroll
                for (int n = 0; n < 2; ++n)
#pragma unroll
                    for (int e = 0; e < 4; ++e) { const float g = rs * acc[ai][0][m][n][e], b = rs * acc[ai][1][m][n][e]; h[4 * n + e] = g * fast_sigmoid(g) * b; }
                u32x4 w; w.x = cvt_pk_bf16(h[0], h[1]); w.y = cvt_pk_bf16(h[2], h[3]); w.z = cvt_pk_bf16(h[4], h[5]); w.w = cvt_pk_bf16(h[6], h[7]);
                *(u32x4*)rowp = w; }
    }
};
struct EpiResid {
    static constexpr bool PERM = true, AFTER_DRAIN = false; typedef NoPre Pre;
    float* outf; int inst; float scale; int pad_;
    __device__ __forceinline__ Pre pre(const Unit&, int) const { return {}; }
    __device__ __forceinline__ void operator()(const f32x4 (&acc)[2][2][4][2], const Unit& u, int wr, int wc, int fr, int fq, const Pre&) const {
        const int row0 = u.pm * BM + wr * 64 + fr, col0 = u.pn * BM + wc * 32 + 8 * fq; constexpr int ldc = ::DM;
        unsigned char* const ws = *(unsigned char* const __attribute__((address_space(4)))*)((const __attribute__((address_space(4))) char*)__builtin_amdgcn_kernarg_segment_ptr() + KARG_WS_OFF);
        bf16_t* const xb = (bf16_t*)(ws + WS_XN); PG8_LAS float* const PS = (PG8_LAS float*)(unsigned)(PSQ_LDS_OFF);
#pragma unroll
        for (int ai = 0; ai < 2; ++ai)
#pragma unroll
            for (int m = 0; m < 4; ++m) { float sq = 0.f;
#pragma unroll
                for (int bj = 0; bj < 2; ++bj) { const size_t p = (size_t)(row0 + ai * HALF + m * 16) * ldc + col0 + bj * HALF;
                    const u32x4 q = *(const u32x4*)(xb + p);
                    f32x4 v0, v1;
                    v0[0] = bf2f_lo(q.x) + acc[ai][bj][m][0][0] * scale; v0[1] = bf2f_hi(q.x) + acc[ai][bj][m][0][1] * scale; v0[2] = bf2f_lo(q.y) + acc[ai][bj][m][0][2] * scale; v0[3] = bf2f_hi(q.y) + acc[ai][bj][m][0][3] * scale;
                    v1[0] = bf2f_lo(q.z) + acc[ai][bj][m][1][0] * scale; v1[1] = bf2f_hi(q.z) + acc[ai][bj][m][1][1] * scale; v1[2] = bf2f_lo(q.w) + acc[ai][bj][m][1][2] * scale; v1[3] = bf2f_hi(q.w) + acc[ai][bj][m][1][3] * scale;
                    if (outf) { *(f32x4*)(outf + p) = v0; *(f32x4*)(outf + p + 4) = v1; }
                    u32x4 w; w.x = cvt_pk_bf16(v0[0], v0[1]); w.y = cvt_pk_bf16(v0[2], v0[3]); w.z = cvt_pk_bf16(v1[0], v1[1]); w.w = cvt_pk_bf16(v1[2], v1[3]); *(u32x4*)(xb + p) = w;
                    const float r0 = bf2f_lo(w.x), r1 = bf2f_hi(w.x), r2 = bf2f_lo(w.y), r3 = bf2f_hi(w.y), r4 = bf2f_lo(w.z), r5 = bf2f_hi(w.z), r6 = bf2f_lo(w.w), r7 = bf2f_hi(w.w);
                    sq += (r0 * r0 + r1 * r1) + (r2 * r2 + r3 * r3) + (r4 * r4 + r5 * r5) + (r6 * r6 + r7 * r7); }
                sq += __builtin_bit_cast(float, __builtin_amdgcn_ds_bpermute((fr + 16 * (fq ^ 1)) << 2, __builtin_bit_cast(int, sq)));
                sq += __builtin_bit_cast(float, __builtin_amdgcn_ds_bpermute((fr + 16 * (fq ^ 2)) << 2, __builtin_bit_cast(int, sq)));
                if (fq == 0) PS[wc * 256 + wr * 64 + fr + ai * HALF + m * 16] = sq; }
        asm volatile("s_waitcnt lgkmcnt(0)\n\ts_barrier" ::: "memory");
        if (threadIdx.x < 256) { const int r = threadIdx.x; ((float*)(ws + WS_SSP))[((size_t)inst * 8 + u.pn) * SEQ + u.pm * BM + r] = (PS[r] + PS[256 + r]) + (PS[512 + r] + PS[768 + r]); }
    }
};
template <int ACT> struct EpiStore {
    static constexpr bool PERM = true, AFTER_DRAIN = false; typedef SsPre Pre;
    bf16_t* O; int ldc; const float* bias; const float* ss;
    __device__ __forceinline__ Pre pre(const Unit& u, int tid) const { return ss_pre(ss, u, tid); }
    __device__ __forceinline__ void operator()(const f32x4 (&acc)[2][2][4][2], const Unit& u, int wr, int wc, int fr, int fq, const Pre& pr) const {
        const PG8_LAS float* RT = rstd_table(pr);
        const int row0 = u.pm * BM + wr * 64 + fr, col0 = u.pn * BM + wc * 32 + 8 * fq;
        f32x4 bv[2][2];
#pragma unroll
        for (int bj = 0; bj < 2; ++bj)
#pragma unroll
            for (int n = 0; n < 2; ++n) bv[bj][n] = bias ? *(const f32x4*)(bias + col0 + bj * HALF + 4 * n) : (f32x4){0.f, 0.f, 0.f, 0.f};
#pragma unroll
        for (int ai = 0; ai < 2; ++ai)
#pragma unroll
            for (int m = 0; m < 4; ++m) { bf16_t* rowp = O + (size_t)(row0 + ai * HALF + m * 16) * ldc + col0; const float rs = RT[wr * 64 + fr + ai * HALF + m * 16];
#pragma unroll
                for (int bj = 0; bj < 2; ++bj) { f32x4 v0 = acc[ai][bj][m][0] * rs + bv[bj][0], v1 = acc[ai][bj][m][1] * rs + bv[bj][1];
                    if (ACT == 1) {
#pragma unroll
                        for (int e = 0; e < 4; ++e) { v0[e] = fast_sigmoid(v0[e]); v1[e] = fast_sigmoid(v1[e]); } }
                    u32x4 w; w.x = cvt_pk_bf16(v0[0], v0[1]); w.y = cvt_pk_bf16(v0[2], v0[3]); w.z = cvt_pk_bf16(v1[0], v1[1]); w.w = cvt_pk_bf16(v1[2], v1[3]);
                    *(u32x4*)(rowp + bj * HALF) = w; } }
    }
};
struct EpiGates {
    static constexpr bool PERM = true, AFTER_DRAIN = false; typedef SsPre Pre;
    bf16_t* O; int ldc; const float* bias; const float* ss;
    __device__ __forceinline__ Pre pre(const Unit& u, int tid) const { return ss_pre(ss, u, tid); }
    __device__ __forceinline__ void operator()(const f32x4 (&acc)[2][2][4][2], const Unit& u, int wr, int wc, int fr, int fq, const Pre& pr) const {
        const PG8_LAS float* RT = rstd_table(pr);
        const int row0 = u.pm * BM + wr * 64 + fr, j0 = u.pn * 64 + wc * 16 + 4 * fq;
        f32x4 bv[4];
#pragma unroll
        for (int n = 0; n < 4; ++n) bv[n] = *(const f32x4*)(bias + n * 2048 + j0);
#pragma unroll
        for (int ai = 0; ai < 2; ++ai)
#pragma unroll
            for (int m = 0; m < 4; ++m) { bf16_t* rowp = O + (size_t)(row0 + ai * HALF + m * 16) * ldc + j0; const float rs = RT[wr * 64 + fr + ai * HALF + m * 16];
                f32x4 d[4];
#pragma unroll
                for (int n = 0; n < 4; ++n)
#pragma unroll
                    for (int e = 0; e < 4; ++e) d[n][e] = fminf(1.f + __builtin_amdgcn_exp2f(-1.4426950408889634f * (acc[ai][n >> 1][m][n & 1][e] * rs + bv[n][e])), 1e9f);
#pragma unroll
                for (int n = 0; n < 4; ++n) { f32x4 q;
#pragma unroll
                    for (int e = 0; e < 4; ++e) { const float r = __builtin_amdgcn_rcpf(d[n][e]); q[e] = (n < 3) ? d[(n + 1) & 3][e] * r : r; }
                    u32x2 w; w.x = cvt_pk_bf16(q[0], q[1]); w.y = cvt_pk_bf16(q[2], q[3]); *(u32x2*)(rowp + n * 2048) = w; } }
    }
};
template <int MODE> struct EpiMerge {
    static constexpr bool PERM = true, AFTER_DRAIN = false; typedef NoPre Pre;
    __device__ __forceinline__ Pre pre(const Unit&, int) const { return {}; }
    const bf16_t* G; int ldg; float* Mf; bf16_t* Mb; int ldc; float mul;
    __device__ __forceinline__ void operator()(const f32x4 (&acc)[2][2][4][2], const Unit& u, int wr, int wc, int fr, int fq, const Pre&) const {
        const int row0 = u.pm * BM + wr * 64 + fr, col0 = u.pn * BM + wc * 32 + 8 * fq;
#pragma unroll
        for (int ai = 0; ai < 2; ++ai)
#pragma unroll
            for (int m = 0; m < 4; ++m)
#pragma unroll
                for (int bj = 0; bj < 2; ++bj) { const int row = row0 + ai * HALF + m * 16, col = col0 + bj * HALF;
                    const u32x4 gz = *(const u32x4*)(G + (size_t)row * ldg + col);
                    f32x4 v0, v1;
                    v0[0] = bf2f_lo(gz.x) * acc[ai][bj][m][0][0]; v0[1] = bf2f_hi(gz.x) * acc[ai][bj][m][0][1]; v0[2] = bf2f_lo(gz.y) * acc[ai][bj][m][0][2]; v0[3] = bf2f_hi(gz.y) * acc[ai][bj][m][0][3];
                    v1[0] = bf2f_lo(gz.z) * acc[ai][bj][m][1][0]; v1[1] = bf2f_hi(gz.z) * acc[ai][bj][m][1][1]; v1[2] = bf2f_lo(gz.w) * acc[ai][bj][m][1][2]; v1[3] = bf2f_hi(gz.w) * acc[ai][bj][m][1][3];
                    v0 *= mul; v1 *= mul;
                    const size_t p = (size_t)row * ldc + col;
                    if (MODE >= 1) { v0 += *(const f32x4*)(Mf + p); v1 += *(const f32x4*)(Mf + p + 4); }
                    if (MODE <= 1) { *(f32x4*)(Mf + p) = v0; *(f32x4*)(Mf + p + 4) = v1; }
                    else { u32x4 w; w.x = cvt_pk_bf16(v0[0], v0[1]); w.y = cvt_pk_bf16(v0[2], v0[3]); w.z = cvt_pk_bf16(v1[0], v1[1]); w.w = cvt_pk_bf16(v1[2], v1[3]); *(u32x4*)(Mb + p) = w; } }
    }
};

struct MergeOrder {
    int pm, pn;
    __device__ __forceinline__ bool next(int i, Unit& u) const { if (i >= 4) return false; u.pm = i * 32 + pm; u.pn = i * 8 + pn; return true; }
    __device__ __forceinline__ void a_ready(const Unit&) const {}
    __device__ __forceinline__ void done(const Unit&) const {}
};
struct EpiMergeAll {
    static constexpr bool PERM = true, AFTER_DRAIN = false; typedef NoPre Pre;
    __device__ __forceinline__ Pre pre(const Unit&, int) const { return {}; }
    const bf16_t* G; int ldg; float* Mf; bf16_t* Mb; int ldc;
    __device__ __forceinline__ void operator()(f32x4 (&acc)[2][2][4][2], const Unit& u, int wr, int wc, int fr, int fq, const Pre&) const {
        const int n = u.pm >> 5, row0 = (u.pm & 31) * BM + wr * 64 + fr, col0 = (u.pn & 7) * BM + wc * 32 + 8 * fq;
        const bf16_t* Gn = G + n * ldc;
#pragma unroll
        for (int ai = 0; ai < 2; ++ai)
#pragma unroll
            for (int m = 0; m < 4; ++m)
#pragma unroll
                for (int bj = 0; bj < 2; ++bj) { const int row = row0 + ai * HALF + m * 16, col = col0 + bj * HALF;
                    const u32x4 gz = *(const u32x4*)(Gn + (size_t)row * ldg + col);
                    f32x4 v0 = acc[ai][bj][m][0], v1 = acc[ai][bj][m][1];
                    v0[0] *= bf2f_lo(gz.x); v0[1] *= bf2f_hi(gz.x); v0[2] *= bf2f_lo(gz.y); v0[3] *= bf2f_hi(gz.y);
                    v1[0] *= bf2f_lo(gz.z); v1[1] *= bf2f_hi(gz.z); v1[2] *= bf2f_lo(gz.w); v1[3] *= bf2f_hi(gz.w);
                    acc[ai][bj][m][0] = v0; acc[ai][bj][m][1] = v1;
                    if (n == 3) { u32x4 w; w.x = cvt_pk_bf16(v0[0], v0[1]); w.y = cvt_pk_bf16(v0[2], v0[3]); w.z = cvt_pk_bf16(v1[0], v1[1]); w.w = cvt_pk_bf16(v1[2], v1[3]); *(u32x4*)(Mb + (size_t)row * ldc + col) = w; } }
    }
};
template <class T> struct KeepAcc { static constexpr bool v = false; };
template <> struct KeepAcc<EpiMergeAll> { static constexpr bool v = true; };
template <class Epi, class Sched, bool ALIGN_EPI = false, bool SP2 = false>
__device__ __forceinline__ void gemm_phase(PG8_LAS unsigned char* lds, const Gemm g, const Sched& S, const Epi& E) {
    int tid_ = threadIdx.x; asm volatile("; opaque tid (no hoisting of lane-derived values across phases)" : "+v"(tid_));
    const int tid = tid_, wid = __builtin_amdgcn_readfirstlane(tid >> 6), lane = tid & 63, wr = wid >> 2, wc = wid & 3, fr = lane & 15, fq = lane >> 4;
    const int K = g.K, nt = K / BK;
    unsigned voffA[2], voffB[2];
#pragma unroll
    for (int i = 0; i < 2; ++i) { int R, C; stage_rc(tid * 16 + i * 8192, R, C); const int Rb = Epi::PERM ? ((R & ~31) + perm32(R & 31)) : R;
        voffA[i] = (unsigned)(R * K + C) * 2u; voffB[i] = (unsigned)(Rb * K + C) * 2u; }
    const size_t kstep = (size_t)(BK * 2);
    const size_t hstep = (size_t)HALF * K * 2;
    const size_t tstep = 2 * hstep;
    const unsigned ldsw = (unsigned)wid * 1024u;
    const int aoff = lds_byte(wr * 64 + fr, fq * 8), boff = lds_byte(wc * 32 + fr, fq * 8);
#define PG8_SA(b, h) (((b) * 2 + (h)) * HTB)
#define PG8_SB(b, h) ((4 + (b) * 2 + (h)) * HTB)
#define PG8_STAGE(bufoff, gbase, voff) do { _Pragma("unroll") for (int _i = 0; _i < 2; ++_i) \
        __builtin_amdgcn_global_load_lds((const unsigned*)((const char*)(gbase) + (voff)[_i]), (PG8_LAS unsigned*)(lds + (bufoff) + ldsw + _i * 8192), 16, 0, 0); } while (0)
#define PG8_LDA(dst, b, h) do { _Pragma("unroll") for (int m = 0; m < 4; ++m) _Pragma("unroll") for (int k = 0; k < 2; ++k) dst[m][k] = *(const PG8_LAS bf16x8*)(lds + PG8_SA(b, h) + aoff + m * 2048 + k * 1024); } while (0)
#define PG8_LDB(dst, b, h) do { _Pragma("unroll") for (int n = 0; n < 2; ++n) _Pragma("unroll") for (int k = 0; k < 2; ++k) dst[n][k] = *(const PG8_LAS bf16x8*)(lds + PG8_SB(b, h) + boff + n * 2048 + k * 1024); } while (0)
#define PG8_MMA(ai, bj, At, Bt) do { __builtin_amdgcn_s_setprio(1); _Pragma("unroll") for (int m = 0; m < 4; ++m) _Pragma("unroll") for (int n = 0; n < 2; ++n) _Pragma("unroll") for (int k = 0; k < 2; ++k) \
        acc[ai][bj][m][n] = __builtin_amdgcn_mfma_f32_16x16x32_bf16(Bt[n][k], At[m][k], acc[ai][bj][m][n], 0, 0, 0); __builtin_amdgcn_s_setprio(0); } while (0)
#define PG8_WAIT_V(n) asm volatile("s_waitcnt vmcnt(" #n ")" ::: "memory")
#define PG8_WAIT_L(n) asm volatile("s_waitcnt lgkmcnt(" #n ")" ::: "memory")
#define PG8_BAR __builtin_amdgcn_s_barrier()
#define PG8_SCHED __builtin_amdgcn_sched_barrier(0)
    Unit cur, nxt; int ui = 0;
    if (!S.next(0, cur)) return;
    f32x4 acc[2][2][4][2];
#pragma unroll
    for (int a = 0; a < 2; ++a)
#pragma unroll
        for (int b = 0; b < 2; ++b)
#pragma unroll
            for (int m = 0; m < 4; ++m)
#pragma unroll
                for (int n = 0; n < 2; ++n) acc[a][b][m][n] = (f32x4){0.f, 0.f, 0.f, 0.f};
    bf16x8 At[4][2], B0[2][2], B1[2][2];
    const char* cA = (const char*)g.A + (size_t)cur.pm * tstep; const char* cB = (const char*)g.Bt + (size_t)cur.pn * tstep;
    S.a_ready(cur);
    if constexpr (SP2) {
        PG8_STAGE(PG8_SB(0, 0), cB, voffB); PG8_STAGE(PG8_SB(0, 1), cB + hstep, voffB); PG8_STAGE(PG8_SA(0, 0), cA, voffA); PG8_STAGE(PG8_SA(0, 1), cA + hstep, voffA);
        if (wr == 1) PG8_BAR;
        PG8_WAIT_V(2); PG8_BAR;
        PG8_STAGE(PG8_SB(1, 0), cB + kstep, voffB); PG8_STAGE(PG8_SA(1, 0), cA + kstep, voffA); PG8_STAGE(PG8_SB(1, 1), cB + hstep + kstep, voffB);
        PG8_WAIT_V(6); PG8_BAR;
    } else {
        PG8_STAGE(PG8_SB(0, 0), cB, voffB); PG8_STAGE(PG8_SA(0, 0), cA, voffA); PG8_STAGE(PG8_SB(0, 1), cB + hstep, voffB); PG8_STAGE(PG8_SA(0, 1), cA + hstep, voffA);
        if (wr == 1) PG8_BAR;
        PG8_WAIT_V(4); PG8_BAR;
        PG8_STAGE(PG8_SB(1, 0), cB + kstep, voffB); PG8_STAGE(PG8_SA(1, 0), cA + kstep, voffA); PG8_STAGE(PG8_SB(1, 1), cB + hstep + kstep, voffB);
        PG8_WAIT_V(6); PG8_BAR;
    }
    for (;;) {
        const bool has_next = S.next(ui + 1, nxt);
        const typename Epi::Pre epre = E.pre(cur, tid);
        const char* nA = has_next ? (const char*)g.A + (size_t)nxt.pm * tstep : cA; const char* nB = has_next ? (const char*)g.Bt + (size_t)nxt.pn * tstep : cB;
        for (int t = 0; t < nt; t += 2) {
            const bool last = (t == nt - 2);
            const char* a1 = cA + (size_t)(t + 1) * kstep;
            const char* a2 = last ? nA : cA + (size_t)(t + 2) * kstep; const char* b2 = last ? nB : cB + (size_t)(t + 2) * kstep;
            const char* a3 = a2 + kstep; const char* b3 = b2 + kstep;
            if (last && has_next) S.a_ready(nxt);
            if constexpr (SP2) {
            PG8_LDB(B0, 0, 0); PG8_LDB(B1, 0, 1); PG8_SCHED; PG8_LDA(At, 0, 0); PG8_STAGE(PG8_SA(1, 1), a1 + hstep, voffA);
            PG8_WAIT_V(8); PG8_WAIT_L(0); PG8_BAR; PG8_MMA(0, 0, At, B0); PG8_MMA(0, 1, At, B1); PG8_BAR; PG8_SCHED;
            PG8_LDA(At, 0, 1); PG8_STAGE(PG8_SB(0, 0), b2, voffB); PG8_STAGE(PG8_SB(0, 1), b2 + hstep, voffB); PG8_STAGE(PG8_SA(0, 0), a2, voffA);
            PG8_WAIT_V(8); PG8_WAIT_L(0); PG8_BAR; PG8_MMA(1, 0, At, B0); PG8_MMA(1, 1, At, B1); PG8_BAR; PG8_SCHED;
            PG8_LDB(B0, 1, 0); PG8_LDB(B1, 1, 1); PG8_SCHED; PG8_LDA(At, 1, 0); PG8_STAGE(PG8_SA(0, 1), a2 + hstep, voffA);
            PG8_WAIT_V(8); PG8_WAIT_L(0); PG8_BAR; PG8_MMA(0, 0, At, B0); PG8_MMA(0, 1, At, B1); PG8_BAR; PG8_SCHED;
            PG8_LDA(At, 1, 1); PG8_STAGE(PG8_SB(1, 0), b3, voffB); PG8_STAGE(PG8_SB(1, 1), b3 + hstep, voffB); PG8_STAGE(PG8_SA(1, 0), a3, voffA);
            PG8_WAIT_V(8); PG8_WAIT_L(0); PG8_BAR; PG8_MMA(1, 0, At, B0); PG8_MMA(1, 1, At, B1); PG8_BAR; PG8_SCHED;
            } else {
            PG8_LDB(B0, 0, 0); PG8_SCHED; PG8_LDA(At, 0, 0); PG8_STAGE(PG8_SA(1, 1), a1 + hstep, voffA);
            PG8_WAIT_L(8); PG8_BAR; PG8_WAIT_L(0); PG8_MMA(0, 0, At, B0); PG8_BAR; PG8_SCHED;
            PG8_LDB(B1, 0, 1); PG8_STAGE(PG8_SB(0, 0), b2, voffB);
            PG8_BAR; PG8_WAIT_L(0); PG8_MMA(0, 1, At, B1); PG8_BAR;
            PG8_LDA(At, 0, 1); PG8_STAGE(PG8_SA(0, 0), a2, voffA);
            PG8_BAR; PG8_WAIT_L(0); PG8_MMA(1, 0, At, B0); PG8_BAR; PG8_SCHED;
            PG8_STAGE(PG8_SB(0, 1), b2 + hstep, voffB);
            PG8_WAIT_V(6); PG8_BAR; PG8_MMA(1, 1, At, B1); PG8_BAR;
            PG8_LDB(B0, 1, 0); PG8_SCHED; PG8_LDA(At, 1, 0); PG8_STAGE(PG8_SA(0, 1), a2 + hstep, voffA);
            PG8_WAIT_L(8); PG8_BAR; PG8_WAIT_L(0); PG8_MMA(0, 0, At, B0); PG8_BAR; PG8_SCHED;
            PG8_LDB(B1, 1, 1); PG8_STAGE(PG8_SB(1, 0), b3, voffB);
            PG8_BAR; PG8_WAIT_L(0); PG8_MMA(0, 1, At, B1); PG8_BAR;
            PG8_LDA(At, 1, 1); PG8_STAGE(PG8_SA(1, 0), a3, voffA);
            PG8_BAR; PG8_WAIT_L(0); PG8_MMA(1, 0, At, B0); PG8_BAR; PG8_SCHED;
            PG8_STAGE(PG8_SB(1, 1), b3 + hstep, voffB);
            PG8_WAIT_V(6); PG8_BAR; PG8_MMA(1, 1, At, B1); PG8_BAR;
            }
        }
        if constexpr (ALIGN_EPI) { if (wr == 0) PG8_BAR; }
        if constexpr (!Epi::AFTER_DRAIN) { E(acc, cur, wr, wc, fr, fq, epre); S.done(cur); }
        if (!has_next) break;
        if constexpr (!KeepAcc<Epi>::v) {
#pragma unroll
        for (int a = 0; a < 2; ++a)
#pragma unroll
            for (int b = 0; b < 2; ++b)
#pragma unroll
                for (int m = 0; m < 4; ++m)
#pragma unroll
                    for (int n = 0; n < 2; ++n) acc[a][b][m][n] = (f32x4){0.f, 0.f, 0.f, 0.f};
        }
        cur = nxt; cA = nA; cB = nB; ++ui;
        if constexpr (ALIGN_EPI) { if (wr == 1) PG8_BAR; }
    }
    PG8_WAIT_V(0);
    if constexpr (!ALIGN_EPI) { if (wr == 0) PG8_BAR; }
    PG8_BAR;
    if constexpr (Epi::AFTER_DRAIN) { E.fused(acc, cur, wr, wc, fr, fq, lds, wid, lane); S.done(cur); }
#undef PG8_SA
#undef PG8_SB
#undef PG8_STAGE
#undef PG8_LDA
#undef PG8_LDB
#undef PG8_MMA
#undef PG8_WAIT_V
#undef PG8_WAIT_L
#undef PG8_BAR
#undef PG8_SCHED
}
}
namespace attn_body {
using bf16=__hip_bfloat16;
using bf16x8=__attribute__((ext_vector_type(8)))short;
using s16x4=__attribute__((ext_vector_type(4)))short;
using f32x16=__attribute__((ext_vector_type(16)))float;
using u32x4=__attribute__((ext_vector_type(4)))unsigned;
constexpr int BATCH=1,NHEAD=8,SEQ=8192,D=64,DM=NHEAD*D,VP=8192;
constexpr int NW=8,QBLK=32,QB=QBLK*NW,KVBLK=64,NQB=SEQ/QB;
constexpr int ATTN_PITCH=DM, ATTN_UNIT_ROWS=QB;
__device__ __forceinline__ int crow(int r,int hi){return (r&3)+8*(r>>2)+4*hi;}
#define SBAR() __builtin_amdgcn_sched_barrier(0)
__device__ __forceinline__ void cmask(f32x16&p0,f32x16&p1,int jb,int qrel,int hi){
  const float NEG=-INFINITY; int kb=64*jb+4*hi;
  #pragma unroll
  for(int r=0;r<16;++r){int kv=kb+(r&3)+8*(r>>2); if(kv>qrel)p0[r]=NEG; if(kv+32>qrel)p1[r]=NEG;}
}

constexpr int NSLOT=3, SLOTB=8192;
constexpr int LDS_K=0, LDS_V=NSLOT*SLOTB, LDS_WS=2*NSLOT*SLOTB, LDS_OST=LDS_WS+NW*64*4, LDS_BYTES0=LDS_OST+NW*4096, LDS_BT=LDS_BYTES0, LDS_E=LDS_BT+32768, LDS_SKP=LDS_E+512, LDS_BYTES=LDS_SKP+16;
constexpr float C2=0.125f*1.4426950408889634f;
__device__ __forceinline__ void glds16(const void*gsrc,unsigned lds_dst){unsigned keep;
  asm volatile("s_mov_b32 %0, m0\n\ts_mov_b32 m0, %2\n\ts_nop 0\n\tglobal_load_lds_dwordx4 %1, off\n\ts_mov_b32 m0, %0":"=&s"(keep):"v"(gsrc),"s"(lds_dst):"memory");}
__device__ __forceinline__ float max3f(float a,float b,float c){float r;asm("v_max3_f32 %0, %1, %2, %3":"=v"(r):"v"(a),"v"(b),"v"(c));return r;}
__device__ __forceinline__ float max2f(float a,float b){float r;asm("v_max_f32_e32 %0, %1, %2":"=v"(r):"v"(a),"v"(b));return r;}
__device__ __forceinline__ float fadd_s(float a,float b){float r;asm("v_add_f32_e32 %0, %1, %2":"=v"(r):"v"(a),"v"(b));return r;}
__device__ __forceinline__ float fsub_s(float a,float b){float r;asm("v_sub_f32_e32 %0, %1, %2":"=v"(r):"v"(a),"v"(b));return r;}
typedef float f32x2_t __attribute__((ext_vector_type(2))); typedef __bf16 bf16x2_t __attribute__((ext_vector_type(2)));
__device__ __forceinline__ unsigned cvtpk_s(float lo,float hi){f32x2_t v={lo,hi};bf16x2_t b=__builtin_convertvector(v,bf16x2_t);return __builtin_bit_cast(unsigned,b);}
typedef float f32x4_t __attribute__((ext_vector_type(4)));
__device__ __forceinline__ float sigm(float x){return __builtin_amdgcn_rcpf(1.f+__builtin_amdgcn_exp2f(-1.4426950408889634f*x));}
#define WAIT_BAR(N) asm volatile("s_waitcnt vmcnt(" #N ") lgkmcnt(0)\n\ts_barrier":::"memory")

__device__ __forceinline__ void qkt(f32x16&p0,f32x16&p1,const char*Kslot,const bf16x8*qr,const f32x16&negm,int r32,int hi){
  const char*kb=Kslot+hi*1024+r32*16;
  #pragma unroll
  for(int d0=0;d0<4;++d0){
    const bf16x8 b0=*reinterpret_cast<const bf16x8*>(kb+d0*2048);
    const bf16x8 b1=*reinterpret_cast<const bf16x8*>(kb+d0*2048+512);
    if(d0==0){p0=__builtin_amdgcn_mfma_f32_32x32x16_bf16(b0,qr[0],negm,0,0,0);p1=__builtin_amdgcn_mfma_f32_32x32x16_bf16(b1,qr[0],negm,0,0,0);}
    else{p0=__builtin_amdgcn_mfma_f32_32x32x16_bf16(b0,qr[d0],p0,0,0,0);p1=__builtin_amdgcn_mfma_f32_32x32x16_bf16(b1,qr[d0],p1,0,0,0);}}
}
typedef __attribute__((address_space(3))) const char* lds_cptr;
typedef short v4i16_t __attribute__((ext_vector_type(4)));
__device__ __forceinline__ void kload8(bf16x8*kf,lds_cptr kp){
  kf[0]=*(const __attribute__((address_space(3))) bf16x8*)(kp);      kf[1]=*(const __attribute__((address_space(3))) bf16x8*)(kp+512);
  kf[2]=*(const __attribute__((address_space(3))) bf16x8*)(kp+2048); kf[3]=*(const __attribute__((address_space(3))) bf16x8*)(kp+2560);
  kf[4]=*(const __attribute__((address_space(3))) bf16x8*)(kp+4096); kf[5]=*(const __attribute__((address_space(3))) bf16x8*)(kp+4608);
  kf[6]=*(const __attribute__((address_space(3))) bf16x8*)(kp+6144); kf[7]=*(const __attribute__((address_space(3))) bf16x8*)(kp+6656);
}
__device__ __forceinline__ void kload2(bf16x8*kf,lds_cptr kp,int j){ kf[2*j]=*(const __attribute__((address_space(3))) bf16x8*)(kp+j*2048); kf[2*j+1]=*(const __attribute__((address_space(3))) bf16x8*)(kp+j*2048+512); }
__device__ __forceinline__ s16x4 vtr(lds_cptr p){ return __builtin_bit_cast(s16x4,__builtin_amdgcn_ds_read_tr16_b64_v4i16((__attribute__((address_space(3))) v4i16_t*)p)); }
__device__ __forceinline__ float rowmax(const f32x16&p0,const f32x16&p1){
  float a=max3f(p0[0],p0[1],p1[0]),b=max3f(p0[2],p0[3],p1[1]);a=max3f(a,p1[2],p1[3]);
  #pragma unroll
  for(int r=4;r<16;r+=4){a=max3f(a,p0[r],p0[r+1]);b=max3f(b,p0[r+2],p0[r+3]);a=max3f(a,p1[r],p1[r+1]);b=max3f(b,p1[r+2],p1[r+3]);}
  const float m=max2f(a,b);
  auto rr=__builtin_amdgcn_permlane32_swap(__float_as_uint(m),__float_as_uint(m),false,false);
  return max2f(__uint_as_float(rr[0]),__uint_as_float(rr[1]));
}
__device__ __forceinline__ void pv(f32x16*o,int vb,bf16x8 pa0,bf16x8 pa1,bf16x8 pa2,bf16x8 pa3){
  #pragma unroll
  for(int d0=0;d0<2;++d0){s16x4 lo[4],hi[4];
    #pragma unroll
    for(int ks=0;ks<4;++ks){
      asm volatile("ds_read_b64_tr_b16 %0,%1 offset:%c2":"=&v"(lo[ks]):"v"(vb),"i"(d0*4096+ks*1024):"memory");
      asm volatile("ds_read_b64_tr_b16 %0,%1 offset:%c2":"=&v"(hi[ks]):"v"(vb),"i"(d0*4096+ks*1024+512):"memory");}
    asm volatile("s_waitcnt lgkmcnt(0)":::"memory");SBAR();
    #define PK(k) (bf16x8){lo[k][0],lo[k][1],lo[k][2],lo[k][3],hi[k][0],hi[k][1],hi[k][2],hi[k][3]}
    o[d0]=__builtin_amdgcn_mfma_f32_32x32x16_bf16(pa0,PK(0),o[d0],0,0,0);
    o[d0]=__builtin_amdgcn_mfma_f32_32x32x16_bf16(pa1,PK(1),o[d0],0,0,0);
    o[d0]=__builtin_amdgcn_mfma_f32_32x32x16_bf16(pa2,PK(2),o[d0],0,0,0);
    o[d0]=__builtin_amdgcn_mfma_f32_32x32x16_bf16(pa3,PK(3),o[d0],0,0,0);
    #undef PK
  }
}

#ifndef ATTN_STORE16
#define ATTN_STORE16(p,v) (*(u32x4*)(p)=(v))
#endif
template<int THRL> __device__ __forceinline__ void attn_unit(int b,int h,int qb,const bf16*Q,const bf16*__restrict__ K,const bf16*__restrict__ V,bf16*O,const float*__restrict__ FP,const float*__restrict__ FT,const bf16*__restrict__ GZ,char*shm){
  int tid_=threadIdx.x; asm volatile("; OPAQUE_TID":"+v"(tid_)); const int tid=tid_,lane=tid&63,r32=lane&31,hi=lane>>5; const int wid=__builtin_amdgcn_readfirstlane(tid>>6);
  const long rowbase=(long)b*SEQ; const int q0=qb*QB;
  const bf16*Qw=Q+(rowbase+q0+wid*QBLK)*DM+h*D;
  const bf16*Kh=K+rowbase*DM+h*D,*Vh=V+rowbase*VP+h*D;
  const unsigned lds0=(unsigned)(uintptr_t)shm;
  float*wsf=(float*)(shm+LDS_WS)+wid*64;
  const bf16*ksrc=Kh+(long)lane*DM+wid*8;
  const bf16*vsrc=Vh+(long)(16*(wid&3)+(lane>>2))*VP+(wid>>2)*32+(lane&3)*8;
  const unsigned kdst=lds0+LDS_K+wid*1024, vdst=lds0+LDS_V+wid*1024;
  #define DMA_K(t,slot) glds16(ksrc+(long)(t)*KVBLK*DM,(unsigned)__builtin_amdgcn_readfirstlane(kdst+(slot)))
  #define DMA_V(t,slot) glds16(vsrc+(long)(t)*KVBLK*VP,(unsigned)__builtin_amdgcn_readfirstlane(vdst+(slot)))
  const int vb0=(int)(lds0+LDS_V)+((lane>>4)&1)*32+(lane&3)*8+(4*hi+((lane&15)>>2))*64;
  const char*Kbase=shm+LDS_K; bf16x8 kf[8];
  const lds_cptr shm3=(lds_cptr)shm; const lds_cptr kp0=shm3+LDS_K+hi*1024+r32*16; const lds_cptr vp0=shm3+LDS_V+((lane>>4)&1)*32+(lane&3)*8+(4*hi+((lane&15)>>2))*64;
  int NT=(q0+QB)/KVBLK;
  int tskip=0;
  { float*Ef=(float*)(shm+LDS_E); float*bt=(float*)(shm+LDS_BT);
    if(wid==0){ const float a0=(2*lane<NT)?FT[h*128+2*lane]:0.f, a1=(2*lane+1<NT)?FT[h*128+2*lane+1]:0.f; float sc=a0+a1;
      _Pragma("unroll") for(int o=1;o<64;o<<=1){ const float u=__builtin_bit_cast(float,__builtin_amdgcn_ds_bpermute(((lane-o)&63)<<2,__builtin_bit_cast(int,sc))); if(lane>=o)sc+=u; }
      const float ex=sc-(a0+a1); Ef[2*lane]=ex; Ef[2*lane+1]=ex+a0; }
    asm volatile("s_waitcnt lgkmcnt(0)\n\ts_barrier":::"memory");
    const float fref=Ef[q0>>6];
    if(wid<2){ const bool fl=(tid<NT)&&((fref-(Ef[tid&127]+FP[h*SEQ+64*(tid&127)+63]))*1.4426950408889634f<-80.f);
      const unsigned long long bm=__ballot(fl); if(lane==0)((int*)(shm+LDS_SKP))[wid]=__popcll(bm); }
    for(int s=tid;s<q0+QB;s+=NW*64){ const float bv=(fref-(Ef[s>>6]+FP[h*SEQ+s]))*1.4426950408889634f; unsigned ub=__float_as_uint(bv); const unsigned hb=(ub+0x7fffu+((ub>>16)&1u))>>16;
      const float rr_=bv-__uint_as_float(hb<<16); unsigned ur=__float_as_uint(rr_); const unsigned lb=(ur+0x7fffu+((ur>>16)&1u))>>16; ((unsigned*)bt)[s]=hb|(lb<<16); }
    asm volatile("s_waitcnt vmcnt(0) lgkmcnt(0)\n\ts_barrier":::"memory"); }
  { int ts=(((const int*)(shm+LDS_SKP))[0]+((const int*)(shm+LDS_SKP))[1])&~1; ts=ts>NT-4?NT-4:ts; ts=__builtin_amdgcn_readfirstlane(ts);
    NT-=ts; ksrc+=(long)ts*KVBLK*DM; vsrc+=(long)ts*KVBLK*VP; tskip=ts; }
  const __attribute__((address_space(3))) unsigned* bt3=(const __attribute__((address_space(3))) unsigned*)(shm3+LDS_BT)+r32+64*tskip;
  #define BIAS(P0,P1,t) do{ const unsigned w0_=bt3[64*(t)], w1_=bt3[64*(t)+32]; \
    const u32x4 a0_={hi?0u:w0_,0u,0u,0u}, a1_={hi?0u:w1_,0u,0u,0u}; const u32x4 one_={0x3F803F80u,0u,0u,0u}; \
    P0=__builtin_amdgcn_mfma_f32_32x32x16_bf16(__builtin_bit_cast(bf16x8,a0_),__builtin_bit_cast(bf16x8,one_),P0,0,0,0); \
    P1=__builtin_amdgcn_mfma_f32_32x32x16_bf16(__builtin_bit_cast(bf16x8,a1_),__builtin_bit_cast(bf16x8,one_),P1,0,0,0); }while(0)
  DMA_K(0,0);DMA_V(0,0);DMA_K(1,SLOTB);
  bf16x8 qr[4];
  #pragma unroll
  for(int d0=0;d0<4;++d0)qr[d0]=*reinterpret_cast<const bf16x8*>(&Qw[(long)r32*DM+d0*16+hi*8]);
  float mhat=0.f,l_reg=0.f;f32x16 o[2];o[0]=f32x16{};o[1]=f32x16{};f32x16 negm=f32x16{};asm volatile("":"+v"(negm));
  const int qrel=wid*QBLK+r32;
  #define CMASK(P0,P1,t) do{int jb_=(t)-(NT-4); if(jb_>=0)cmask(P0,P1,jb_,qrel,hi);}while(0)
  bool resc=false;
  #define START(P0,P1) do{ const float rm=rowmax(P0,P1); resc=false; \
    { const float dl=rm; mhat=fadd_s(mhat,dl); \
      _Pragma("unroll") for(int r=0;r<16;++r){P0[r]=fsub_s(P0[r],dl);P1[r]=fsub_s(P1[r],dl);} \
      _Pragma("unroll") for(int r=0;r<16;++r)negm[r]=-mhat; asm volatile("":"+v"(negm)); } \
    _Pragma("unroll") for(int r=0;r<16;++r)P0[r]=__builtin_amdgcn_exp2f(P0[r]); }while(0)
  #define RESC() do{ if(resc){ asm volatile("s_waitcnt lgkmcnt(0)":::"memory"); \
      _Pragma("unroll") for(int d_=0;d_<2;++d_) _Pragma("unroll") for(int r=0;r<16;++r)o[d_][r]*=wsf[crow(r,hi)]; } }while(0)
  f32x16 pA0,pA1,pB0,pB1;
  int sl_prev=0,sl_cur=0,sl_next=SLOTB;
  #define ROT() do{sl_prev=sl_cur;sl_cur=sl_next;sl_next=(sl_next==(NSLOT-1)*SLOTB)?0:sl_next+SLOTB;}while(0)
  DMA_K(2,2*SLOTB);
  WAIT_BAR(3);
  qkt(pA0,pA1,Kbase,qr,negm,r32,hi);BIAS(pA0,pA1,0);asm volatile("s_nop 15\n\ts_nop 7":"+v"(pA0),"+v"(pA1));CMASK(pA0,pA1,0);
  START(pA0,pA1);
  _Pragma("unroll") for(int r=0;r<16;++r)pA1[r]=__builtin_amdgcn_exp2f(pA1[r]);
  WAIT_BAR(0);
  DMA_K(3,0);DMA_V(1,SLOTB);
  ROT();
  kload8(kf,kp0+sl_cur);
  WAIT_BAR(2);
  s16x4 vlo[8],vhi[8]; u32x4 pw0,pw1,pw2,pw3;
  #define PKW(P,B) cvtpk_s(P[B],P[B+1])
  #define PAF(k) __builtin_bit_cast(bf16x8,pw##k)
  #define VFR(i) (bf16x8){vlo[i][0],vlo[i][1],vlo[i][2],vlo[i][3],vhi[i][0],vhi[i][1],vhi[i][2],vhi[i][3]}
  #define PIN(x) asm volatile("":"+v"(x))
  #define MX3(a,b,c) __builtin_fmaxf(__builtin_fmaxf((a),(b)),(c))
  #define GAPA(MF,A0,A1,A2,A3,W0,W1,PW) do{ MF; sacc+=A0; sacc+=A1; sacc+=A2; sacc+=A3; PIN(sacc); W0; W1; PIN(PW); SBAR(); }while(0)
  #define EX(v) __builtin_amdgcn_exp2f(v)
  #define GAPB(MF,X,B) do{ MF; X[B]=EX(X[B]); X[B+1]=EX(X[B+1]); X[B+2]=EX(X[B+2]); X[B+3]=EX(X[B+3]); PIN(X); SBAR(); }while(0)
  #define VRD(i) do{ vlo[i]=vtr(vp_+(((i)>>2)*4096+((i)&3)*1024)); vhi[i]=vtr(vp_+(((i)>>2)*4096+((i)&3)*1024+512)); }while(0)
  #define KRD(G,j) do{ if(G){ kload2(kf,kp0+sl_next,j); SBAR(); } }while(0)
  #define STEP(C0,C1,P0,P1,t,GK,GV,GL) do{ SBAR(); \
    const lds_cptr vp_=vp0+sl_prev; \
    VRD(0); SBAR(); float sacc=(P0[0]+P0[1]); \
    GAPA(C0=__builtin_amdgcn_mfma_f32_32x32x16_bf16(kf[0],qr[0],negm,0,0,0), P0[2],P0[3],P0[4],P0[5],     pw0[0]=PKW(P0,0), pw0[1]=PKW(P0,2), pw0); \
    VRD(4); SBAR(); GAPA(C1=__builtin_amdgcn_mfma_f32_32x32x16_bf16(kf[1],qr[0],negm,0,0,0), P0[6],P0[7],P0[8],P0[9],     pw0[2]=PKW(P0,4), pw0[3]=PKW(P0,6), pw0); \
    VRD(1); SBAR(); GAPA(C0=__builtin_amdgcn_mfma_f32_32x32x16_bf16(kf[2],qr[1],C0,0,0,0),   P0[10],P0[11],P0[12],P0[13], pw1[0]=PKW(P0,8), pw1[1]=PKW(P0,10), pw1); \
    VRD(5); SBAR(); GAPA(C1=__builtin_amdgcn_mfma_f32_32x32x16_bf16(kf[3],qr[1],C1,0,0,0),   P0[14],P0[15],P1[0],P1[1],   pw1[2]=PKW(P0,12),pw1[3]=PKW(P0,14), pw1); \
    VRD(2); SBAR(); GAPA(C0=__builtin_amdgcn_mfma_f32_32x32x16_bf16(kf[4],qr[2],C0,0,0,0),   P1[2],P1[3],P1[4],P1[5],     pw2[0]=PKW(P1,0), pw2[1]=PKW(P1,2), pw2); \
    VRD(6); SBAR(); GAPA(C1=__builtin_amdgcn_mfma_f32_32x32x16_bf16(kf[5],qr[2],C1,0,0,0),   P1[6],P1[7],P1[8],P1[9],     pw2[2]=PKW(P1,4), pw2[3]=PKW(P1,6), pw2); \
    VRD(3); SBAR(); GAPA(C0=__builtin_amdgcn_mfma_f32_32x32x16_bf16(kf[6],qr[3],C0,0,0,0),   P1[10],P1[11],P1[12],P1[13], pw3[0]=PKW(P1,8), pw3[1]=PKW(P1,10), pw3); \
    VRD(7); SBAR(); GAPA(C1=__builtin_amdgcn_mfma_f32_32x32x16_bf16(kf[7],qr[3],C1,0,0,0),   P1[14],P1[15],0.f,0.f,       pw3[2]=PKW(P1,12),pw3[3]=PKW(P1,14), pw3); \
    l_reg+=sacc; \
    if(GK){DMA_K((t)+3,sl_cur);} if(GV){DMA_V((t)+1,sl_next);} \
    BIAS(C0,C1,t); CMASK(C0,C1,t); \
    { float a=MX3(C0[0],C0[1],C1[0]),b=MX3(C0[2],C0[3],C1[1]); a=MX3(a,C1[2],C1[3]); \
      _Pragma("unroll") for(int r=4;r<16;r+=4){a=MX3(a,C0[r],C0[r+1]);b=MX3(b,C0[r+2],C0[r+3]);a=MX3(a,C1[r],C1[r+1]);b=MX3(b,C1[r+2],C1[r+3]);} \
      float rm=__builtin_fmaxf(a,b); { auto rr=__builtin_amdgcn_permlane32_swap(__float_as_uint(rm),__float_as_uint(rm),false,false); rm=__builtin_fmaxf(__uint_as_float(rr[0]),__uint_as_float(rr[1])); } \
      resc=false; \
      if(__builtin_expect(__any(rm>(float)THRL),0)){ const float dl=__builtin_fmaxf(rm,0.f); mhat+=dl; \
        _Pragma("unroll") for(int r=0;r<16;++r){C0[r]-=dl;C1[r]-=dl;} \
        _Pragma("unroll") for(int r=0;r<16;++r)negm[r]=-mhat; asm volatile("":"+v"(negm)); \
        const float f=__builtin_amdgcn_exp2f(-dl); l_reg*=f; if(hi==0)wsf[r32]=f; resc=true; } } \
    SBAR(); \
    GAPB(o[0]=__builtin_amdgcn_mfma_f32_32x32x16_bf16(PAF(0),VFR(0),o[0],0,0,0), C0,0); \
    GAPB(o[1]=__builtin_amdgcn_mfma_f32_32x32x16_bf16(PAF(0),VFR(4),o[1],0,0,0), C0,4); \
    KRD(GL,0); GAPB(o[0]=__builtin_amdgcn_mfma_f32_32x32x16_bf16(PAF(1),VFR(1),o[0],0,0,0), C0,8); \
    KRD(GL,1); GAPB(o[1]=__builtin_amdgcn_mfma_f32_32x32x16_bf16(PAF(1),VFR(5),o[1],0,0,0), C0,12); \
    KRD(GL,2); GAPB(o[0]=__builtin_amdgcn_mfma_f32_32x32x16_bf16(PAF(2),VFR(2),o[0],0,0,0), C1,0); \
    KRD(GL,3); GAPB(o[1]=__builtin_amdgcn_mfma_f32_32x32x16_bf16(PAF(2),VFR(6),o[1],0,0,0), C1,4); \
    GAPB(o[0]=__builtin_amdgcn_mfma_f32_32x32x16_bf16(PAF(3),VFR(3),o[0],0,0,0), C1,8); \
    GAPB(o[1]=__builtin_amdgcn_mfma_f32_32x32x16_bf16(PAF(3),VFR(7),o[1],0,0,0), C1,12); \
    }while(0)
  int t=1;
  #undef CMASK
  #define CMASK(P0,P1,t) do{}while(0)
  for(;t+5<NT;t+=2){
    STEP(pB0,pB1,pA0,pA1,t,true,true,true);     WAIT_BAR(2); RESC(); ROT();
    STEP(pA0,pA1,pB0,pB1,t+1,true,true,true);   WAIT_BAR(2); RESC(); ROT();
  }
  #undef CMASK
  #define CMASK(P0,P1,t) do{int jb_=(t)-(NT-4); if(jb_>=0)cmask(P0,P1,jb_,qrel,hi);}while(0)
  #define ENDW(tt) do{ if((tt)+3<NT){WAIT_BAR(2);} else if((tt)+2<NT){WAIT_BAR(1);} else {WAIT_BAR(0);} }while(0)
  for(;t+1<NT;t+=2){
    STEP(pB0,pB1,pA0,pA1,t,(t+3<NT),(t+1<NT),(t+1<NT));       ENDW(t);   RESC(); ROT();
    STEP(pA0,pA1,pB0,pB1,t+1,(t+4<NT),(t+2<NT),(t+2<NT));     ENDW(t+1); RESC(); ROT();
  }
  STEP(pB0,pB1,pA0,pA1,NT-1,false,false,false); RESC();
  { float sacc=pB0[0]+pB0[1]; _Pragma("unroll") for(int r=2;r<16;++r)sacc+=pB0[r]; _Pragma("unroll") for(int r=0;r<16;++r)sacc+=pB1[r]; l_reg+=sacc;
    pw0=(u32x4){PKW(pB0,0),PKW(pB0,2),PKW(pB0,4),PKW(pB0,6)};pw1=(u32x4){PKW(pB0,8),PKW(pB0,10),PKW(pB0,12),PKW(pB0,14)};pw2=(u32x4){PKW(pB1,0),PKW(pB1,2),PKW(pB1,4),PKW(pB1,6)};pw3=(u32x4){PKW(pB1,8),PKW(pB1,10),PKW(pB1,12),PKW(pB1,14)};
    SBAR(); pv(o,vb0+sl_cur,PAF(0),PAF(1),PAF(2),PAF(3)); }
  #undef PKW
  #undef PAF
  #undef VFR
  #undef PIN
  #undef MX3
  #undef GAPA
  #undef GAPB
  #undef EX
  #undef VRD
  #undef KRD
  #undef STEP
  #undef ENDW
  {auto rr=__builtin_amdgcn_permlane32_swap(__float_as_uint(l_reg),__float_as_uint(l_reg),false,false);l_reg=__uint_as_float(rr[0])+__uint_as_float(rr[1]);}
  if(hi==0)wsf[32+r32]=l_reg;asm volatile("s_waitcnt lgkmcnt(0)":::"memory");
  float rli[16];
  #pragma unroll
  for(int r=0;r<16;++r)rli[r]=__builtin_amdgcn_rcpf(wsf[32+crow(r,hi)]);
  bf16*Ow=O+(rowbase+q0+wid*QBLK)*DM+h*D;
  { bf16*stg=(bf16*)(shm+LDS_OST)+wid*2048;
    #pragma unroll
    for(int r=0;r<16;++r){const int orow=crow(r,hi);
      #pragma unroll
      for(int d0=0;d0<2;++d0)stg[orow*64+d0*32+r32]=__float2bfloat16(o[d0][r]*rli[r]);}
    asm volatile("s_waitcnt lgkmcnt(0)":::"memory");
    #pragma unroll
    for(int i=0;i<4;++i){const int row=i*8+(lane>>3),ch=lane&7; const u32x4 v=*(const u32x4*)(stg+row*64+ch*8);
      const u32x4 gz=*(const u32x4*)(GZ+(rowbase+q0+wid*QBLK+row)*VP+h*D+ch*8); u32x4 w;
      #define GM(a,g) cvtpk_s(__uint_as_float((a)<<16)*sigm(__uint_as_float((g)<<16)), __uint_as_float((a)&0xffff0000u)*sigm(__uint_as_float((g)&0xffff0000u)))
      w.x=GM(v.x,gz.x); w.y=GM(v.y,gz.y); w.z=GM(v.z,gz.z); w.w=GM(v.w,gz.w);
      #undef GM
      ATTN_STORE16(Ow+(long)row*DM+ch*8,w);} }
  asm volatile("s_waitcnt lgkmcnt(0)\n\ts_barrier":::"memory");
  #undef DMA_K
  #undef DMA_V
  #undef BIAS
  #undef CMASK
  #undef START
  #undef RESC
  #undef ROT
}
constexpr int ATTN_LDS_BYTES=LDS_BYTES;
#undef SBAR
#undef WAIT_BAR
}
#define GAS __attribute__((address_space(1)))
#define LAS __attribute__((address_space(3)))
typedef unsigned short bf16;
typedef unsigned v4u __attribute__((ext_vector_type(4)));
typedef float f32x4 __attribute__((ext_vector_type(4)));
typedef short bf16x8 __attribute__((ext_vector_type(8)));
typedef GAS unsigned gu32;
typedef GAS unsigned long long gu64;
#define RLX_AGENT __ATOMIC_RELAXED, __HIP_MEMORY_SCOPE_AGENT
#define LDS_WAIT() asm volatile("s_waitcnt lgkmcnt(0)" ::: "memory")
#define VM_WAIT() asm volatile("s_waitcnt vmcnt(0)" ::: "memory")
__device__ __forceinline__ unsigned long long rt() { return __builtin_amdgcn_s_memrealtime(); }
__device__ __forceinline__ unsigned f2bf(float f) { unsigned u = __builtin_bit_cast(unsigned, f); return (u + 0x7fffu + ((u >> 16) & 1u)) >> 16; }
__device__ __forceinline__ unsigned pk2(float lo, float hi) { return f2bf(lo) | (f2bf(hi) << 16); }

#define XB_TMO      128
#define XB_XCNT(j)  (256  + 64 * (j))
#define XB_XSUB(j)  (1280 + 64 * (j))
#define XB_XGEN(j)  (2304 + 64 * (j))
#define XB_TOP      3328
#define XB_TOPGEN   3392
#define XCD_BAR_WORDS 3456
#define XB_SPIN_CAP (1u << 18)

__device__ __forceinline__ unsigned xb_ld(unsigned* p)              { return __hip_atomic_load(p, __ATOMIC_RELAXED, __HIP_MEMORY_SCOPE_AGENT); }
__device__ __forceinline__ unsigned xb_add(unsigned* p, unsigned v) { return __hip_atomic_fetch_add(p, v, __ATOMIC_RELAXED, __HIP_MEMORY_SCOPE_AGENT); }
__device__ __forceinline__ unsigned xb_xcc_id() { return (unsigned)__builtin_amdgcn_s_getreg((3 << 11) | 20) & 0xFu; }
#define XB_SPIN(cond, bar) do { unsigned _sp = 0; while (cond) { __builtin_amdgcn_s_sleep(1); \
    if ((++_sp & 255u) == 0u) { if (xb_ld(&(bar)[XB_TMO])) break; if (_sp > XB_SPIN_CAP) { atomicAdd(&(bar)[XB_TMO], 1u); break; } } } } while (0)

struct XcdBarrier {
    unsigned* bar; unsigned x;
    volatile LAS unsigned* st;
};

__device__ __forceinline__ XcdBarrier xcd_barrier_post(unsigned* bar, volatile LAS unsigned* st) {
    XcdBarrier b; b.bar = bar; b.x = xb_xcc_id(); b.st = st;
    if (threadIdx.x == 0) (void)xb_add(&bar[XB_XCNT(b.x)], 1u);
    return b;
}
__device__ __forceinline__ void xcd_barrier_complete(unsigned* bar, unsigned x, unsigned& nloc, unsigned& nx) {
    const unsigned G = gridDim.x * gridDim.y * gridDim.z;
    unsigned sum, cnt, mine, sp = 0u;
    for (;;) {
        sum = 0u; cnt = 0u; mine = 0u;
#pragma unroll
        for (unsigned j = 0; j < 16; ++j) { const unsigned c = xb_ld(&bar[XB_XCNT(j)]); sum += c; cnt += (c > 0u) ? 1u : 0u; mine = (j == x) ? c : mine; }
        if (sum == G) break;
        __builtin_amdgcn_s_sleep(1);
        if ((++sp & 255u) == 0u) { if (xb_ld(&bar[XB_TMO])) break; if (sp > XB_SPIN_CAP) { atomicAdd(&bar[XB_TMO], 1u); break; } }
    }
    nloc = mine > 0u ? mine : 1u; nx = cnt > 0u ? cnt : 1u;
}

__device__ __forceinline__ void xcd_barrier(const XcdBarrier& b) {
    asm volatile("s_waitcnt vmcnt(0)" ::: "memory");
    __syncthreads();
    if (threadIdx.x == 0) {
        unsigned* bar = b.bar;
        __builtin_amdgcn_s_waitcnt(0);
        unsigned nloc = b.st[0], nx = b.st[1];
        if (nloc == 0u) { xcd_barrier_complete(bar, b.x, nloc, nx); b.st[0] = nloc; b.st[1] = nx; }
        const unsigned old = xb_add(&bar[XB_XSUB(b.x)], 1u);
        const unsigned gen = old / nloc;
        if (old + 1u == (gen + 1u) * nloc) {
            __builtin_amdgcn_fence(__ATOMIC_RELEASE, "agent");
            asm volatile("s_waitcnt vmcnt(0)" ::: "memory");
            const unsigned og = xb_add(&bar[XB_TOP], 1u);
            const unsigned tg = og / nx;
            if (og + 1u == (tg + 1u) * nx) xb_add(&bar[XB_TOPGEN], 1u);
            else XB_SPIN(xb_ld(&bar[XB_TOPGEN]) == tg, bar);
            __builtin_amdgcn_fence(__ATOMIC_ACQUIRE, "agent");
            xb_add(&bar[XB_XGEN(b.x)], 1u);
            asm volatile("s_waitcnt vmcnt(0)" ::: "memory");
        } else {
            XB_SPIN(xb_ld(&bar[XB_XGEN(b.x)]) == gen, bar);
            __builtin_amdgcn_fence(__ATOMIC_ACQUIRE, "agent");
            asm volatile("s_waitcnt vmcnt(0)" ::: "memory");
        }
    }
    __syncthreads();
}
struct Args { const float* in[N_IN]; float* out; unsigned char* ws; int ph_lo, ph_hi, li, pad; };
struct Frame {
    LAS unsigned char* lds; volatile LAS unsigned* MISC; gu32* ctl;
    int tid, lane, wave, vcu, G, bx;
    unsigned char* ws;
};
template <int CTRL> __device__ __forceinline__ float dpp_add(float v) {
    return v + __builtin_bit_cast(float, __builtin_amdgcn_update_dpp(0, __builtin_bit_cast(int, v), CTRL, 0xf, 0xf, true));
}
__device__ __forceinline__ float row16_sum(float v) {
    v = dpp_add<0xB1>(v);
    v = dpp_add<0x4E>(v);
    v = dpp_add<0x141>(v);
    v = dpp_add<0x140>(v);
    return v;
}
__device__ __forceinline__ float bperm(int srclane, float v) { return __builtin_bit_cast(float, __builtin_amdgcn_ds_bpermute(srclane << 2, __builtin_bit_cast(int, v))); }
template <int M> __device__ __forceinline__ float shx(float v) {
    constexpr int ctrl = (M == 1) ? 0xB1 : ((M == 2) ? 0x4E : 0x141);
    return __builtin_bit_cast(float, __builtin_amdgcn_update_dpp(0, __builtin_bit_cast(int, v), ctrl, 0xf, 0xf, true));
}
__device__ __forceinline__ float sum8(float v) { v += shx<1>(v); v += shx<2>(v); v += shx<4>(v); return v; }
__device__ __forceinline__ float rdlane(float v, int l) { return __builtin_bit_cast(float, __builtin_amdgcn_readlane(__builtin_bit_cast(int, v), l)); }
__device__ __forceinline__ float wave_sum(float v) { v = row16_sum(v); return (rdlane(v, 0) + rdlane(v, 16)) + (rdlane(v, 32) + rdlane(v, 48)); }
__device__ __forceinline__ float wave_incl_scan(float v, int lane) {
#pragma unroll
    for (int o = 1; o < 64; o <<= 1) { const float u = bperm((lane - o) & 63, v); if (lane >= o) v += u; }
    return v;
}
__device__ __forceinline__ float wave_incl_max(float v, int lane) {
#pragma unroll
    for (int o = 1; o < 64; o <<= 1) { const float u = bperm((lane - o) & 63, v); if (lane >= o) v = fmaxf(v, u); }
    return v;
}
__device__ __forceinline__ float lo16(unsigned p) { return __builtin_bit_cast(float, p << 16); }
__device__ __forceinline__ float hi16(unsigned p) { return __builtin_bit_cast(float, p & 0xffff0000u); }
__device__ __forceinline__ void unpack8(const v4u p, float (&f)[8]) { f[0] = lo16(p.x); f[1] = hi16(p.x); f[2] = lo16(p.y); f[3] = hi16(p.y); f[4] = lo16(p.z); f[5] = hi16(p.z); f[6] = lo16(p.w); f[7] = hi16(p.w); }
__device__ __forceinline__ unsigned cvtpk(float lo, float hi) { return pg8::cvt_pk_bf16(lo, hi); }
__device__ __forceinline__ v4u pack8(const float (&f)[8]) { v4u o; o.x = cvtpk(f[0], f[1]); o.y = cvtpk(f[2], f[3]); o.z = cvtpk(f[4], f[5]); o.w = cvtpk(f[6], f[7]); return o; }
__device__ __forceinline__ float bf1(const bf16* p) { return __builtin_bit_cast(float, (unsigned)(*p) << 16); }
__device__ __forceinline__ float sigmoidf_(float x) { return __builtin_amdgcn_rcpf(1.f + __builtin_amdgcn_exp2f(-1.4426950408889634f * x)); }
__device__ __forceinline__ float logsigf_(float x) { return fminf(x, 0.f) - log1pf(__expf(-fabsf(x))); }
__device__ __forceinline__ float siluf_(float x) { return x * sigmoidf_(x); }

__device__ __forceinline__ int win_src(int n) { return n < 2048 ? n : (n < 7936 ? n + 8 : (n < 7944 ? n - 5888 : (n < 7960 ? n : -1))); }
template <bool SPREAD = false>
__device__ __forceinline__ void tr_item64(const float* W, int Nsrc, int sc0, bf16* WT, int K, int k0, int drow0, LAS bf16* T, int lane, const float* gk = nullptr) {
    const int kr = lane >> 4, c4 = lane & 15;
    f32x4 v[16];
#pragma unroll
    for (int j = 0; j < 16; ++j) v[j] = *(const f32x4*)(W + (size_t)(k0 + 4 * j + kr) * Nsrc + sc0 + 4 * c4);
    if (gk) {
#pragma unroll
        for (int j = 0; j < 16; ++j) v[j] = v[j] * gk[k0 + 4 * j + kr]; }
#pragma unroll
    for (int j = 0; j < 16; ++j) { const unsigned p0 = cvtpk(v[j][0], v[j][1]), p1 = cvtpk(v[j][2], v[j][3]); const int kk = 4 * j + kr;
        const int col = ((((kk >> 3) ^ (c4 >> 1)) & 7) << 3) + (kk & 7);
        T[(4 * c4 + 0) * LDT + col] = (bf16)(p0 & 0xffffu); T[(4 * c4 + 1) * LDT + col] = (bf16)(p0 >> 16); T[(4 * c4 + 2) * LDT + col] = (bf16)(p1 & 0xffffu); T[(4 * c4 + 3) * LDT + col] = (bf16)(p1 >> 16); }
    LDS_WAIT(); asm volatile("" ::: "memory");
#pragma unroll
    for (int p = 0; p < 8; ++p) { const int n = (lane >> 3) + 8 * p, kc = lane & 7; const int dr = SPREAD ? 8 * (n >> 2) + (n & 3) : n; *(GAS v4u*)(WT + (size_t)(drow0 + dr) * K + k0 + 8 * kc) = *(const LAS v4u*)(T + n * LDT + (((kc ^ (n >> 3)) & 7) << 3)); }
    LDS_WAIT(); asm volatile("" ::: "memory");
}
__device__ __forceinline__ void tr_item64_win_special(const float* W, bf16* WT, int k0, LAS bf16* T, int lane, const float* gk) {
    const int sc = win_src(7936 + lane);
    for (int kk = 0; kk < 64; ++kk) T[lane * LDT + kk] = (bf16)f2bf(sc >= 0 ? gk[k0 + kk] * W[(size_t)(k0 + kk) * 7960 + sc] : 0.f);
    LDS_WAIT(); asm volatile("" ::: "memory");
#pragma unroll
    for (int p = 0; p < 8; ++p) { const int n = (lane >> 3) + 8 * p, kc = lane & 7; *(GAS v4u*)(WT + (size_t)(7936 + n) * DM + k0 + 8 * kc) = *(const LAS v4u*)(T + n * LDT + 8 * kc); }
    LDS_WAIT(); asm volatile("" ::: "memory");
}
template <class InT> __device__ __forceinline__ void p0_prologue(Frame& F, const InT& in) {
    LAS bf16* T = (LAS bf16*)(F.lds + RING_OFF + F.wave * 16384);
    const int gw = F.vcu * NWAVES + F.wave, NGW = F.G * NWAVES, lane = F.lane;
    constexpr int I_13 = (DM / 64) * (2 * DFF / 64), I_2 = (DFF / 64) * (DM / 64), I_IN = (DM / 64) * (ZW / 64), I_G = (DM / 64) * (4 * DM / 64), I_B = 4 * (MW / 64) * (DM / 64), I_O = (DM / 64) * (DM / 64);
    constexpr int I_LR = 32;
    constexpr int PER_L = 2 * (I_13 + I_2) + I_IN + I_G + I_B + I_O + I_LR;
    for (int it = gw; it < DEPTH * PER_L; it += NGW) {
        const int l = it / PER_L; int r = it % PER_L;
        unsigned char* wl = F.ws + WS_W + (size_t)l * WL_BYTES;
        if (r < 2 * (I_13 + I_2)) {
            const int ffn = r / (I_13 + I_2); r %= (I_13 + I_2);
            if (r < I_13) { const int kblk = DM / 64, kb = r % kblk, nb = r / kblk, n0 = nb * 64, tile = n0 >> 8, within = n0 & 255;
                const float* w = in[within < 128 ? (ffn ? I_F2W1 : I_F1W1) : (ffn ? I_F2W3 : I_F1W3)] + (size_t)l * DM * DFF;
                tr_item64(w, DFF, tile * 128 + (within & 127), (bf16*)(wl + (ffn ? WL_W13B : WL_W13A)), DM, kb * 64, n0, T, lane, in[ffn ? I_F2N : I_F1N] + (size_t)l * DM); }
            else { r -= I_13; const int kblk = DFF / 64, kb = r % kblk, nb = r / kblk; tr_item64(in[ffn ? I_F2W2 : I_F1W2] + (size_t)l * DFF * DM, DM, nb * 64, (bf16*)(wl + (ffn ? WL_W2B : WL_W2A)), DFF, kb * 64, nb * 64, T, lane); }
            continue; }
        r -= 2 * (I_13 + I_2);
        if (r < I_IN) { const int kblk = DM / 64, kb = r % kblk, nb = r / kblk, n0 = nb * 64; const float* w = in[I_WIN] + (size_t)l * DM * 7960;
            if (n0 < 7936) tr_item64(w, 7960, n0 < 2048 ? n0 : n0 + 8, (bf16*)(wl + WL_WIN), DM, kb * 64, n0, T, lane, in[I_MIXN] + (size_t)l * DM);
            else if (n0 == 7936) tr_item64_win_special(w, (bf16*)(wl + WL_WIN), kb * 64, T, lane, in[I_MIXN] + (size_t)l * DM);
            else { const v4u z = {0u, 0u, 0u, 0u};
#pragma unroll
                for (int p = 0; p < 8; ++p) { const int n = (lane >> 3) + 8 * p, kc = lane & 7; *(GAS v4u*)((bf16*)(wl + WL_WIN) + (size_t)(n0 + n) * DM + kb * 64 + 8 * kc) = z; } }
            continue; }
        r -= I_IN;
        if (r < I_G) { const int kblk = DM / 64, kb = r % kblk, nb = r / kblk, gn = nb >> 5, gt = nb & 31;
            tr_item64<true>(in[I_WG] + (size_t)l * DM * 4 * DM, 4 * DM, nb * 64, (bf16*)(wl + WL_WG), DM, kb * 64, 256 * gt + 128 * (gn >> 1) + 4 * (gn & 1), T, lane, in[I_MIXN] + (size_t)l * DM); continue; }
        r -= I_G;
        if (r < I_B) { const int per = (MW / 64) * (DM / 64), n = r / per; r %= per; const int kblk = MW / 64, kb = r % kblk, nb = r / kblk;
            tr_item64(in[I_WB] + ((size_t)l * 4 + n) * MW * DM, DM, nb * 64, (bf16*)(wl + WL_WB) + (size_t)n * DM * MW, MW, kb * 64, nb * 64, T, lane); continue; }
        r -= I_B;
        if (r < I_O) { const int kblk = DM / 64, kb = r % kblk, nb = r / kblk; tr_item64(in[I_WO] + (size_t)l * DM * DM, DM, nb * 64, (bf16*)(wl + WL_WO), DM, kb * 64, nb * 64, T, lane); continue; }
        r -= I_O;
        { bf16* lr = (bf16*)(F.ws + WS_LORA) + (size_t)l * 131072;
          if (r < 8) tr_item64(in[I_RW2] + (size_t)l * 64 * MW, MW, r * 64, lr, 64, 0, r * 64, T, lane);
          else if (r < 16) tr_item64(in[I_RA2] + (size_t)l * 64 * MW, MW, (r - 8) * 64, lr + 32768, 64, 0, (r - 8) * 64, T, lane);
          else { const int q = r - 16; tr_item64(in[I_RG2] + (size_t)l * 128 * MW, MW, (q >> 1) * 64, lr + 65536, 128, (q & 1) * 64, (q >> 1) * 64, T, lane); } }
    }
}
__device__ __forceinline__ void xin_phase(Frame& F, const float* x, bf16* xb, float* ssp) {
    const int gw = F.vcu * NWAVES + F.wave, NGW = F.G * NWAVES;
    for (int m = gw; m < SEQ; m += NGW) {
        const GAS f32x4* xr = (const GAS f32x4*)(x + (size_t)m * DM) + F.lane; f32x4 v[8]; float s = 0.f;
#pragma unroll
        for (int j = 0; j < 8; ++j) { v[j] = xr[64 * j]; s += (v[j].x * v[j].x + v[j].y * v[j].y) + (v[j].z * v[j].z + v[j].w * v[j].w); }
        s = wave_sum(s); if (F.lane < 8) ssp[(size_t)F.lane * SEQ + m] = (F.lane == 0) ? s : 0.f;
        GAS unsigned long long* o8 = (GAS unsigned long long*)(xb + (size_t)m * DM) + F.lane;
#pragma unroll
        for (int j = 0; j < 8; ++j) o8[64 * j] = (unsigned long long)cvtpk(v[j].x, v[j].y) | ((unsigned long long)cvtpk(v[j].z, v[j].w) << 32);
    }
}
struct PrepP {
    const bf16* Z; const int* pos; const bf16 *w2t, *a2t, *g2t;
    const float *fox_fb, *fox_qg, *fox_kg, *mu, *w0, *w2, *a0, *a2, *g2, *k_k, *k_a, *r_k, *conv_w, *conv_b, *mib, *mfb;
    bf16 *FQ, *FK, *RQ, *RK, *MQ, *MK, *RG, *FV, *FO, *TV, *TG, *MV, *MO; float *RW, *RBON, *FP, *FT, *MBC, *MA, *MAX, *MBL;
};
__device__ __forceinline__ void prep_phase(Frame& F, const PrepP& P, int pmask) {
    const int gw = F.vcu * NWAVES + F.wave, NGW = F.G * NWAVES, lane = F.lane;
    if (pmask & 1) for (int it = gw; it < 128 * NH; it += NGW) {
        const int j = it >> 3, h = it & 7, t = 64 * j + lane; const bf16* zr = P.Z + (size_t)t * ZW;
        const float lf = logsigf_(bf1(zr + ZC_FF + h) + P.fox_fb[h]);
        const float inc = wave_incl_scan(lf, lane);
        P.FP[h * SEQ + t] = inc; if (lane == 63) P.FT[h * 128 + j] = inc;
        const float li = bf1(zr + ZC_MI + h) + P.mib[h];
        const float lfm = logsigf_(bf1(zr + ZC_MF + h) + P.mfb[h]);
        const float bc = wave_incl_scan(lfm, lane);
        P.MBC[h * SEQ + t] = bc; P.MA[h * SEQ + t] = li - bc;
        const float amax = wave_incl_max(li - bc, lane); if (lane == 63) { P.MAX[h * 128 + j] = amax; P.MBL[h * 128 + j] = bc; }
    }
    if (pmask & 2) {
        const int o8 = 8 * (lane & 7);
        float qg[8], kg[8], ifr[8];
#pragma unroll
        for (int i = 0; i < 8; ++i) { qg[i] = P.fox_qg[o8 + i] * (0.125f * 1.4426950408889634f); kg[i] = P.fox_kg[o8 + i];
            const int f = (o8 + i) & 31; ifr[i] = powf(10000.f, -(float)(2 * f) / 64.f); }
        const bool first = (lane & 7) < 4;
        for (int t = gw; t < SEQ; t += NGW) {
            const bf16* zr = P.Z + (size_t)t * ZW;
            {
                float q[8], k[8]; unpack8(*(const v4u*)(zr + ZC_FQ + 8 * lane), q); unpack8(*(const v4u*)(zr + ZC_FK + 8 * lane), k);
                float sq = 0.f, sk = 0.f;
#pragma unroll
                for (int i = 0; i < 8; ++i) { sq += q[i] * q[i]; sk += k[i] * k[i]; }
                sq += shx<1>(sq); sk += shx<1>(sk); sq += shx<2>(sq); sk += shx<2>(sk); sq += shx<4>(sq); sk += shx<4>(sk);
                const float rq = __builtin_amdgcn_rsqf(sq * (1.f / 64.f) + 1e-6f), rk = __builtin_amdgcn_rsqf(sk * (1.f / 64.f) + 1e-6f);
#pragma unroll
                for (int i = 0; i < 8; ++i) { q[i] = q[i] * rq * qg[i]; k[i] = k[i] * rk * kg[i]; }
                *(v4u*)(P.FQ + (size_t)t * MW + 8 * lane) = pack8(q); *(v4u*)(P.FK + (size_t)t * MW + 8 * lane) = pack8(k);
            }
            {
                const float pf = (float)P.pos[t];
                float cs[8], sn[8];
#pragma unroll
                for (int i = 0; i < 8; ++i) { const float ang = pf * ifr[i]; const double rev = (double)ang * 0.15915494309189535; const float fr = (float)(rev - rint(rev));
                    sn[i] = __builtin_amdgcn_sinf(fr); cs[i] = __builtin_amdgcn_cosf(fr); }
                float q[8], k[8], qo[8], ko[8]; unpack8(*(const v4u*)(zr + ZC_TQ + 8 * lane), q); unpack8(*(const v4u*)(zr + ZC_TK + 8 * lane), k);
#pragma unroll
                for (int i = 0; i < 8; ++i) { const float qp = bperm(lane ^ 4, q[i]), kp = bperm(lane ^ 4, k[i]);
                    qo[i] = first ? (q[i] * cs[i] - qp * sn[i]) : (qp * sn[i] + q[i] * cs[i]);
                    ko[i] = 0.125f * (first ? (k[i] * cs[i] - kp * sn[i]) : (kp * sn[i] + k[i] * cs[i])); }
                *(v4u*)(P.RQ + (size_t)t * MW + 8 * lane) = pack8(qo); *(v4u*)(P.RK + (size_t)t * MW + 8 * lane) = pack8(ko);
            }
#pragma unroll
            for (int p = 0; p < 2; ++p) {
                const int ch = 512 * p + 8 * lane; float acc[8];
#pragma unroll
                for (int i = 0; i < 8; ++i) acc[i] = P.conv_b[ch + i];
#pragma unroll
                for (int j = 0; j < 4; ++j) { const int tt = t - 3 + j; if (tt >= 0) { float x[8]; unpack8(*(const v4u*)(P.Z + (size_t)tt * ZW + ZC_MQK + ch), x);
#pragma unroll
                        for (int i = 0; i < 8; ++i) acc[i] += P.conv_w[j * 1024 + ch + i] * x[i]; } }
#pragma unroll
                for (int i = 0; i < 8; ++i) acc[i] = siluf_(acc[i]) * (p ? 0.125f : 1.f);
                *(v4u*)((p ? P.MK : P.MQ) + (size_t)t * MW + 8 * lane) = pack8(acc);
            }
        }
    }
    if (pmask & 4) {
        constexpr int XS = 264, OS = 520;
        LAS bf16* Xb = (LAS bf16*)(F.lds + RING_OFF); LAS bf16* OW = Xb + 32 * XS; LAS bf16* OA = OW + 32 * OS; LAS bf16* OG = OA + 32 * OS;
        const int hh = lane >> 3, c0 = 8 * lane, wave = F.wave;
        {
            const int tb = gw, t0 = 4 * tb;
            if (lane < 32) {
                float m8[8];
#pragma unroll
                for (int i = 0; i < 8; ++i) m8[i] = P.mu[1536 + 8 * lane + i];
                float prev[8];
                if (t0 > 0) unpack8(*(const v4u*)(P.Z + (size_t)(t0 - 1) * ZW + ZC_RL + 8 * lane), prev);
                else {
#pragma unroll
                    for (int i = 0; i < 8; ++i) prev[i] = 0.f; }
#pragma unroll
                for (int tk = 0; tk < 4; ++tk) { float cur[8], xv[8]; unpack8(*(const v4u*)(P.Z + (size_t)(t0 + tk) * ZW + ZC_RL + 8 * lane), cur);
#pragma unroll
                    for (int i = 0; i < 8; ++i) { float v = cur[i] + m8[i] * (prev[i] - cur[i]); v = (lane < 8) ? tanhf(v) : ((lane < 16) ? v : sigmoidf_(v)); xv[i] = v; prev[i] = cur[i]; }
                    *(LAS v4u*)(Xb + (4 * wave + tk) * XS + 8 * lane) = pack8(xv); }
            }
            __syncthreads();
            {
                typedef float f32x16_t __attribute__((ext_vector_type(16)));
                const int n = lane & 31, h = lane >> 5;
#pragma unroll
                for (int mat = 0; mat < 3; ++mat) { const int K = (mat == 2) ? 128 : 64, koff = (mat == 0) ? 0 : ((mat == 1) ? 64 : 128); const bf16* wt = (mat == 0) ? P.w2t : ((mat == 1) ? P.a2t : P.g2t); LAS bf16* O = (mat == 0) ? OW : ((mat == 1) ? OA : OG);
#pragma unroll
                    for (int ct = 0; ct < 2; ++ct) { f32x16_t acc = {0.f, 0.f, 0.f, 0.f, 0.f, 0.f, 0.f, 0.f, 0.f, 0.f, 0.f, 0.f, 0.f, 0.f, 0.f, 0.f};
                        const bf16* wrow = wt + (size_t)(64 * wave + 32 * ct + n) * K + 8 * h;
#pragma unroll
                        for (int ks = 0; ks < ((mat == 2) ? 8 : 4); ++ks) { const bf16x8 a = *(const LAS bf16x8*)(Xb + n * XS + koff + 16 * ks + 8 * h), b = *(const bf16x8*)(wrow + 16 * ks);
                            acc = __builtin_amdgcn_mfma_f32_32x32x16_bf16(a, b, acc, 0, 0, 0); }
#pragma unroll
                        for (int r_ = 0; r_ < 16; ++r_) O[((r_ & 3) + 8 * (r_ >> 2) + 4 * h) * OS + 64 * wave + 32 * ct + n] = (bf16)f2bf(acc[r_]); } }
            }
            __syncthreads();
            float aw[4][8], aa[4][8];
#pragma unroll
            for (int tk = 0; tk < 4; ++tk) { unpack8(*(const LAS v4u*)(OW + (4 * wave + tk) * OS + c0), aw[tk]); unpack8(*(const LAS v4u*)(OA + (4 * wave + tk) * OS + c0), aa[tk]); }
            float pr[8], pk[8], pv[8];
            if (t0 > 0) { const bf16* zp = P.Z + (size_t)(t0 - 1) * ZW; unpack8(*(const v4u*)(zp + ZC_RR + c0), pr); unpack8(*(const v4u*)(zp + ZC_RK + c0), pk); unpack8(*(const v4u*)(zp + ZC_RV + c0), pv); }
            else {
#pragma unroll
                for (int i = 0; i < 8; ++i) { pr[i] = 0.f; pk[i] = 0.f; pv[i] = 0.f; } }
#pragma unroll
            for (int tk = 0; tk < 4; ++tk) {
                asm volatile("" ::: "memory");
                const int t = t0 + tk; const bf16* zc = P.Z + (size_t)t * ZW;
                unsigned char* recb = (unsigned char*)(P.RW + ((size_t)hh * SEQ + t) * RREC) + 16 * (lane & 7);
                float r[8], k[8];
                { float cr[8], cv[8], v[8]; unpack8(*(const v4u*)(zc + ZC_RR + c0), cr); unpack8(*(const v4u*)(zc + ZC_RV + c0), cv);
#pragma unroll
                  for (int i = 0; i < 8; ++i) { r[i] = cr[i] + P.mu[c0 + i] * (pr[i] - cr[i]); v[i] = cv[i] + P.mu[1024 + c0 + i] * (pv[i] - cv[i]); pr[i] = cr[i]; pv[i] = cv[i]; }
                  *(v4u*)(recb + 512) = pack8(v); }
                { float w[8], wr[8];
#pragma unroll
                  for (int i = 0; i < 8; ++i) { const float u = P.w0[c0 + i] + aw[tk][i]; w[i] = -0.6065306597126334f * sigmoidf_(u); wr[i] = r[i]; }
                  float* lwp = (float*)(recb + 640 + 16 * (lane & 7)); *(f32x4*)lwp = (f32x4){w[0], w[1], w[2], w[3]}; *(f32x4*)(lwp + 4) = (f32x4){w[4], w[5], w[6], w[7]};
                  *(v4u*)(recb + 384) = pack8(wr); }
                { float ck[8]; unpack8(*(const v4u*)(zc + ZC_RK + c0), ck);
#pragma unroll
                  for (int i = 0; i < 8; ++i) { k[i] = ck[i] + P.mu[512 + c0 + i] * (pk[i] - ck[i]); pk[i] = ck[i]; } }
                float a[8], kk[8]; float ss = 0.f;
#pragma unroll
                for (int i = 0; i < 8; ++i) { a[i] = sigmoidf_(P.a0[c0 + i] + aa[tk][i]); kk[i] = k[i] * P.k_k[c0 + i]; ss += kk[i] * kk[i]; }
                ss += shx<1>(ss); ss += shx<2>(ss); ss += shx<4>(ss);
                const float rn = __builtin_amdgcn_rsqf(fmaxf(ss, 1e-12f));
                float c1 = 0.f, c2 = 0.f, bo = 0.f; float kp[8], b[8];
#pragma unroll
                for (int i = 0; i < 8; ++i) { kk[i] *= rn; kp[i] = k[i] * (1.f + (a[i] - 1.f) * P.k_a[c0 + i]); b[i] = kk[i] * a[i]; c1 += b[i] * r[i]; c2 += kp[i] * r[i]; bo += r[i] * kp[i] * P.r_k[c0 + i]; }
                c1 += shx<1>(c1); c2 += shx<1>(c2); bo += shx<1>(bo); c1 += shx<2>(c1); c2 += shx<2>(c2); bo += shx<2>(bo); c1 += shx<4>(c1); c2 += shx<4>(c2); bo += shx<4>(bo);
                *(v4u*)(recb) = pack8(kk); *(v4u*)(recb + 128) = pack8(b); *(v4u*)(recb + 256) = pack8(kp);
                if ((lane & 7) == 0) P.RBON[t * 8 + hh] = bo;
            }
#pragma unroll
            for (int tk = 0; tk < 4; ++tk) *(v4u*)(P.RG + (size_t)(t0 + tk) * MW + c0) = *(const LAS v4u*)(OG + (4 * wave + tk) * OS + c0);
            __syncthreads();
        }
    }
}
constexpr int SC_STEPS = 32, SC_BUF = SC_STEPS * RREC * 4;
__device__ __forceinline__ void rwkv_scan_role(Frame& F, const float* RW, float* YRAW, int head, int quarter) {
    const int tid = F.tid, lane = F.lane, j16 = lane & 15, rr = lane >> 4;
    const int row = 16 * quarter + 4 * (F.wave & 3) + rr;
    const bool active = F.wave < 4;
    const float* src = RW + (size_t)head * SEQ * RREC;
    LAS unsigned char* buf0 = F.lds + RING_OFF;
    constexpr int NPIECE = SC_BUF / 16, NIT = (NPIECE + 511) / 512;
    f32x4 st[NIT];
#pragma unroll
    for (int i = 0; i < NIT; ++i) { const int p = tid + 512 * i; if (p < NPIECE) *(LAS f32x4*)(buf0 + 16 * p) = *(const f32x4*)(src + 4 * p); }
    __syncthreads();
    float s0 = 0.f, s1 = 0.f, s2 = 0.f, s3 = 0.f, ybuf = 0.f;
    constexpr int NCH = SEQ / SC_STEPS;
    for (int c = 0; c < NCH; ++c) {
        const LAS unsigned char* cur = buf0 + (c & 1) * SC_BUF; LAS unsigned char* nxt = buf0 + ((c + 1) & 1) * SC_BUF;
        if (c + 1 < NCH) {
#pragma unroll
            for (int i = 0; i < NIT; ++i) { const int p = tid + 512 * i; if (p < NPIECE) st[i] = *(const f32x4*)(src + (size_t)(c + 1) * (SC_BUF / 4) + 4 * p); }
        }
        if (active) {
        const LAS unsigned char* rp = cur + 16 * j16;
        f32x4 kk = *(const LAS f32x4*)(rp), bb = *(const LAS f32x4*)(rp + 256), ww = *(const LAS f32x4*)(rp + 512), kp = *(const LAS f32x4*)(rp + 768), wr = *(const LAS f32x4*)(rp + 1024);
        float vv = *(const LAS float*)(cur + 1280 + 4 * row); float c1 = *(const LAS float*)(cur + 1536), c2 = *(const LAS float*)(cur + 1540);
#pragma unroll 4
        for (int s = 0; s < SC_STEPS; ++s) {
            const LAS unsigned char* np_ = cur + ((s + 1) & (SC_STEPS - 1)) * (RREC * 4) + 16 * j16; const LAS unsigned char* nb_ = cur + ((s + 1) & (SC_STEPS - 1)) * (RREC * 4);
            const f32x4 nkk = *(const LAS f32x4*)(np_), nbb = *(const LAS f32x4*)(np_ + 256), nww = *(const LAS f32x4*)(np_ + 512), nkp = *(const LAS f32x4*)(np_ + 768), nwr = *(const LAS f32x4*)(np_ + 1024);
            const float nvv = *(const LAS float*)(nb_ + 1280 + 4 * row), nc1 = *(const LAS float*)(nb_ + 1536), nc2 = *(const LAS float*)(nb_ + 1540);
            float d1 = s0 * kk[0] + s1 * kk[1] + (s2 * kk[2] + s3 * kk[3]);
            float d2 = s0 * wr[0] + s1 * wr[1] + (s2 * wr[2] + s3 * wr[3]);
            d1 = row16_sum(d1); d2 = row16_sum(d2);
            const float sa = -d1;
            s0 = fmaf(sa, bb[0], fmaf(s0, ww[0], vv * kp[0])); s1 = fmaf(sa, bb[1], fmaf(s1, ww[1], vv * kp[1]));
            s2 = fmaf(sa, bb[2], fmaf(s2, ww[2], vv * kp[2])); s3 = fmaf(sa, bb[3], fmaf(s3, ww[3], vv * kp[3]));
            const float y = d2 + sa * c1 + vv * c2;
            ybuf = (j16 == (s & 15)) ? y : ybuf;
            if ((s & 15) == 15) YRAW[(size_t)(c * SC_STEPS + (s & ~15) + j16) * MW + head * 64 + row] = ybuf;
            kk = nkk; bb = nbb; ww = nww; kp = nkp; wr = nwr; vv = nvv; c1 = nc1; c2 = nc2;
        }
        }
        if (c + 1 < NCH) {
#pragma unroll
            for (int i = 0; i < NIT; ++i) { const int p = tid + 512 * i; if (p < NPIECE) *(LAS f32x4*)(nxt + 16 * p) = st[i]; }
        }
        __syncthreads();
    }
}
constexpr int CK_TILE = 64 * LDT * 2;
constexpr int CK_Q = 0, CK_K = 2 * CK_TILE, CK_VT = 4 * CK_TILE, CK_KT = 6 * CK_TILE, CK_S = 8 * CK_TILE, CK_STB = 9 * CK_TILE, CK_OF = 10 * CK_TILE, CK_G = CK_OF + 64 * 68 * 4, CK_NV = CK_G + 2 * 1280, CK_END = CK_NV + 512;
__device__ __forceinline__ f32x4 mma64(f32x4 acc, const LAS bf16* A, const LAS bf16* B, int fr, int fq) {
#pragma unroll
    for (int ks = 0; ks < 2; ++ks) { const bf16x8 a = *(const LAS bf16x8*)(A + fr * LDT + ks * 32 + fq * 8), b = *(const LAS bf16x8*)(B + fr * LDT + ks * 32 + fq * 8);
        acc = __builtin_amdgcn_mfma_f32_16x16x32_bf16(a, b, acc, 0, 0, 0); }
    return acc;
}
__device__ __forceinline__ int swz(int row, int chunk) { return row * LDT + ((chunk ^ ((row >> 3) & 7)) << 3); }
template <bool SA, bool SB> __device__ __forceinline__ f32x4 mma64s(f32x4 acc, const LAS bf16* A, int ra, const LAS bf16* B, int rbw, int fr, int fq) {
#pragma unroll
    for (int ks = 0; ks < 2; ++ks) { const int ch = ks * 4 + fq;
        const bf16x8 a = *(const LAS bf16x8*)(A + (SA ? swz(ra + fr, ch) : (ra + fr) * LDT + ch * 8)), b = *(const LAS bf16x8*)(B + (SB ? swz(rbw + fr, ch) : (rbw + fr) * LDT + ch * 8));
        acc = __builtin_amdgcn_mfma_f32_16x16x32_bf16(a, b, acc, 0, 0, 0); }
    return acc;
}
template <int MODE> __device__ __forceinline__ void chunk_role(Frame& F, const bf16* Qp, const bf16* Kp, const bf16* Vp, const bf16* Gp, const float* gain, bf16* Y, int head, const float* MBC, const float* MA) {
    const int tid = F.tid, lane = F.lane, wave = F.wave, row = tid >> 3, seg = tid & 7, rb = wave >> 1, cb0 = 2 * (wave & 1), fr = lane & 15, fq = lane >> 4;
    LAS unsigned char* L = F.lds + RING_OFF;
    LAS bf16* Ss = (LAS bf16*)(L + CK_S); LAS bf16* STb = (LAS bf16*)(L + CK_STB); LAS float* Of = (LAS float*)(L + CK_OF); LAS float* NV = (LAS float*)(L + CK_NV);
    const float log2g = (MODE == 0) ? log2f(1.f - exp2f(-5.f - (float)head)) : 0.f;
    for (int i = tid; i < 64 * LDT / 2; i += 512) ((LAS unsigned*)STb)[i] = 0u;
    if (tid < 128) NV[tid] = 0.f;
    if (MODE == 0 && tid < 128) { LAS float* G = (LAS float*)(L + CK_G) + (tid >> 6) * 320; G[192 + (tid & 63)] = exp2f((float)(63 - (tid & 63)) * log2g); }
    f32x4 st0 = {0.f, 0.f, 0.f, 0.f}, st1 = {0.f, 0.f, 0.f, 0.f};
    const size_t gofs = (size_t)head * 64 + 8 * seg;
    v4u q8, k8, v8, g8;
    { const size_t t = row; q8 = *(const v4u*)(Qp + t * MW + gofs); k8 = *(const v4u*)(Kp + t * MW + gofs); v8 = *(const v4u*)(Vp + t * ZW + gofs); g8 = *(const v4u*)(Gp + t * ZW + gofs); }
    float gn[8];
#pragma unroll
    for (int i = 0; i < 8; ++i) gn[i] = gain[gofs + i];
    float a_n = 0.f, bc_n = 0.f;
    if (MODE == 1 && wave == 0) { a_n = MA[(size_t)head * SEQ + lane]; bc_n = MBC[(size_t)head * SEQ + lane]; }
    for (int c = 0; c < 128; ++c) {
        const int bsel = c & 1;
        { LAS bf16* Qs = (LAS bf16*)(L + CK_Q + bsel * CK_TILE); LAS bf16* Ks = (LAS bf16*)(L + CK_K + bsel * CK_TILE); LAS bf16* VT = (LAS bf16*)(L + CK_VT + bsel * CK_TILE); LAS bf16* KT = (LAS bf16*)(L + CK_KT + bsel * CK_TILE);
          *(LAS v4u*)(Qs + row * LDT + 8 * seg) = q8; *(LAS v4u*)(Ks + row * LDT + 8 * seg) = k8;
          const unsigned kw[4] = {k8.x, k8.y, k8.z, k8.w}, vw[4] = {v8.x, v8.y, v8.z, v8.w};
#pragma unroll
          for (int i = 0; i < 4; ++i) { const int c_ = ((((row >> 3) ^ seg) & 7) << 3) + (row & 7), r0 = (8 * seg + 2 * i) * LDT + c_, r1 = r0 + LDT;
              KT[r0] = (bf16)(kw[i] & 0xffffu); KT[r1] = (bf16)(kw[i] >> 16); VT[r0] = (bf16)(vw[i] & 0xffffu); VT[r1] = (bf16)(vw[i] >> 16); }
          if (MODE == 1 && wave == 0) { LAS float* G = (LAS float*)(L + CK_G) + bsel * 320; const LAS float* Gp_ = (const LAS float*)(L + CK_G) + (bsel ^ 1) * 320;
              const float a = a_n, bc = bc_n; if (c + 1 < 128) { a_n = MA[(size_t)head * SEQ + 64 * (c + 1) + lane]; bc_n = MBC[(size_t)head * SEQ + 64 * (c + 1) + lane]; }
              const float mp = (c == 0) ? 0.f : Gp_[256];
              const float Mi = fmaxf(mp, wave_incl_max(a, lane)); const float M63 = rdlane(Mi, 63);
              G[lane] = a; G[64 + lane] = Mi; G[128 + lane] = bc; G[192 + lane] = __expf(a - M63);
              if (lane == 63) { G[256] = bc + Mi; G[257] = mp; } }
        }
        const v4u gcur = g8;
        if (c + 1 < 128) { const size_t t = (size_t)64 * (c + 1) + row; q8 = *(const v4u*)(Qp + t * MW + gofs); k8 = *(const v4u*)(Kp + t * MW + gofs); v8 = *(const v4u*)(Vp + t * ZW + gofs); g8 = *(const v4u*)(Gp + t * ZW + gofs); }
        asm volatile("s_waitcnt lgkmcnt(0)\n\ts_barrier" ::: "memory");
        const LAS bf16* Qs = (const LAS bf16*)(L + CK_Q + bsel * CK_TILE); const LAS bf16* Ks = (const LAS bf16*)(L + CK_K + bsel * CK_TILE); const LAS bf16* VT = (const LAS bf16*)(L + CK_VT + bsel * CK_TILE); const LAS bf16* KT = (const LAS bf16*)(L + CK_KT + bsel * CK_TILE);
        const LAS float* G = (const LAS float*)(L + CK_G) + bsel * 320;
        const float mp = (MODE == 1) ? G[257] : 0.f;
        f32x4 o0, o1;
        {
            const f32x4 z4 = {0.f, 0.f, 0.f, 0.f};
#pragma unroll
            for (int ct = 0; ct < 2; ++ct) { const int cb = cb0 + ct; f32x4 sc = mma64(z4, Qs + 16 * rb * LDT, Ks + 16 * cb * LDT, fr, fq);
                const int j = 16 * cb + fr; const float aj = (MODE == 1) ? G[j] : 0.f;
#pragma unroll
                for (int e = 0; e < 4; ++e) { const int i = 16 * rb + 4 * fq + e; float d;
                    if (MODE == 0) d = exp2f((float)(i > j ? i - j : j - i) * log2g); else d = (j <= i) ? __expf(aj - G[64 + i]) : 0.f;
                    Ss[i * LDT + j] = (bf16)f2bf(sc[e] * d); } }
            o0 = mma64(z4, Qs + 16 * rb * LDT, STb + 16 * cb0 * LDT, fr, fq); o1 = mma64(z4, Qs + 16 * rb * LDT, STb + 16 * (cb0 + 1) * LDT, fr, fq);
#pragma unroll
            for (int e = 0; e < 4; ++e) { const int i = 16 * rb + 4 * fq + e; const float sc = (MODE == 0) ? exp2f((float)(i + 1) * log2g) : __expf(mp - G[64 + i]); o0[e] *= sc; o1[e] *= sc; }
            const float dec = (MODE == 0) ? exp2f(64.f * log2g) : __expf(mp - G[64 + 63]);
            st0 *= dec; st1 *= dec;
#pragma unroll
            for (int ks = 0; ks < 2; ++ks) { float a8[8]; unpack8(*(const LAS v4u*)(VT + swz(16 * rb + fr, ks * 4 + fq)), a8);
                const f32x4 w0 = *(const LAS f32x4*)(G + 192 + ks * 32 + fq * 8), w1 = *(const LAS f32x4*)(G + 192 + ks * 32 + fq * 8 + 4);
                a8[0] *= w0[0]; a8[1] *= w0[1]; a8[2] *= w0[2]; a8[3] *= w0[3]; a8[4] *= w1[0]; a8[5] *= w1[1]; a8[6] *= w1[2]; a8[7] *= w1[3];
                const bf16x8 a = __builtin_bit_cast(bf16x8, pack8(a8));
                const bf16x8 b0 = *(const LAS bf16x8*)(KT + swz(16 * cb0 + fr, ks * 4 + fq)), b1 = *(const LAS bf16x8*)(KT + swz(16 * (cb0 + 1) + fr, ks * 4 + fq));
                st0 = __builtin_amdgcn_mfma_f32_16x16x32_bf16(a, b0, st0, 0, 0, 0); st1 = __builtin_amdgcn_mfma_f32_16x16x32_bf16(a, b1, st1, 0, 0, 0); }
        }
        asm volatile("s_waitcnt lgkmcnt(0)\n\ts_barrier" ::: "memory");
        o0 = mma64s<false, true>(o0, Ss, 16 * rb, VT, 16 * cb0, fr, fq); o1 = mma64s<false, true>(o1, Ss, 16 * rb, VT, 16 * (cb0 + 1), fr, fq);
#pragma unroll
        for (int e = 0; e < 4; ++e) { const int r_ = 16 * rb + 4 * fq + e;
            STb[r_ * LDT + 16 * cb0 + fr] = (bf16)f2bf(st0[e]); STb[r_ * LDT + 16 * (cb0 + 1) + fr] = (bf16)f2bf(st1[e]);
            Of[r_ * 68 + 16 * cb0 + fr] = o0[e]; Of[r_ * 68 + 16 * (cb0 + 1) + fr] = o1[e]; }
        asm volatile("s_waitcnt lgkmcnt(0)\n\ts_barrier" ::: "memory");
        {
            float o[8]; { const f32x4 a = *(const LAS f32x4*)(Of + row * 68 + 8 * seg), b = *(const LAS f32x4*)(Of + row * 68 + 8 * seg + 4); o[0] = a[0]; o[1] = a[1]; o[2] = a[2]; o[3] = a[3]; o[4] = b[0]; o[5] = b[1]; o[6] = b[2]; o[7] = b[3]; }
            float gz[8]; unpack8(gcur, gz);
            if (MODE == 1) {
                float s8[8], q8f[8]; unpack8(*(const LAS v4u*)(Ss + row * LDT + 8 * seg), s8); unpack8(*(const LAS v4u*)(Qs + row * LDT + 8 * seg), q8f);
                const LAS float* nv = NV + bsel * 64 + 8 * seg; float ds = 0.f, nq = 0.f;
#pragma unroll
                for (int i = 0; i < 8; ++i) { ds += s8[i]; nq += nv[i] * q8f[i]; }
                ds += shx<1>(ds); nq += shx<1>(nq); ds += shx<2>(ds); nq += shx<2>(nq); ds += shx<4>(ds); nq += shx<4>(nq);
                const float Mi = G[64 + row], den = ds + __expf(mp - Mi) * nq, dn = fmaxf(fabsf(den), __expf(-(G[128 + row] + Mi))), inv = 1.f / dn;
#pragma unroll
                for (int i = 0; i < 8; ++i) o[i] = o[i] * inv * sigmoidf_(gz[i]);
                float k8f[8]; unpack8(*(const LAS v4u*)(KT + swz(row, seg)), k8f); float ns = 0.f;
#pragma unroll
                for (int i = 0; i < 8; ++i) ns += k8f[i] * G[192 + 8 * seg + i];
                ns += shx<1>(ns); ns += shx<2>(ns); ns += shx<4>(ns);
                if (seg == 0) NV[(bsel ^ 1) * 64 + row] = __expf(mp - G[64 + 63]) * NV[bsel * 64 + row] + ns;
            }
            float ss = 0.f;
#pragma unroll
            for (int i = 0; i < 8; ++i) ss += o[i] * o[i];
            ss += shx<1>(ss); ss += shx<2>(ss); ss += shx<4>(ss);
            const float rs = 1.f / sqrtf(ss * (1.f / 64.f) + 1e-6f);
#pragma unroll
            for (int i = 0; i < 8; ++i) { o[i] = o[i] * rs * gn[i]; if (MODE == 0) o[i] *= siluf_(gz[i]); }
            *(v4u*)(Y + ((size_t)64 * c + row) * MW + gofs) = pack8(o);
        }
    }
    __syncthreads();
}
constexpr int RC_B = 64 * LDT * 2;
constexpr int RC_KT = 0, RC_KH = RC_B, RC_BH = 2 * RC_B, RC_RT = 3 * RC_B, RC_KTT = 4 * RC_B, RC_KHT = 5 * RC_B, RC_BHT = 6 * RC_B, RC_VT = 7 * RC_B, RC_M = 8 * RC_B, RC_QKT = 9 * RC_B, RC_QBT = 10 * RC_B, RC_UL = 11 * RC_B;
constexpr int RC_NF = 12 * RC_B, RC_GC = RC_NF + 64 * 68 * 4, RC_END = RC_GC + 256;
constexpr int RC_TT = RC_KT, RC_MTT = RC_KH, RC_W1 = RC_BH, RC_RQS = RC_M, RC_PCS = RC_KT;
static_assert(RC_END <= RING_BYTES, "chunked rwkv LDS map");
struct RwkvC { const float* RW; bf16* RQT; bf16* PCT; float* YLT; float* SL; float* GCV; bf16* SALL; };
__device__ __forceinline__ f32x4 mma64g(f32x4 acc, const LAS bf16* A, const bf16* Bg, int ldb, int fr, int fq) {
#pragma unroll
    for (int ks = 0; ks < 2; ++ks) { const bf16x8 a = *(const LAS bf16x8*)(A + fr * LDT + ks * 32 + fq * 8), b = *(const bf16x8*)(Bg + (size_t)fr * ldb + ks * 32 + fq * 8);
        acc = __builtin_amdgcn_mfma_f32_16x16x32_bf16(a, b, acc, 0, 0, 0); }
    return acc;
}
__device__ __forceinline__ void rwkv_r1(Frame& F, const RwkvC& R) {
    const int tid = F.tid, lane = F.lane, wave = F.wave, fr = lane & 15, fq = lane >> 4, rb = wave >> 1, cb0 = 2 * (wave & 1);
    LAS unsigned char* L = F.lds + RING_OFF;
    LAS float* NF = (LAS float*)(L + RC_NF); LAS float* GC = (LAS float*)(L + RC_GC);
    const f32x4 z4 = {0.f, 0.f, 0.f, 0.f};
    v4u nkk, nb_, nkp, nr, nv; f32x4 nl0, nl1;
#define R1_LOAD(PI) do { const unsigned char* rb_ = (const unsigned char*)(R.RW + ((size_t)((PI) >> 7) * SEQ + 64 * ((PI) & 127) + lane) * RREC) + 16 * wave; \
        nkk = *(const v4u*)(rb_); nb_ = *(const v4u*)(rb_ + 128); nkp = *(const v4u*)(rb_ + 256); nr = *(const v4u*)(rb_ + 384); nv = *(const v4u*)(rb_ + 512); \
        nl0 = *(const f32x4*)(rb_ + 640 + 16 * wave); nl1 = *(const f32x4*)(rb_ + 656 + 16 * wave); } while (0)
    if (F.vcu < NH * 128) R1_LOAD(F.vcu);
    for (int pi = F.vcu; pi < NH * 128; pi += F.G) {
        const int h = pi >> 7, c = pi & 127;
        {
            float kk[8], b[8], lw[8], kp[8], r[8], v[8];
            unpack8(nkk, kk); unpack8(nb_, b); unpack8(nkp, kp); unpack8(nr, r); unpack8(nv, v);
            lw[0] = nl0[0]; lw[1] = nl0[1]; lw[2] = nl0[2]; lw[3] = nl0[3]; lw[4] = nl1[0]; lw[5] = nl1[1]; lw[6] = nl1[2]; lw[7] = nl1[3];
            if (pi + F.G < NH * 128) R1_LOAD(pi + F.G);
            float kt[8], kh[8], bh[8], rt[8];
#pragma unroll
            for (int e = 0; e < 8; ++e) { const float g = wave_incl_scan(lw[e], lane); const float eg = __expf(g), egi = __expf(-g), ege = __expf(g - lw[e]);
                kt[e] = kk[e] * ege; kh[e] = kp[e] * egi; bh[e] = b[e] * egi; rt[e] = r[e] * eg; if (lane == 63) GC[8 * wave + e] = eg; }
            const v4u pkt = pack8(kt), pkh = pack8(kh), pbh = pack8(bh), prt = pack8(rt), pv = pack8(v);
            *(LAS v4u*)(L + RC_KT + (lane * LDT + 8 * wave) * 2) = pkt; *(LAS v4u*)(L + RC_KH + (lane * LDT + 8 * wave) * 2) = pkh;
            *(LAS v4u*)(L + RC_BH + (lane * LDT + 8 * wave) * 2) = pbh; *(LAS v4u*)(L + RC_RT + (lane * LDT + 8 * wave) * 2) = prt;
            const unsigned wkt[4] = {pkt.x, pkt.y, pkt.z, pkt.w}, wkh[4] = {pkh.x, pkh.y, pkh.z, pkh.w}, wbh[4] = {pbh.x, pbh.y, pbh.z, pbh.w}, wv[4] = {pv.x, pv.y, pv.z, pv.w};
#pragma unroll
            for (int i = 0; i < 4; ++i) { const int k0 = (8 * wave + 2 * i) * LDT + lane, k1 = k0 + LDT;
                ((LAS bf16*)(L + RC_KTT))[k0] = (bf16)(wkt[i] & 0xffffu); ((LAS bf16*)(L + RC_KTT))[k1] = (bf16)(wkt[i] >> 16);
                ((LAS bf16*)(L + RC_KHT))[k0] = (bf16)(wkh[i] & 0xffffu); ((LAS bf16*)(L + RC_KHT))[k1] = (bf16)(wkh[i] >> 16);
                ((LAS bf16*)(L + RC_BHT))[k0] = (bf16)(wbh[i] & 0xffffu); ((LAS bf16*)(L + RC_BHT))[k1] = (bf16)(wbh[i] >> 16);
                ((LAS bf16*)(L + RC_VT))[k0] = (bf16)(wv[i] & 0xffffu); ((LAS bf16*)(L + RC_VT))[k1] = (bf16)(wv[i] >> 16); }
        }
        __syncthreads();
        {
            const LAS bf16* Kt = (const LAS bf16*)(L + RC_KT); const LAS bf16* Kh = (const LAS bf16*)(L + RC_KH); const LAS bf16* Bh = (const LAS bf16*)(L + RC_BH); const LAS bf16* Rt = (const LAS bf16*)(L + RC_RT);
#pragma unroll
            for (int ct = 0; ct < 2; ++ct) { const int cb = cb0 + ct;
                const f32x4 n4 = mma64(z4, Bh + 16 * rb * LDT, Kt + 16 * cb * LDT, fr, fq), m4 = mma64(z4, Kh + 16 * rb * LDT, Kt + 16 * cb * LDT, fr, fq);
                const f32x4 qk4 = mma64(z4, Kh + 16 * rb * LDT, Rt + 16 * cb * LDT, fr, fq), qb4 = mma64(z4, Bh + 16 * rb * LDT, Rt + 16 * cb * LDT, fr, fq);
                const int i = 16 * cb + fr;
#pragma unroll
                for (int e = 0; e < 4; ++e) { const int j = 16 * rb + 4 * fq + e;
                    NF[j * 68 + i] = (j < i) ? n4[e] : 0.f;
                    ((LAS bf16*)(L + RC_M))[j * LDT + i] = (bf16)f2bf((j < i) ? m4[e] : 0.f);
                    ((LAS bf16*)(L + RC_QKT))[i * LDT + j] = (bf16)f2bf((j <= i) ? qk4[e] : 0.f);
                    ((LAS bf16*)(L + RC_QBT))[i * LDT + j] = (bf16)f2bf((j <= i) ? qb4[e] : 0.f); } }
        }
        __syncthreads();
        {
            const int r = tid >> 3, p = tid & 7; float t[8];
#pragma unroll
            for (int m = 0; m < 8; ++m) t[m] = 0.f;
#pragma unroll
            for (int io = 0; io < 8; ++io)
#pragma unroll
                for (int ii = 0; ii < 8; ++ii) { const int i = 8 * io + ii; float a = 0.f;
#pragma unroll
                    for (int m = 0; m <= io; ++m) a += t[m] * NF[(8 * m + p) * 68 + i];
                    a = dpp_add<0xB1>(a); a = dpp_add<0x4E>(a); a = dpp_add<0x141>(a);
                    const float val = ((i == r) ? 1.f : 0.f) - a; if (p == ii) t[io] = val; }
#pragma unroll
            for (int m = 0; m < 8; ++m) ((LAS bf16*)(L + RC_TT))[(8 * m + p) * LDT + r] = (bf16)f2bf(t[m]);
        }
        __syncthreads();
        {
            const LAS bf16* KtT = (const LAS bf16*)(L + RC_KTT); const LAS bf16* Tt = (const LAS bf16*)(L + RC_TT); const LAS bf16* Mm = (const LAS bf16*)(L + RC_M);
#pragma unroll
            for (int ct = 0; ct < 2; ++ct) { const int cb = cb0 + ct; const f32x4 w4 = mma64(z4, KtT + 16 * rb * LDT, Tt + 16 * cb * LDT, fr, fq), mt4 = mma64(z4, Mm + 16 * rb * LDT, Tt + 16 * cb * LDT, fr, fq);
                const int i = 16 * cb + fr;
#pragma unroll
                for (int e = 0; e < 4; ++e) { const int j = 16 * rb + 4 * fq + e; ((LAS bf16*)(L + RC_W1))[j * LDT + i] = (bf16)f2bf(w4[e]); ((LAS bf16*)(L + RC_MTT))[i * LDT + j] = (bf16)f2bf(mt4[e]); } }
        }
        __syncthreads();
        {
            const LAS bf16* VT = (const LAS bf16*)(L + RC_VT); const LAS bf16* MTt = (const LAS bf16*)(L + RC_MTT);
#pragma unroll
            for (int ct = 0; ct < 2; ++ct) { const int cb = cb0 + ct; const f32x4 u4 = mma64(z4, VT + 16 * rb * LDT, MTt + 16 * cb * LDT, fr, fq); const int i = 16 * cb + fr;
#pragma unroll
                for (int e = 0; e < 4; ++e) ((LAS bf16*)(L + RC_UL))[(16 * rb + 4 * fq + e) * LDT + i] = (bf16)f2bf(u4[e]); }
        }
        __syncthreads();
        {
            const LAS bf16* W1 = (const LAS bf16*)(L + RC_W1); const LAS bf16* Qbt = (const LAS bf16*)(L + RC_QBT); const LAS bf16* Qkt = (const LAS bf16*)(L + RC_QKT); const LAS bf16* Ul = (const LAS bf16*)(L + RC_UL);
            const LAS bf16* VT = (const LAS bf16*)(L + RC_VT); const LAS bf16* KhT = (const LAS bf16*)(L + RC_KHT); const LAS bf16* BhT = (const LAS bf16*)(L + RC_BHT); const LAS bf16* Rt = (const LAS bf16*)(L + RC_RT);
            float* slg = R.SL + (size_t)pi * 4096;
#pragma unroll
            for (int ct = 0; ct < 2; ++ct) { const int cb = cb0 + ct, cc = 16 * cb + fr;
                const f32x4 a_rq = mma64(z4, W1 + 16 * rb * LDT, Qbt + 16 * cb * LDT, fr, fq);
                const f32x4 a_y1 = mma64(z4, VT + 16 * rb * LDT, Qkt + 16 * cb * LDT, fr, fq), a_y2 = mma64(z4, Ul + 16 * rb * LDT, Qbt + 16 * cb * LDT, fr, fq);
                const f32x4 a_pc = mma64(z4, W1 + 16 * rb * LDT, BhT + 16 * cb * LDT, fr, fq);
                const f32x4 a_s1 = mma64(z4, VT + 16 * rb * LDT, KhT + 16 * cb * LDT, fr, fq), a_s2 = mma64(z4, Ul + 16 * rb * LDT, BhT + 16 * cb * LDT, fr, fq);
                const float gc = GC[cc];
#pragma unroll
                for (int e = 0; e < 4; ++e) { const int rr = 16 * rb + 4 * fq + e;
                    const float rtv = __builtin_bit_cast(float, (unsigned)Rt[cc * LDT + rr] << 16);
                    ((LAS bf16*)(L + RC_RQS))[cc * LDT + rr] = (bf16)f2bf(rtv - a_rq[e]);
                    NF[cc * 68 + rr] = a_y1[e] - a_y2[e];
                    ((LAS bf16*)(L + RC_PCS))[cc * LDT + rr] = (bf16)f2bf(a_pc[e] * gc);
                    slg[rr * 64 + cc] = (a_s1[e] - a_s2[e]) * gc; }
            }
        }
        __syncthreads();
        {
            const int row = tid >> 3, seg = tid & 7;
            *(v4u*)(R.RQT + (size_t)pi * 4096 + row * 64 + 8 * seg) = *(const LAS v4u*)(L + RC_RQS + (row * LDT + 8 * seg) * 2);
            *(v4u*)(R.PCT + (size_t)pi * 4096 + row * 64 + 8 * seg) = *(const LAS v4u*)(L + RC_PCS + (row * LDT + 8 * seg) * 2);
            *(f32x4*)(R.YLT + (size_t)pi * 4096 + row * 64 + 8 * seg) = *(const LAS f32x4*)(NF + row * 68 + 8 * seg);
            *(f32x4*)(R.YLT + (size_t)pi * 4096 + row * 64 + 8 * seg + 4) = *(const LAS f32x4*)(NF + row * 68 + 8 * seg + 4);
            if (tid < 64) R.GCV[pi * 64 + tid] = GC[tid];
        }
        __syncthreads();
    }
}
__device__ __forceinline__ void rwkv_r2(Frame& F, const RwkvC& R, int head) {
    const int lane = F.lane, wave = F.wave, fr = lane & 15, fq = lane >> 4, rb = wave >> 1, cb0 = 2 * (wave & 1);
    LAS bf16* Sb = (LAS bf16*)(F.lds + RING_OFF);
    f32x4 s0 = {0.f, 0.f, 0.f, 0.f}, s1 = {0.f, 0.f, 0.f, 0.f};
    for (int c = 0; c < 128; ++c) {
        const int pi = head * 128 + c; LAS bf16* sb = Sb + (c & 1) * 64 * LDT; bf16* sg = R.SALL + (size_t)pi * 4096;
        const bf16* pc = R.PCT + (size_t)pi * 4096; const float* sl = R.SL + (size_t)pi * 4096; const float* gcv = R.GCV + pi * 64;
        bf16x8 b0[2], b1[2];
#pragma unroll
        for (int ks = 0; ks < 2; ++ks) { b0[ks] = *(const bf16x8*)(pc + (size_t)(16 * cb0 + fr) * 64 + ks * 32 + fq * 8); b1[ks] = *(const bf16x8*)(pc + (size_t)(16 * (cb0 + 1) + fr) * 64 + ks * 32 + fq * 8); }
        float l0[4], l1[4]; const float g0 = gcv[16 * cb0 + fr], g1 = gcv[16 * (cb0 + 1) + fr];
#pragma unroll
        for (int e = 0; e < 4; ++e) { const int d = 16 * rb + 4 * fq + e; l0[e] = sl[d * 64 + 16 * cb0 + fr]; l1[e] = sl[d * 64 + 16 * (cb0 + 1) + fr]; }
#pragma unroll
        for (int e = 0; e < 4; ++e) { const int d = 16 * rb + 4 * fq + e; const bf16 h0 = (bf16)f2bf(s0[e]), h1 = (bf16)f2bf(s1[e]);
            sb[d * LDT + 16 * cb0 + fr] = h0; sb[d * LDT + 16 * (cb0 + 1) + fr] = h1; sg[d * 64 + 16 * cb0 + fr] = h0; sg[d * 64 + 16 * (cb0 + 1) + fr] = h1; }
        __syncthreads();
        f32x4 p0 = {0.f, 0.f, 0.f, 0.f}, p1 = {0.f, 0.f, 0.f, 0.f};
#pragma unroll
        for (int ks = 0; ks < 2; ++ks) { const bf16x8 a = *(const LAS bf16x8*)(sb + (16 * rb + fr) * LDT + ks * 32 + fq * 8);
            p0 = __builtin_amdgcn_mfma_f32_16x16x32_bf16(a, b0[ks], p0, 0, 0, 0); p1 = __builtin_amdgcn_mfma_f32_16x16x32_bf16(a, b1[ks], p1, 0, 0, 0); }
#pragma unroll
        for (int e = 0; e < 4; ++e) { s0[e] = s0[e] * g0 - p0[e] + l0[e]; s1[e] = s1[e] * g1 - p1[e] + l1[e]; }
    }
    __syncthreads();
}
__device__ __forceinline__ void rwkv_r3(Frame& F, const RwkvC& R, const float* RBON, const bf16* RG, const float* gnw, const float* gnb, bf16* YB) {
    const int tid = F.tid, lane = F.lane, wave = F.wave, fr = lane & 15, fq = lane >> 4, rb = wave >> 1, cb0 = 2 * (wave & 1), row = tid >> 3, seg = tid & 7;
    LAS float* Of = (LAS float*)(F.lds + RING_OFF);
    for (int pi = F.vcu; pi < NH * 128; pi += F.G) {
        const int h = pi >> 7, c = pi & 127; const bf16* rq = R.RQT + (size_t)pi * 4096; const bf16* sa = R.SALL + (size_t)pi * 4096; const float* yl = R.YLT + (size_t)pi * 4096;
        f32x4 y0 = {0.f, 0.f, 0.f, 0.f}, y1 = {0.f, 0.f, 0.f, 0.f};
#pragma unroll
        for (int ks = 0; ks < 2; ++ks) { const bf16x8 a = *(const bf16x8*)(rq + (size_t)(16 * rb + fr) * 64 + ks * 32 + fq * 8);
            const bf16x8 b0 = *(const bf16x8*)(sa + (size_t)(16 * cb0 + fr) * 64 + ks * 32 + fq * 8), b1 = *(const bf16x8*)(sa + (size_t)(16 * (cb0 + 1) + fr) * 64 + ks * 32 + fq * 8);
            y0 = __builtin_amdgcn_mfma_f32_16x16x32_bf16(a, b0, y0, 0, 0, 0); y1 = __builtin_amdgcn_mfma_f32_16x16x32_bf16(a, b1, y1, 0, 0, 0); }
#pragma unroll
        for (int e = 0; e < 4; ++e) { const int i = 16 * rb + 4 * fq + e; Of[i * 68 + 16 * cb0 + fr] = y0[e] + yl[i * 64 + 16 * cb0 + fr]; Of[i * 68 + 16 * (cb0 + 1) + fr] = y1[e] + yl[i * 64 + 16 * (cb0 + 1) + fr]; }
        __syncthreads();
        {   const int t = 64 * c + row, c0 = h * 64 + 8 * seg;
            const f32x4 ya = *(const LAS f32x4*)(Of + row * 68 + 8 * seg), yb = *(const LAS f32x4*)(Of + row * 68 + 8 * seg + 4);
            float y[8] = {ya[0], ya[1], ya[2], ya[3], yb[0], yb[1], yb[2], yb[3]};
            float s = 0.f;
#pragma unroll
            for (int i = 0; i < 8; ++i) s += y[i];
            s += shx<1>(s); s += shx<2>(s); s += shx<4>(s);
            const float mu = s * (1.f / 64.f); float q = 0.f;
#pragma unroll
            for (int i = 0; i < 8; ++i) { y[i] -= mu; q += y[i] * y[i]; }
            q += shx<1>(q); q += shx<2>(q); q += shx<4>(q);
            const float rs = __builtin_amdgcn_rsqf(q * (1.f / 64.f) + 64e-5f);
            float v[8]; unpack8(*(const v4u*)((const unsigned char*)(R.RW + ((size_t)h * SEQ + t) * RREC) + 512 + 16 * seg), v);
            const float bon = RBON[t * 8 + h];
            float g[8]; unpack8(*(const v4u*)(RG + (size_t)t * MW + c0), g);
            float o[8];
#pragma unroll
            for (int i = 0; i < 8; ++i) o[i] = (y[i] * rs * gnw[c0 + i] + gnb[c0 + i] + bon * v[i]) * g[i];
            *(v4u*)(YB + (size_t)t * MW + c0) = pack8(o);
        }
        __syncthreads();
    }
}
struct ChunkG {
    const bf16 *Qr, *Kr, *Qm, *Km, *Z; const float *gr, *gm; bf16 *Yr, *Ym;
    const float *MBC, *MA, *MAX, *MBL; float *MCG, *KV, *NVC, *NB; bf16* SB;
};
__device__ __forceinline__ void mc_scan(Frame& F, const ChunkG& G, LAS float* MC, bool write_global) {
    const int h = F.wave, lane = F.lane;
    const float b0 = G.MBL[h * 128 + 2 * lane], b1 = G.MBL[h * 128 + 2 * lane + 1], d0 = G.MAX[h * 128 + 2 * lane] + b0, d1 = G.MAX[h * 128 + 2 * lane + 1] + b1;
    float B = b0 + b1, D = fmaxf(d0 + b1, d1);
#pragma unroll
    for (int o = 1; o < 64; o <<= 1) { const float pb = bperm((lane - o) & 63, B), pd = bperm((lane - o) & 63, D); if (lane >= o) { D = fmaxf(pd + B, D); B = pb + B; } }
    const float m_after = fmaxf(B, D);
    const float up = bperm((lane - 1) & 63, m_after); const float m_even = (lane == 0) ? 0.f : up, m_odd = fmaxf(m_even + b0, d0);
    MC[h * 128 + 2 * lane] = m_even; MC[h * 128 + 2 * lane + 1] = m_odd;
    if (write_global) { G.MCG[h * 128 + 2 * lane] = m_even; G.MCG[h * 128 + 2 * lane + 1] = m_odd; }
}
__device__ __forceinline__ void chunk_x1(Frame& F, const ChunkG& G) {
    const int tid = F.tid, lane = F.lane, wave = F.wave, row = tid >> 3, seg = tid & 7, rb = wave >> 1, cb0 = 2 * (wave & 1), fr = lane & 15, fq = lane >> 4;
    LAS unsigned char* L = F.lds + RING_OFF;
    LAS bf16* VT = (LAS bf16*)(L + CK_VT); LAS bf16* KT = (LAS bf16*)(L + CK_KT); LAS float* WJ = (LAS float*)(L + CK_G); LAS float* MC = (LAS float*)(L + CK_OF);
    mc_scan(F, G, MC, F.vcu == 0);
    __syncthreads();
    for (int p2 = F.vcu; p2 < 2 * NH * 128; p2 += F.G) {
        const int br = p2 >> 10, pi = p2 & 1023, h = pi >> 7, c = pi & 127; const size_t t = (size_t)64 * c + row, gofs = (size_t)h * 64 + 8 * seg;
        const v4u k8 = *(const v4u*)((br ? G.Km : G.Kr) + t * MW + gofs), v8 = *(const v4u*)(G.Z + t * ZW + (br ? ZC_MV : ZC_TV) + gofs);
        if (tid < 64) { float w;
            if (br == 0) w = exp2f((float)(63 - tid) * log2f(1.f - exp2f(-5.f - (float)h)));
            else w = __expf(G.MA[(size_t)h * SEQ + 64 * c + tid] - fmaxf(MC[h * 128 + c], G.MAX[h * 128 + c]));
            WJ[tid] = w; }
        const unsigned kw[4] = {k8.x, k8.y, k8.z, k8.w}, vw[4] = {v8.x, v8.y, v8.z, v8.w};
#pragma unroll
        for (int i = 0; i < 4; ++i) { const int c_ = ((((row >> 3) ^ seg) & 7) << 3) + (row & 7), r0 = (8 * seg + 2 * i) * LDT + c_, r1 = r0 + LDT;
            KT[r0] = (bf16)(kw[i] & 0xffffu); KT[r1] = (bf16)(kw[i] >> 16); VT[r0] = (bf16)(vw[i] & 0xffffu); VT[r1] = (bf16)(vw[i] >> 16); }
        asm volatile("s_waitcnt lgkmcnt(0)\n\ts_barrier" ::: "memory");
        f32x4 st0 = {0.f, 0.f, 0.f, 0.f}, st1 = {0.f, 0.f, 0.f, 0.f};
#pragma unroll
        for (int ks = 0; ks < 2; ++ks) { float a8[8]; unpack8(*(const LAS v4u*)(VT + swz(16 * rb + fr, ks * 4 + fq)), a8);
            const f32x4 w0 = *(const LAS f32x4*)(WJ + ks * 32 + fq * 8), w1 = *(const LAS f32x4*)(WJ + ks * 32 + fq * 8 + 4);
            a8[0] *= w0[0]; a8[1] *= w0[1]; a8[2] *= w0[2]; a8[3] *= w0[3]; a8[4] *= w1[0]; a8[5] *= w1[1]; a8[6] *= w1[2]; a8[7] *= w1[3];
            const bf16x8 a = __builtin_bit_cast(bf16x8, pack8(a8));
            const bf16x8 b0 = *(const LAS bf16x8*)(KT + swz(16 * cb0 + fr, ks * 4 + fq)), b1 = *(const LAS bf16x8*)(KT + swz(16 * (cb0 + 1) + fr, ks * 4 + fq));
            st0 = __builtin_amdgcn_mfma_f32_16x16x32_bf16(a, b0, st0, 0, 0, 0); st1 = __builtin_amdgcn_mfma_f32_16x16x32_bf16(a, b1, st1, 0, 0, 0); }
        float* kv = G.KV + (size_t)p2 * 4096;
#pragma unroll
        for (int e = 0; e < 4; ++e) { const int v = 16 * rb + 4 * fq + e; kv[v * 64 + 16 * cb0 + fr] = st0[e]; kv[v * 64 + 16 * (cb0 + 1) + fr] = st1[e]; }
        if (br == 1) { float k8f[8]; unpack8(*(const LAS v4u*)(KT + swz(row, seg)), k8f); float ns = 0.f;
#pragma unroll
            for (int i = 0; i < 8; ++i) ns += k8f[i] * WJ[8 * seg + i];
            ns += shx<1>(ns); ns += shx<2>(ns); ns += shx<4>(ns);
            if (seg == 0) G.NVC[pi * 64 + row] = ns; }
        asm volatile("s_waitcnt lgkmcnt(0)\n\ts_barrier" ::: "memory");
    }
}
__device__ __forceinline__ void chunk_x2(Frame& F, const ChunkG& G, int br, int h) {
    const int tid = F.tid; LAS float* DEC = (LAS float*)(F.lds + RING_OFF);
    if (tid < 128) DEC[tid] = br ? __expf(G.MCG[h * 128 + tid] - fmaxf(G.MCG[h * 128 + tid], G.MAX[h * 128 + tid])) : exp2f(64.f * log2f(1.f - exp2f(-5.f - (float)h)));
    __syncthreads();
    float S[8] = {0.f, 0.f, 0.f, 0.f, 0.f, 0.f, 0.f, 0.f}; float N = 0.f;
    const size_t base = ((size_t)br * 1024 + h * 128) * 4096 + 8 * tid;
#pragma unroll 4
    for (int c = 0; c < 128; ++c) {
        const float* kv = G.KV + base + (size_t)c * 4096; const f32x4 a = *(const f32x4*)kv, b = *(const f32x4*)(kv + 4); const float dec = DEC[c];
        *(v4u*)(G.SB + base + (size_t)c * 4096) = pack8(S);
        S[0] = dec * S[0] + a[0]; S[1] = dec * S[1] + a[1]; S[2] = dec * S[2] + a[2]; S[3] = dec * S[3] + a[3]; S[4] = dec * S[4] + b[0]; S[5] = dec * S[5] + b[1]; S[6] = dec * S[6] + b[2]; S[7] = dec * S[7] + b[3];
        if (br == 1 && tid < 64) { const int pi = h * 128 + c; G.NB[pi * 64 + tid] = N; N = dec * N + G.NVC[pi * 64 + tid]; }
    }
    __syncthreads();
}
__device__ __forceinline__ void chunk_x3(Frame& F, const ChunkG& G) {
    const int tid = F.tid, lane = F.lane, wave = F.wave, row = tid >> 3, seg = tid & 7, rb = wave >> 1, cb0 = 2 * (wave & 1), fr = lane & 15, fq = lane >> 4;
    LAS unsigned char* L = F.lds + RING_OFF;
    LAS bf16* Qs = (LAS bf16*)(L + CK_Q); LAS bf16* Ks = (LAS bf16*)(L + CK_K); LAS bf16* VT = (LAS bf16*)(L + CK_VT);
    LAS bf16* Ss = (LAS bf16*)(L + CK_S); LAS bf16* STb = (LAS bf16*)(L + CK_STB); LAS float* Of = (LAS float*)(L + CK_OF); LAS float* Gt = (LAS float*)(L + CK_G); LAS float* NV = (LAS float*)(L + CK_NV);
    const f32x4 z4 = {0.f, 0.f, 0.f, 0.f};
    v4u q8n, k8n, v8n, s8n, g8n; float an = 0.f, bcn = 0.f, mpn = 0.f, nbn = 0.f;
#define X3_LOAD(P2) do { const int br_ = (P2) >> 10, pi_ = (P2) & 1023, h_ = pi_ >> 7, c_ = pi_ & 127; const size_t t_ = (size_t)64 * c_ + row, go_ = (size_t)h_ * 64 + 8 * seg; \
        q8n = *(const v4u*)((br_ ? G.Qm : G.Qr) + t_ * MW + go_); k8n = *(const v4u*)((br_ ? G.Km : G.Kr) + t_ * MW + go_); v8n = *(const v4u*)(G.Z + t_ * ZW + (br_ ? ZC_MV : ZC_TV) + go_); \
        s8n = *(const v4u*)(G.SB + (size_t)(P2) * 4096 + row * 64 + 8 * seg); g8n = *(const v4u*)(G.Z + t_ * ZW + (br_ ? ZC_MO : ZC_TG) + go_); \
        if (br_ == 1 && wave == 0) { an = G.MA[(size_t)h_ * SEQ + 64 * c_ + lane]; bcn = G.MBC[(size_t)h_ * SEQ + 64 * c_ + lane]; mpn = G.MCG[h_ * 128 + c_]; } \
        if (br_ == 1 && wave == 1) nbn = G.NB[pi_ * 64 + lane]; } while (0)
    if (F.vcu < 2 * NH * 128) X3_LOAD(F.vcu);
    for (int p2 = F.vcu; p2 < 2 * NH * 128; p2 += F.G) {
        const int br = p2 >> 10, pi = p2 & 1023, h = pi >> 7, c = pi & 127; const size_t t = (size_t)64 * c + row, gofs = (size_t)h * 64 + 8 * seg;
        const float log2g = log2f(1.f - exp2f(-5.f - (float)h));
        {
            const v4u q8 = q8n, k8 = k8n, v8 = v8n, s8 = s8n;
            *(LAS v4u*)(Qs + row * LDT + 8 * seg) = q8; *(LAS v4u*)(Ks + row * LDT + 8 * seg) = k8; *(LAS v4u*)(STb + row * LDT + 8 * seg) = s8;
            const unsigned vw[4] = {v8.x, v8.y, v8.z, v8.w};
#pragma unroll
            for (int i = 0; i < 4; ++i) { const int c_ = ((((row >> 3) ^ seg) & 7) << 3) + (row & 7), r0 = (8 * seg + 2 * i) * LDT + c_; VT[r0] = (bf16)(vw[i] & 0xffffu); VT[r0 + LDT] = (bf16)(vw[i] >> 16); }
            if (br == 1 && wave == 0) { const float a = an, bc = bcn, mp = mpn;
                const float Mi = fmaxf(mp, wave_incl_max(a, lane)); Gt[lane] = a; Gt[64 + lane] = Mi; Gt[128 + lane] = bc; if (lane == 0) Gt[257] = mp; }
            if (br == 1 && wave == 1) NV[lane] = nbn;
        }
        const v4u gcur = g8n;
        if (p2 + F.G < 2 * NH * 128) X3_LOAD(p2 + F.G);
        asm volatile("s_waitcnt lgkmcnt(0)\n\ts_barrier" ::: "memory");
        const float mp = br ? Gt[257] : 0.f;
        f32x4 o0, o1;
        {
#pragma unroll
            for (int ct = 0; ct < 2; ++ct) { const int cb = cb0 + ct; f32x4 sc = mma64(z4, Qs + 16 * rb * LDT, Ks + 16 * cb * LDT, fr, fq);
                const int j = 16 * cb + fr; const float aj = br ? Gt[j] : 0.f;
#pragma unroll
                for (int e = 0; e < 4; ++e) { const int i = 16 * rb + 4 * fq + e; float d;
                    if (br == 0) d = exp2f((float)(i > j ? i - j : j - i) * log2g); else d = (j <= i) ? __expf(aj - Gt[64 + i]) : 0.f;
                    Ss[i * LDT + j] = (bf16)f2bf(sc[e] * d); } }
            o0 = mma64(z4, Qs + 16 * rb * LDT, STb + 16 * cb0 * LDT, fr, fq); o1 = mma64(z4, Qs + 16 * rb * LDT, STb + 16 * (cb0 + 1) * LDT, fr, fq);
#pragma unroll
            for (int e = 0; e < 4; ++e) { const int i = 16 * rb + 4 * fq + e; const float sc = (br == 0) ? exp2f((float)(i + 1) * log2g) : __expf(mp - Gt[64 + i]); o0[e] *= sc; o1[e] *= sc; }
        }
        asm volatile("s_waitcnt lgkmcnt(0)\n\ts_barrier" ::: "memory");
        o0 = mma64s<false, true>(o0, Ss, 16 * rb, VT, 16 * cb0, fr, fq); o1 = mma64s<false, true>(o1, Ss, 16 * rb, VT, 16 * (cb0 + 1), fr, fq);
#pragma unroll
        for (int e = 0; e < 4; ++e) { const int r_ = 16 * rb + 4 * fq + e; Of[r_ * 68 + 16 * cb0 + fr] = o0[e]; Of[r_ * 68 + 16 * (cb0 + 1) + fr] = o1[e]; }
        asm volatile("s_waitcnt lgkmcnt(0)\n\ts_barrier" ::: "memory");
        {
            float o[8]; { const f32x4 a = *(const LAS f32x4*)(Of + row * 68 + 8 * seg), b = *(const LAS f32x4*)(Of + row * 68 + 8 * seg + 4); o[0] = a[0]; o[1] = a[1]; o[2] = a[2]; o[3] = a[3]; o[4] = b[0]; o[5] = b[1]; o[6] = b[2]; o[7] = b[3]; }
            float gz[8]; unpack8(gcur, gz);
            if (br == 1) {
                float s8f[8], q8f[8]; unpack8(*(const LAS v4u*)(Ss + row * LDT + 8 * seg), s8f); unpack8(*(const LAS v4u*)(Qs + row * LDT + 8 * seg), q8f);
                float ds = 0.f, nq = 0.f;
#pragma unroll
                for (int i = 0; i < 8; ++i) { ds += s8f[i]; nq += NV[8 * seg + i] * q8f[i]; }
                ds += shx<1>(ds); nq += shx<1>(nq); ds += shx<2>(ds); nq += shx<2>(nq); ds += shx<4>(ds); nq += shx<4>(nq);
                const float Mi = Gt[64 + row], den = ds + __expf(mp - Mi) * nq, dn = fmaxf(fabsf(den), __expf(-(Gt[128 + row] + Mi))), inv = __builtin_amdgcn_rcpf(dn);
#pragma unroll
                for (int i = 0; i < 8; ++i) o[i] = o[i] * inv * sigmoidf_(gz[i]);
            }
            float ss = 0.f;
#pragma unroll
            for (int i = 0; i < 8; ++i) ss += o[i] * o[i];
            ss += shx<1>(ss); ss += shx<2>(ss); ss += shx<4>(ss);
            const float rs = __builtin_amdgcn_rsqf(ss * (1.f / 64.f) + 1e-6f); const float* gn = (br ? G.gm : G.gr) + gofs;
#pragma unroll
            for (int i = 0; i < 8; ++i) { o[i] = o[i] * rs * gn[i]; if (br == 0) o[i] *= siluf_(gz[i]); }
            *(v4u*)((br ? G.Ym : G.Yr) + t * MW + gofs) = pack8(o);
        }
        asm volatile("s_waitcnt lgkmcnt(0)\n\ts_barrier" ::: "memory");
    }
#undef X3_LOAD
}
#if DBG
__device__ __forceinline__ unsigned dh(unsigned x) { x ^= x >> 16; x *= 0x7feb352du; x ^= x >> 15; x *= 0x846ca68bu; x ^= x >> 16; return x; }
__device__ __forceinline__ float b2f(bf16 v) { return __builtin_bit_cast(float, (unsigned)v << 16); }
__device__ __forceinline__ float rbf(float f) { return __builtin_bit_cast(float, f2bf(f) << 16); }
__device__ __forceinline__ void dflag(unsigned* flags, int idx, float err, float tol) { if (!(err <= tol)) { atomicOr(&flags[idx], 1u); atomicMax(&flags[32 + idx], __float_as_uint(fminf(fabsf(err), 1e30f))); } }
__device__ __forceinline__ float ddot(const bf16* a, const bf16* b, int K) { float s = 0.f; for (int k = 0; k < K; ++k) s += b2f(a[k]) * b2f(b[k]); return s; }
__global__ void k_check(Args args, int which, int l) {
    const int sid = blockIdx.x * blockDim.x + threadIdx.x; unsigned char* ws = args.ws; unsigned* flags = (unsigned*)(ws + WS_CTL) + 2048;
    const unsigned h1 = dh(sid * 2654435761u + which * 97u), h2 = dh(h1 + 12345u);
    const int row = h1 % SEQ; unsigned char* wl = ws + WS_W + (size_t)l * WL_BYTES;
    const bf16* XN = (const bf16*)(ws + WS_XN); const bf16* Z = (const bf16*)(ws + WS_Z); const bf16* HID = (const bf16*)(ws + WS_HID); const bf16* GATES = (const bf16*)(ws + WS_GATES);
    const float* SNAP = (const float*)(ws + WS_END);
    if (which == 1) {
        const int n = h1 % (2 * DFF), k = h2 % DM, tile = n >> 8, within = n & 255; const float* w = args.in[within < 128 ? I_F1W1 : I_F1W3] + (size_t)l * DM * DFF;
        const float ref = rbf(w[(size_t)k * DFF + tile * 128 + (within & 127)]); const float got = b2f(((const bf16*)(wl + WL_W13A))[(size_t)n * DM + k]);
        dflag(flags, which, fabsf(ref - got), 0.f);
        const int n2 = h1 % ZW; const int sc = win_src(n2); const float r2 = sc >= 0 ? rbf((args.in[I_WIN] + (size_t)l * DM * 7960)[(size_t)k * 7960 + sc]) : 0.f; dflag(flags, which, fabsf(r2 - b2f(((const bf16*)(wl + WL_WIN))[(size_t)n2 * DM + k])), 0.f);
        const int k2 = h2 % DFF, n3 = h1 % DM; dflag(flags, which, fabsf(rbf((args.in[I_F1W2] + (size_t)l * DFF * DM)[(size_t)k2 * DM + n3]) - b2f(((const bf16*)(wl + WL_W2A))[(size_t)n3 * DFF + k2])), 0.f);
        const int nb = h2 % 4, kb = h1 % MW; dflag(flags, which, fabsf(rbf((args.in[I_WB] + ((size_t)l * 4 + nb) * MW * DM)[(size_t)kb * DM + n3]) - b2f(((const bf16*)(wl + WL_WB))[((size_t)nb * DM + n3) * MW + kb])), 0.f);
        dflag(flags, which, fabsf(rbf((args.in[I_WO] + (size_t)l * DM * DM)[(size_t)k * DM + n3]) - b2f(((const bf16*)(wl + WL_WO))[(size_t)n3 * DM + k])), 0.f);
        const int n4 = h1 % (4 * DM); dflag(flags, which, fabsf(rbf((args.in[I_WG] + (size_t)l * DM * 4 * DM)[(size_t)k * 4 * DM + n4]) - b2f(((const bf16*)(wl + WL_WG))[(size_t)n4 * DM + k])), 0.f);
    }
    if (which == 2 || which == 5) {
        const float* x = (which == 2) ? args.in[I_X] : args.out; const float* g = args.in[which == 2 ? I_F1N : I_MIXN] + (size_t)l * DM;
        float ss = 0.f; for (int k = 0; k < DM; ++k) { const float v = x[(size_t)row * DM + k]; ss += v * v; }
        const float rs = 1.f / sqrtf(ss / DM + 1e-6f); const int c = h2 % DM; const float ref = x[(size_t)row * DM + c] * rs * g[c];
        dflag(flags, which, fabsf(ref - b2f(XN[(size_t)row * DM + c])), 0.02f * fabsf(ref) + 0.01f);
    }
    if (which == 3) {
        const int c = h2 % DFF, tile = c >> 7, w_ = c & 127; const bf16* B = (const bf16*)(wl + WL_W13A);
        const float a = ddot(XN + (size_t)row * DM, B + (size_t)(tile * 256 + w_) * DM, DM), b = ddot(XN + (size_t)row * DM, B + (size_t)(tile * 256 + 128 + w_) * DM, DM);
        const float ref = a / (1.f + expf(-a)) * b; dflag(flags, which, fabsf(ref - b2f(HID[(size_t)row * DFF + c])), 0.02f * fabsf(ref) + 0.02f);
    }
    if (which == 4) {
        const int c = h2 % DM; const float ref = args.in[I_X][(size_t)row * DM + c] + 0.5f * ddot(HID + (size_t)row * DFF, (const bf16*)(wl + WL_W2A) + (size_t)c * DFF, DFF);
        dflag(flags, which, fabsf(ref - args.out[(size_t)row * DM + c]), 0.01f * fabsf(ref) + 0.01f);
    }
    if (which == 6) {
        const int c = (sid & 1) ? (7936 + h2 % 24) : (h2 % ZW); const float ref = ddot(XN + (size_t)row * DM, (const bf16*)(wl + WL_WIN) + (size_t)c * DM, DM);
        dflag(flags, which, fabsf(ref - b2f(Z[(size_t)row * ZW + c])), 0.02f * fabsf(ref) + 0.02f);
    }
    if (which == 7) {
        const int c = h2 % (4 * DM); const float a = ddot(XN + (size_t)row * DM, (const bf16*)(wl + WL_WG) + (size_t)c * DM, DM) + (args.in[I_WGB] + (size_t)l * 4 * DM)[c];
#if DBG_RAWGATE
        const float ref = a - ((DBG_RAWGATE == 2) ? 0.f : (args.in[I_WGB] + (size_t)l * 4 * DM)[c]); dflag(flags, which, fabsf(ref - b2f(GATES[(size_t)row * 4 * DM + c])), 0.02f * fabsf(ref) + 0.02f);
#else
        const float ref = 1.f / (1.f + expf(-a)); dflag(flags, which, fabsf(ref - b2f(GATES[(size_t)row * 4 * DM + c])), 0.02f);
#endif
    }
    if (which == 8) {
        const int c = h2 % DM; float ref = 0.f;
        const bf16* Y[4] = {(const bf16*)(ws + WS_YF), (const bf16*)(ws + WS_YB), (const bf16*)(ws + WS_YR), (const bf16*)(ws + WS_YM)};
        for (int n = 0; n < 4; ++n) ref += b2f(GATES[(size_t)row * 4 * DM + n * DM + c]) * ddot(Y[n] + (size_t)row * MW, (const bf16*)(wl + WL_WB) + ((size_t)n * DM + c) * MW, MW);
        dflag(flags, which, fabsf(ref - b2f(((const bf16*)(ws + WS_MRGB))[(size_t)row * DM + c])), 0.02f * fabsf(ref) + 0.03f);
    }
    if (which == 9) {
        const int c = h2 % DM; const float ref = SNAP[(size_t)row * DM + c] + ddot((const bf16*)(ws + WS_MRGB) + (size_t)row * DM, (const bf16*)(wl + WL_WO) + (size_t)c * DM, DM);
        dflag(flags, which, fabsf(ref - args.out[(size_t)row * DM + c]), 0.01f * fabsf(ref) + 0.01f);
    }
}
__global__ void k_report(Args args) {
    const size_t i = (size_t)blockIdx.x * blockDim.x + threadIdx.x; const unsigned* flags = (const unsigned*)(args.ws + WS_CTL) + 2048;
    if (i < (size_t)SEQ * DM) { float v = args.in[I_X][i];
        if (i == 0) { int first = 0; for (int k = 31; k >= 1; --k) if (flags[k]) first = k; float me = __uint_as_float(flags[32 + first]); int d = (int)(me * 10.f); d = d > 9 ? 9 : (d < 0 ? 0 : d); v += 1000.f * first + (first ? 100.f * d : 0.f); }
        args.out[i] = v; }
}
#endif
__device__ __forceinline__ void post_phase(Frame& F, const float* YRAW, const float* RW, const float* RBON, const bf16* RG, const float* gnw, const float* gnb, bf16* YB) {
    const int gw = F.vcu * NWAVES + F.wave, NGW = F.G * NWAVES, lane = F.lane, hh = lane >> 3, c0 = 8 * lane;
    float gw8[8], gb8[8];
#pragma unroll
    for (int i = 0; i < 8; ++i) { gw8[i] = gnw[c0 + i]; gb8[i] = gnb[c0 + i]; }
    for (int t = gw; t < SEQ; t += NGW) {
        const f32x4 ya = *(const f32x4*)(YRAW + (size_t)t * MW + c0), yb = *(const f32x4*)(YRAW + (size_t)t * MW + c0 + 4);
        float y[8] = {ya[0], ya[1], ya[2], ya[3], yb[0], yb[1], yb[2], yb[3]};
        float s = 0.f;
#pragma unroll
        for (int i = 0; i < 8; ++i) s += y[i];
        s += shx<1>(s); s += shx<2>(s); s += shx<4>(s);
        const float mu = s * (1.f / 64.f); float q = 0.f;
#pragma unroll
        for (int i = 0; i < 8; ++i) { y[i] -= mu; q += y[i] * y[i]; }
        q += shx<1>(q); q += shx<2>(q); q += shx<4>(q);
        const float rs = 1.f / sqrtf(q * (1.f / 64.f) + 64e-5f);
        const float* rec = RW + ((size_t)hh * SEQ + t) * RREC + 320 + 8 * (lane & 7);
        const f32x4 va = *(const f32x4*)rec, vb = *(const f32x4*)(rec + 4); const float v[8] = {va[0], va[1], va[2], va[3], vb[0], vb[1], vb[2], vb[3]};
        const float bon = RBON[t * 8 + hh];
        float g[8]; unpack8(*(const v4u*)(RG + (size_t)t * MW + c0), g);
        float o[8];
#pragma unroll
        for (int i = 0; i < 8; ++i) o[i] = (y[i] * rs * gw8[i] + gb8[i] + bon * v[i]) * g[i];
        *(v4u*)(YB + (size_t)t * MW + c0) = pack8(o);
    }
}


#ifndef MIX_PRE_R2
#define MIX_PRE_R2 2300
#endif
#ifndef MIX_PRE_CHUNK
#define MIX_PRE_CHUNK 300
#endif
#ifndef MIX_ATT_STEP
#define MIX_ATT_STEP 54
#endif
#ifndef MIX_GATE_UNIT
#define MIX_GATE_UNIT 500
#endif
constexpr int kFoxTiles[8] = {999, 999, 999, 999, 999, 999, 999, 999};
constexpr int att_cost(int r) { const int h = r & 7, qb = 31 - (r >> 3); int tiles = 4 * (qb + 1); const int cap = kFoxTiles[h] + 4; if (tiles > cap) tiles = cap; return MIX_ATT_STEP * tiles / 4; }
constexpr int mix_pre(int j) {
    if (j < 8) return MIX_PRE_R2; if (j < 24) return MIX_PRE_CHUNK;
    const int a = j - 24; int pre = att_cost(a); if (a >= 208) pre += att_cost(463 - a); return pre;
}
constexpr int mix_cnt(int j, int T) { const int x = T - mix_pre(j) + MIX_GATE_UNIT / 2; return x <= 0 ? 0 : x / MIX_GATE_UNIT; }
struct GAssign { short first[257]; };
constexpr GAssign make_gassign() {
    GAssign g{}; int lo = 0, hi = 40000;
    while (lo < hi) { const int mid = (lo + hi + 1) / 2; int s = 0; for (int j = 0; j < 256; ++j) s += mix_cnt(j, mid); if (s <= 1024) lo = mid; else hi = mid - 1; }
    int cnt[256] = {}; int s = 0; for (int j = 0; j < 256; ++j) { cnt[j] = mix_cnt(j, lo); s += cnt[j]; }
    for (int j = 255; s < 1024; j = (j == 24) ? 255 : j - 1) { cnt[j] += 1; s += 1; }
    int acc = 0; for (int j = 0; j < 256; ++j) { g.first[j] = (short)acc; acc += cnt[j]; } g.first[256] = (short)acc;
    return g;
}
__device__ const GAssign kGAssign = make_gassign();
static_assert(make_gassign().first[256] == 1024, "gate units");
#ifndef PHMASK
#define PHMASK 1023
#endif
#ifndef YMASK
#define YMASK 0
#endif
#ifndef GATES_IN_ZG
#define GATES_IN_ZG 0
#endif
enum { K_PRO = 0, K_NORM, K_UP, K_DOWN, K_ZG, K_PREP, K_MIX, K_POST, K_MERGE, K_OUTP, K_R1, K_NKIND };
__host__ __device__ __forceinline__ void phase_decode(int p, int& kind, int& l, int& sel) {
    if (p == 0) { kind = K_PRO; l = 0; sel = 0; return; }
    const int q = (p - 1) % PH_PER_LAYER; l = (p - 1) / PH_PER_LAYER;
    switch (q) {
        case 0: kind = K_UP; sel = 0; break; case 1: kind = K_DOWN; sel = 0; break;
        case 2: kind = K_ZG; sel = 0; break; case 3: kind = K_PREP; sel = 0; break; case 4: kind = K_R1; sel = 0; break; case 5: kind = K_MIX; sel = 0; break;
        case 6: kind = K_POST; sel = 0; break; case 7: kind = K_MERGE; sel = 0; break; case 8: kind = K_OUTP; sel = 0; break;
        case 9: kind = K_UP; sel = 1; break; default: kind = K_DOWN; sel = 1; break;
    }
}
static_assert(offsetof(Args, ws) == KARG_WS_OFF, "Args::ws offset");
typedef const __attribute__((address_space(4))) Args* ArgP;
struct ArgsView { ArgP p; __device__ __forceinline__ const float* operator[](int i) const { return p->in[i]; } };
__device__ __forceinline__ void frame_fill(Frame& F, unsigned char* lds, unsigned char* ws) {
    int tid_ = threadIdx.x; asm volatile("; opaque tid" : "+v"(tid_));
    F.lds = (LAS unsigned char*)lds; F.MISC = (volatile LAS unsigned*)(F.lds + MISC_OFF);
    F.tid = tid_; F.lane = F.tid & 63; F.wave = __builtin_amdgcn_readfirstlane(F.tid >> 6);
    int bx = blockIdx.x, G = gridDim.x; asm volatile("; opaque bx" : "+s"(bx), "+s"(G));
    F.G = G; F.vcu = (G % 8 == 0) ? (bx % 8) * (G / 8) + bx / 8 : bx; F.bx = bx;
    F.ws = ws; F.ctl = (gu32*)(ws + WS_CTL);
}
template <int KIND> __device__ __forceinline__ void run_phase(unsigned char* lds_, int l_, int sel_) {
    ArgP pa = (ArgP)__builtin_amdgcn_kernarg_segment_ptr(); asm volatile("; opaque kernarg" : "+s"(pa));
    int l = l_, sel = sel_; asm volatile("; opaque l" : "+s"(l), "+s"(sel));
    struct { ArgsView in; float* out; unsigned char* ws; } args; args.in.p = pa; args.out = pa->out; args.ws = pa->ws;
    Frame F; frame_fill(F, lds_, args.ws);
    unsigned char* ws = args.ws; float* OUT = args.out; const int bx = F.bx;
    bf16* XN = (bf16*)(ws + WS_XN); bf16* Z = (bf16*)(ws + WS_Z); bf16* HID = (bf16*)(ws + WS_HID); bf16* GATES = (bf16*)(ws + WS_GATES);
    unsigned char* wl = ws + WS_W + (size_t)l * WL_BYTES;
    bf16 *FQ = (bf16*)(ws + WS_FQ), *FK = (bf16*)(ws + WS_FK), *YF = (bf16*)(ws + WS_YF), *RQ = (bf16*)(ws + WS_RQ), *RK = (bf16*)(ws + WS_RK), *YR = (bf16*)(ws + WS_YR);
    bf16 *FV = (bf16*)(ws + WS_FV), *FO = (bf16*)(ws + WS_FO), *TV = (bf16*)(ws + WS_TV), *TG = (bf16*)(ws + WS_TG), *MV = (bf16*)(ws + WS_MV), *MO = (bf16*)(ws + WS_MO);
    bf16 *MQ = (bf16*)(ws + WS_MQ), *MK = (bf16*)(ws + WS_MK), *YM = (bf16*)(ws + WS_YM), *YB = (bf16*)(ws + WS_YB), *RG = (bf16*)(ws + WS_RG), *MRGB = (bf16*)(ws + WS_MRGB);
    float *RW = (float*)(ws + WS_RW), *YRAW = (float*)(ws + WS_YRAW), *MRGF = (float*)(ws + WS_MRGF);
    RwkvC RC; RC.RW = RW; RC.RQT = (bf16*)(ws + WS_RQT); RC.PCT = (bf16*)(ws + WS_PCT); RC.YLT = (float*)(ws + WS_YLT); RC.SL = (float*)(ws + WS_SL); RC.GCV = (float*)(ws + WS_GCV); RC.SALL = (bf16*)(ws + WS_SALL);
    ChunkG CG; CG.Qr = RQ; CG.Kr = RK; CG.Qm = MQ; CG.Km = MK; CG.Z = Z; CG.gr = args.in[I_TGN] + l * 512; CG.gm = args.in[I_MGN] + l * 512; CG.Yr = YR; CG.Ym = YM;
    CG.MBC = (float*)(ws + WS_SM + SM_MBC); CG.MA = (float*)(ws + WS_SM + SM_MA); CG.MAX = (float*)(ws + WS_SM + SM_MAX); CG.MBL = (float*)(ws + WS_SM + SM_MBL); CG.MCG = (float*)(ws + WS_SM + SM_MCG);
    CG.KV = (float*)(ws + WS_KV); CG.NVC = (float*)(ws + WS_NVC); CG.NB = (float*)(ws + WS_NB); CG.SB = (bf16*)(ws + WS_SB);
    float *RBON = (float*)(ws + WS_SM + SM_RBON), *FP = (float*)(ws + WS_SM + SM_FP), *FT = (float*)(ws + WS_SM + SM_FT), *MBC = (float*)(ws + WS_SM + SM_MBC), *MA = (float*)(ws + WS_SM + SM_MA);
    float* SSB = (float*)(ws + WS_SSP);
    if constexpr (KIND == K_PRO && ((PHMASK >> K_PRO) & 1)) { p0_prologue(F, args.in); xin_phase(F, args.in[I_X], XN, SSB); }
    if constexpr (KIND == K_UP && ((PHMASK >> K_UP) & 1)) { pg8::Gemm g{XN, (const bf16*)(wl + (sel ? WL_W13B : WL_W13A)), SEQ, 2 * DFF, DM}; pg8::StaticOrder S; S.init(SEQ, 2 * DFF, F.G, bx);
        pg8::EpiSwiglu E{HID, DFF, SSB + (size_t)(3 * l + (sel ? 2 : 0)) * 8 * SEQ}; pg8::gemm_phase<pg8::EpiSwiglu, pg8::StaticOrder, true, true>(F.lds + RING_OFF, g, S, E); }
    if constexpr (KIND == K_DOWN && ((PHMASK >> K_DOWN) & 1)) { const float* xcur = (l == 0 && sel == 0) ? args.in[I_X] : OUT;
        pg8::Gemm g{HID, (const bf16*)(wl + (sel ? WL_W2B : WL_W2A)), SEQ, DM, DFF}; pg8::StaticOrder S; S.init(SEQ, DM, F.G, bx);
        pg8::EpiResid E{(l == DEPTH - 1 && sel == 1) ? OUT : nullptr, 3 * l + (sel ? 3 : 1), 0.5f, 0}; pg8::gemm_phase<pg8::EpiResid, pg8::StaticOrder, true, true>(F.lds + RING_OFF, g, S, E); }
    if constexpr (KIND == K_ZG && ((PHMASK >> K_ZG) & 1)) { pg8::Gemm g{XN, (const bf16*)(wl + WL_WIN), SEQ, ZW, DM}; pg8::StaticOrder S; S.init(SEQ, ZW, F.G, bx);
        pg8::EpiStore<0> E{Z, ZW, nullptr, SSB + (size_t)(3 * l + 1) * 8 * SEQ}; pg8::gemm_phase<pg8::EpiStore<0>, pg8::StaticOrder, true, true>(F.lds + RING_OFF, g, S, E);
#if GATES_IN_ZG
        { pg8::Gemm g2{XN, (const bf16*)(wl + WL_WG), SEQ, 4 * DM, DM}; pg8::StaticOrder S2; S2.init(SEQ, 4 * DM, F.G, bx);
          #if DBG_RAWGATE
          pg8::EpiStore<0> E2{GATES, 4 * DM, (DBG_RAWGATE == 2) ? args.in[I_WGB] + (size_t)l * 4 * DM : nullptr, SSB + (size_t)(3 * l + 1) * 8 * SEQ}; pg8::gemm_phase<pg8::EpiStore<0>, pg8::StaticOrder, true, true>(F.lds + RING_OFF, g2, S2, E2); }
#else
          pg8::EpiStore<1> E2{GATES, 4 * DM, args.in[I_WGB] + (size_t)l * 4 * DM, SSB + (size_t)(3 * l + 1) * 8 * SEQ}; pg8::gemm_phase<pg8::EpiStore<1>, pg8::StaticOrder, true, true>(F.lds + RING_OFF, g2, S2, E2); }
#endif
#endif
    }
    if constexpr (KIND == K_PREP && ((PHMASK >> K_PREP) & 1)) {
        PrepP P; P.Z = Z; P.pos = (const int*)args.in[I_POS]; P.w2t = (const bf16*)(ws + WS_LORA) + (size_t)l * 131072; P.a2t = P.w2t + 32768; P.g2t = P.w2t + 65536;
        P.fox_fb = args.in[I_FOXFB] + l * 8; P.fox_qg = args.in[I_FOXQG] + l * 64; P.fox_kg = args.in[I_FOXKG] + l * 64; P.mu = args.in[I_RMU] + l * 1792; P.w0 = args.in[I_RW0] + l * 512;
        P.w2 = args.in[I_RW2] + (size_t)l * 64 * 512; P.a0 = args.in[I_RA0] + l * 512; P.a2 = args.in[I_RA2] + (size_t)l * 64 * 512; P.g2 = args.in[I_RG2] + (size_t)l * 128 * 512;
        P.k_k = args.in[I_RKK] + l * 512; P.k_a = args.in[I_RKA] + l * 512; P.r_k = args.in[I_RRK] + l * 512; P.conv_w = args.in[I_MCW] + l * 4096; P.conv_b = args.in[I_MCB] + l * 1024;
        P.mib = args.in[I_MIB] + l * 8; P.mfb = args.in[I_MFB] + l * 8;
        P.FV = FV; P.FO = FO; P.TV = TV; P.TG = TG; P.MV = MV; P.MO = MO; P.FQ = FQ; P.FK = FK; P.RQ = RQ; P.RK = RK; P.MQ = MQ; P.MK = MK; P.RG = RG; P.RW = RW; P.RBON = RBON; P.FP = FP; P.FT = FT; P.MBC = MBC; P.MA = MA; P.MAX = (float*)(ws + WS_SM + SM_MAX); P.MBL = (float*)(ws + WS_SM + SM_MBL);
        prep_phase(F, P, sel ? sel : 7); }
    if constexpr (KIND == K_MIX && ((PHMASK >> K_MIX) & 1)) {
#ifndef MIXSEL
#define MIXSEL 31
#endif
        const int rm = sel ? sel : 31;
        if (bx < 8) { if (rm & 1) rwkv_r2(F, RC, bx); }
        else if (bx < 24) { if (rm & 6) chunk_x2(F, CG, (bx - 8) >> 3, (bx - 8) & 7); }
        else {
            const int a = bx - 24; char* shm = (char*)(LAS char*)(F.lds + RING_OFF);
            const int nun = (a >= 208) ? 2 : 1;
            if (rm & 8) for (int ui = 0; ui < nun; ++ui) { const int r = ui ? 463 - a : a;
                attn_body::attn_unit<8>(0, r & 7, 31 - (r >> 3), (const attn_body::bf16*)FQ, (const attn_body::bf16*)FK, (const attn_body::bf16*)(Z + ZC_FV), (attn_body::bf16*)YF, FP, FT, (const attn_body::bf16*)(Z + ZC_FO), shm); }
        }
        if ((rm & 16) && !GATES_IN_ZG) {
            const int gfirst = kGAssign.first[bx], gcount = kGAssign.first[bx + 1] - gfirst;
            pg8::Gemm g{XN, (const bf16*)(wl + WL_WG), SEQ, 4 * DM, DM}; pg8::RangeOrder S; S.init(SEQ, 4 * DM, gfirst, gcount);
            pg8::EpiGates E{GATES, 4 * DM, args.in[I_WGB] + (size_t)l * 4 * DM, SSB + (size_t)(3 * l + 1) * 8 * SEQ}; pg8::gemm_phase<pg8::EpiGates, pg8::RangeOrder, true, true>(F.lds + RING_OFF, g, S, E);
        } }
    if constexpr (KIND == K_POST && ((PHMASK >> K_POST) & 1)) { rwkv_r3(F, RC, RBON, RG, args.in[I_RGNW] + l * 512, args.in[I_RGNB] + l * 512, YB); chunk_x3(F, CG); }
    if constexpr (KIND == K_R1) { rwkv_r1(F, RC); chunk_x1(F, CG); }
    if constexpr (KIND == K_MERGE && ((PHMASK >> K_MERGE) & 1)) {
        pg8::StaticOrder S0; S0.init(SEQ, DM, F.G, bx); pg8::Unit u0; S0.next(0, u0);
        pg8::MergeOrder S{u0.pm, u0.pn}; pg8::Gemm g{YF, (const bf16*)(wl + WL_WB), 4 * SEQ, 4 * DM, MW};
        pg8::EpiMergeAll E{GATES, 4 * DM, MRGF, MRGB, DM}; pg8::gemm_phase<pg8::EpiMergeAll, pg8::MergeOrder, true, false>(F.lds + RING_OFF, g, S, E); }
    if constexpr (KIND == K_OUTP && ((PHMASK >> K_OUTP) & 1)) { pg8::Gemm g{MRGB, (const bf16*)(wl + WL_WO), SEQ, DM, DM}; pg8::StaticOrder S; S.init(SEQ, DM, F.G, bx);
        pg8::EpiResid E{nullptr, 3 * l + 2, 1.0f, 0}; pg8::gemm_phase<pg8::EpiResid, pg8::StaticOrder, true, true>(F.lds + RING_OFF, g, S, E); }
}
__device__ __forceinline__ void lds_ctl_zero(unsigned char* lds) {
    for (int u = threadIdx.x; u < (LDS_BYTES - LDSCTL_OFF) / 4; u += NWAVES * 64) ((LAS unsigned*)((LAS unsigned char*)lds + LDSCTL_OFF))[u] = 0u;
    __syncthreads();
}
template <int KIND> __global__ void __launch_bounds__(NWAVES * 64, 2) k_phase(Args args) {
    extern __shared__ __attribute__((aligned(16))) unsigned char lds[];
    lds_ctl_zero(lds);
    run_phase<KIND>(lds, args.ph_lo, args.ph_hi);
}
#if !MK_PER_PHASE
__device__ __forceinline__ void grid_bar(unsigned char* lds) {
    ArgP pa = (ArgP)__builtin_amdgcn_kernarg_segment_ptr(); asm volatile("; opaque kernarg (barrier)" : "+s"(pa));
    XcdBarrier b; b.bar = (unsigned*)((gu32*)(pa->ws + WS_CTL) + CW_BAR); b.x = xb_xcc_id(); b.st = (volatile LAS unsigned*)((LAS unsigned char*)lds + MISC_OFF) + 8;
    xcd_barrier(b);
}
#if DBG_STAMP
#define STAMP_PH(kind) do { if (blockIdx.x == STAMP_BLK && threadIdx.x == 0) { gu32* c_ = (gu32*)(args.ws + WS_CTL); const unsigned now_ = (unsigned)__builtin_amdgcn_s_memrealtime(); c_[3000 + (kind)] += now_ - c_[3040]; c_[3040] = now_; } } while (0)
#define STAMP_BAR(kind) do { if (blockIdx.x == STAMP_BLK && threadIdx.x == 0) { gu32* c_ = (gu32*)(args.ws + WS_CTL); const unsigned now_ = (unsigned)__builtin_amdgcn_s_memrealtime(); c_[3016 + (kind)] += now_ - c_[3040]; c_[3040] = now_; } } while (0)
#else
#define STAMP_PH(kind) do { } while (0)
#define STAMP_BAR(kind) do { } while (0)
#endif
#define PHASE(K, l, s) do { run_phase<K>(lds, l, s); STAMP_PH(K); grid_bar(lds); STAMP_BAR(K); } while (0)
__global__ void __launch_bounds__(NWAVES * 64, 2) mega_fwd(Args args) {
    extern __shared__ __attribute__((aligned(16))) unsigned char lds[];
    lds_ctl_zero(lds);
    (void)xcd_barrier_post((unsigned*)((gu32*)(args.ws + WS_CTL) + CW_BAR), (volatile LAS unsigned*)((LAS unsigned char*)lds + MISC_OFF) + 8);
#if DBG_STAMP
    if (blockIdx.x == STAMP_BLK && threadIdx.x == 0) ((gu32*)(args.ws + WS_CTL))[3040] = (unsigned)__builtin_amdgcn_s_memrealtime();
#endif
    PHASE(K_PRO, 0, 0);
#if PROBE_DUP == 10
    PHASE(K_PRO, 0, 0);
#endif
    for (int l = 0; l < DEPTH; ++l) {
        for (int f = 0; f < 2; ++f) {
            PHASE(K_UP, l, f);
#if PROBE_DUP == 2
            PHASE(K_UP, l, f);
#endif
            PHASE(K_DOWN, l, f);
            if (f == 0) {
                PHASE(K_ZG, l, 0);
#if PROBE_DUP == 4
                PHASE(K_ZG, l, 0);
#endif
                PHASE(K_PREP, l, 0);
#if PROBE_DUP == 5
                PHASE(K_PREP, l, PROBE_ROLE);
#endif
                PHASE(K_R1, l, 0);
#if PROBE_DUP == 11
                PHASE(K_R1, l, 0);
#endif
                PHASE(K_MIX, l, 0);
#if PROBE_DUP == 6
                PHASE(K_MIX, l, PROBE_ROLE);
#endif
                PHASE(K_POST, l, 0);
#if PROBE_DUP == 7
                PHASE(K_POST, l, 0);
#endif
                PHASE(K_MERGE, l, 0);
#if PROBE_DUP == 8
                PHASE(K_MERGE, l, 0);
#endif
                PHASE(K_OUTP, l, 0);
            }
        }
    }
#if DBG_STAMP
    if (blockIdx.x == STAMP_BLK && threadIdx.x == 0) { const gu32* c_ = (const gu32*)(args.ws + WS_CTL); unsigned v_ = 0;
        if (STAMP_SEL < 32) v_ = c_[3000 + STAMP_SEL]; else if (STAMP_SEL == 32) { for (int q = 0; q < 16; ++q) v_ += c_[3000 + q]; } else { for (int q = 16; q < 32; ++q) v_ += c_[3000 + q]; }
        __builtin_amdgcn_s_sleep(10); __threadfence(); args.out[0] = (float)v_; }
#endif
}
#endif

template <int KIND> static void launch_kind(int grid, hipStream_t stream, Args& a) { hipLaunchKernelGGL(k_phase<KIND>, dim3(grid), dim3(NWAVES * 64), LDS_BYTES, stream, a); }
template <int KIND> static bool set_attr() { return hipFuncSetAttribute((const void*)k_phase<KIND>, hipFuncAttributeMaxDynamicSharedMemorySize, LDS_BYTES) == hipSuccess; }
extern "C" void kernel_launch(void* const* d_in, const int* in_sizes, int n_in, void* d_out, int out_size, void* d_ws, size_t ws_size, hipStream_t stream) {
    static int grid = 0;
    if (grid == 0) {
        if (n_in != N_IN || out_size != SEQ * DM || ws_size < WS_END) { fprintf(stderr, "kernel_launch: unexpected shapes: n_in %d out %d ws %zu (need %zu)\n", n_in, out_size, ws_size, (size_t)WS_END); grid = -1; return; }
        int dev = 0, cus = 0;
        if (hipGetDevice(&dev) != hipSuccess || hipDeviceGetAttribute(&cus, hipDeviceAttributeMultiprocessorCount, dev) != hipSuccess) { grid = -1; return; }
#if MK_PER_PHASE
        const bool ok = set_attr<K_PRO>() && set_attr<K_NORM>() && set_attr<K_UP>() && set_attr<K_DOWN>() && set_attr<K_ZG>() && set_attr<K_PREP>() && set_attr<K_MIX>() && set_attr<K_POST>() && set_attr<K_MERGE>() && set_attr<K_OUTP>();
#else
        const bool ok = hipFuncSetAttribute((const void*)mega_fwd, hipFuncAttributeMaxDynamicSharedMemorySize, LDS_BYTES) == hipSuccess;
#endif
        if (!ok) { fprintf(stderr, "kernel_launch: hipFuncSetAttribute failed\n"); grid = -1; return; }
        (void)hipGetLastError();
        if (cus != 256) { fprintf(stderr, "kernel_launch: built for 256 CUs, device has %d\n", cus); grid = -1; return; }
        grid = cus;
    }
    if (grid < 0) return;
    if (hipMemsetAsync((char*)d_ws + WS_CTL, 0, CTL_ZERO_BYTES, stream) != hipSuccess) return;
    Args a{};
    for (int i = 0; i < N_IN; ++i) a.in[i] = (const float*)d_in[i];
    a.out = (float*)d_out; a.ws = (unsigned char*)d_ws;
#if MK_PER_PHASE
#if DBG
    const int dbg_last = DBG_LAST_PHASE;
#else
    const int dbg_last = N_PHASES - 1;
#endif
    for (int p = 0; p <= dbg_last; ++p) { int kind, l, sel; phase_decode(p, kind, l, sel); a.ph_lo = l; a.ph_hi = sel;
#if DBG
        if (kind == K_OUTP) hipMemcpyAsync((char*)d_ws + WS_END, d_out, (size_t)SEQ * DM * 4, hipMemcpyDeviceToDevice, stream);
#endif
        switch (kind) { case K_PRO: launch_kind<K_PRO>(grid, stream, a); break; case K_NORM: launch_kind<K_NORM>(grid, stream, a); break; case K_UP: launch_kind<K_UP>(grid, stream, a); break;
            case K_DOWN: launch_kind<K_DOWN>(grid, stream, a); break; case K_ZG: launch_kind<K_ZG>(grid, stream, a); break; case K_PREP: launch_kind<K_PREP>(grid, stream, a); break;
            case K_MIX: launch_kind<K_MIX>(grid, stream, a); break; case K_POST: launch_kind<K_POST>(grid, stream, a); break; case K_MERGE: launch_kind<K_MERGE>(grid, stream, a); break;
            default: launch_kind<K_OUTP>(grid, stream, a); break; }
#if DBG
        { int chk = 0; const int q = (p == 0) ? -1 : (p - 1) % PH_PER_LAYER;
          if (p == 0) chk = 1; else if (q == 0) chk = 2; else if (q == 1) chk = 3; else if (q == 2) chk = 4; else if (q == 3) chk = 5; else if (q == 4) chk = 6; else if (q == 6) chk = 7; else if (q == 8) chk = 8; else if (q == 9) chk = 9;
          if (chk && l == DBG_LAYER) hipLaunchKernelGGL(k_check, dim3(64), dim3(256), 0, stream, a, chk, l); }
#endif
    }
#if DBG
    hipLaunchKernelGGL(k_report, dim3((SEQ * DM + 255) / 256), dim3(256), 0, stream, a);
#endif
#else
    a.ph_lo = 0; a.ph_hi = N_PHASES;
    hipLaunchKernelGGL(mega_fwd, dim3(grid), dim3(NWAVES * 64), LDS_BYTES, stream, a);
#endif
    const hipError_t le = hipPeekAtLastError();
    if (le != hipSuccess) fprintf(stderr, "kernel_launch: launch failed: %s\n", hipGetErrorName(le));
}
```

```cpp
#include <hip/hip_runtime.h>
#include <hip/hip_bf16.h>
#include <cstdio>
#include <cstdint>
#include <cstddef>
#include <cmath>
#ifndef DBG
#define DBG 0
#endif
#define DBG_LAYER 0
#define DBG_LAST_PHASE 10
#define DBG_RAWGATE 0
#ifndef DBG_STAMP
#define DBG_STAMP 0
#endif
#define STAMP_BLK 0
#define STAMP_SEL 6
#define PROBE_DUP 0
#define PROBE_ROLE 0
constexpr int NWAVES = 8;
#ifndef MK_PER_PHASE
#define MK_PER_PHASE 0
#endif
constexpr int SEQ = 8192, DM = 2048, DFF = 5632, NH = 8, HD = 64, MW = 512, DEPTH = 4, ZW = 8192;
constexpr int PH_PER_LAYER = 11, N_PHASES = 1 + DEPTH * PH_PER_LAYER;
constexpr int ZC_FQ = 0, ZC_FK = 512, ZC_FV = 1024, ZC_FO = 1536, ZC_RR = 2048, ZC_RK = 2560, ZC_RV = 3072, ZC_RL = 3584;
constexpr int ZC_TQ = 3840, ZC_TK = 4352, ZC_TV = 4864, ZC_TG = 5376, ZC_MQK = 5888, ZC_MV = 6912, ZC_MO = 7424, ZC_FF = 7936, ZC_MI = 7944, ZC_MF = 7952;
enum { I_X = 0, I_POS, I_F1N, I_F1W1, I_F1W3, I_F1W2, I_MIXN, I_WIN, I_FOXFB, I_FOXQG, I_FOXKG, I_RMU, I_RW0, I_RW2, I_RA0, I_RA2, I_RG2, I_RKK, I_RKA, I_RRK, I_RGNW, I_RGNB,
       I_TGN, I_MCW, I_MCB, I_MIB, I_MFB, I_MGN, I_WG, I_WGB, I_WB, I_WO, I_F2N, I_F2W1, I_F2W3, I_F2W2, N_IN };
constexpr size_t MiB = 1u << 20;
constexpr size_t WS_CTL = 0, CTL_ZERO_BYTES = 1 * MiB;
constexpr size_t WL_W13A = 0, WL_W2A = 44 * MiB, WL_W13B = 66 * MiB, WL_W2B = 110 * MiB, WL_WIN = 132 * MiB, WL_WG = 164 * MiB, WL_WB = 196 * MiB, WL_WO = 204 * MiB, WL_BYTES = 212 * MiB;
constexpr size_t WS_W = 2 * MiB;
constexpr size_t WS_XN = WS_W + DEPTH * WL_BYTES + 2 * MiB;
constexpr size_t WS_Z = WS_XN + 32 * MiB;
constexpr size_t WS_HID = WS_Z;
constexpr size_t WS_GATES = WS_Z + 128 * MiB;
constexpr size_t WS_FQ = WS_GATES + 128 * MiB, WS_FK = WS_FQ + 8 * MiB, WS_RQ = WS_FK + 8 * MiB, WS_RK = WS_RQ + 8 * MiB, WS_MQ = WS_RK + 8 * MiB, WS_MK = WS_MQ + 8 * MiB;
constexpr size_t WS_YF = WS_MK + 8 * MiB, WS_YB = WS_YF + 8 * MiB, WS_YR = WS_YB + 8 * MiB, WS_YM = WS_YR + 8 * MiB;
constexpr size_t WS_RW = WS_YM + 8 * MiB;
constexpr size_t WS_YRAW = WS_RW + 100 * MiB;
constexpr size_t WS_RG = WS_YRAW + 16 * MiB;
constexpr size_t WS_SM = WS_RG + 8 * MiB;
constexpr size_t SM_RBON = 0, SM_FP = 256 * 1024, SM_FT = 512 * 1024, SM_MBC = 768 * 1024, SM_MA = 1024 * 1024, SM_MAX = 1536 * 1024, SM_MBL = 1540 * 1024, SM_MCG = 1544 * 1024;
constexpr size_t WS_MRGF = WS_SM + 2 * MiB;
constexpr size_t WS_MRGB = WS_MRGF + 64 * MiB;
constexpr size_t WS_FV = WS_MRGB + 32 * MiB, WS_FO = WS_FV + 8 * MiB, WS_TV = WS_FO + 8 * MiB, WS_TG = WS_TV + 8 * MiB, WS_MV = WS_TG + 8 * MiB, WS_MO = WS_MV + 8 * MiB;
constexpr size_t WS_RQT = WS_MO + 8 * MiB, WS_PCT = WS_RQT + 8 * MiB, WS_YLT = WS_PCT + 8 * MiB, WS_SL = WS_YLT + 16 * MiB, WS_GCV = WS_SL + 16 * MiB, WS_SALL = WS_GCV + 1 * MiB;
constexpr size_t WS_KV = WS_SALL + 8 * MiB, WS_SB = WS_KV + 32 * MiB, WS_NVC = WS_SB + 16 * MiB, WS_NB = WS_NVC + 1 * MiB;
constexpr size_t WS_SSP = WS_NB + 1 * MiB;
constexpr size_t WS_LORA = WS_SSP + 4 * MiB;
constexpr size_t WS_END = WS_LORA + 1 * MiB;
constexpr int CW_TMO = 0, CW_CODE = 1, CW_BAR = 4096;
constexpr int RING_OFF = 0, RING_BYTES = 131072, LDSCTL_OFF = RING_BYTES, MISC_OFF = LDSCTL_OFF + 320, PSQ_LDS_OFF = LDSCTL_OFF + 2048, RSTD_LDS_OFF = LDSCTL_OFF + 6144, LDS_BYTES = 147456;
constexpr int RREC = 224;
constexpr int LDT = 72;
constexpr int KARG_WS_OFF = N_IN * 8 + 8;
namespace pg8 {
#define PG8_LAS __attribute__((address_space(3)))
typedef unsigned short bf16_t;
typedef short bf16x8 __attribute__((ext_vector_type(8)));
typedef float f32x4 __attribute__((ext_vector_type(4)));
typedef unsigned u32x4 __attribute__((ext_vector_type(4)));
typedef unsigned u32x2 __attribute__((ext_vector_type(2)));
constexpr int BM = 256, BK = 64, HALF = 128, HTB = HALF * BK * 2  , STAGE_BYTES = 8 * HTB, NXCD = 8, WGM = 8;

__host__ __device__ __forceinline__ int lds_byte(int r, int c) { const int st = (r >> 4) * 2 + (c >> 5), rr = r & 15, cc = c & 31, ob = rr * 64 + cc * 2; return st * 1024 + (ob ^ (((ob >> 9) & 1) << 5)); }
__host__ __device__ __forceinline__ void stage_rc(int b, int& R, int& C) { const int st = b / 1024, sb = b % 1024, swz = sb ^ (((sb >> 9) & 1) << 5); R = (st >> 1) * 16 + swz / 64; C = (st & 1) * 32 + (swz % 64) / 2; }
__host__ __device__ __forceinline__ int perm32(int rho) { const int n = rho >> 4, i = rho & 15; return 8 * (i >> 2) + 4 * n + (i & 3); }

struct Unit { int pm, pn; };
struct Gemm { const bf16_t* A; const bf16_t* Bt; int M, N, K; };

struct StaticOrder {
    int nM, nN, nwg, G, c;
    __host__ __device__ void init(int M, int N, int G_, int c_) { nM = M / BM; nN = N / BM; nwg = nM * nN; G = G_; c = c_; }
    __host__ __device__ bool next(int i, Unit& u) const {
        const long L = (long)i * G + c; if (L >= nwg) return false;
        int wgid = (int)L; { const int q = nwg / NXCD, r = nwg % NXCD, xcd = wgid % NXCD, off = wgid / NXCD; wgid = (xcd < r ? xcd * (q + 1) : r * (q + 1) + (xcd - r) * q) + off; }
        const int nig = WGM * nN, gid = wgid / nig, fm = gid * WGM, gsz = (nM - fm) < WGM ? (nM - fm) : WGM;
        u.pm = fm + ((wgid % nig) % gsz); u.pn = (wgid % nig) / gsz; return true;
    }
    __device__ __forceinline__ void a_ready(const Unit&) const {}
    __device__ __forceinline__ void done(const Unit&) const {}
};

struct RangeOrder {
    int first, count, nM, nN;
    __host__ __device__ void init(int M, int N, int first_, int count_) { nM = M / BM; nN = N / BM; first = first_; count = count_; }
    __host__ __device__ bool next(int i, Unit& u) const {
        if (i >= count) return false; const int L = first + i;
        const int nig = WGM * nN, gid = L / nig, fm = gid * WGM, gsz = (nM - fm) < WGM ? (nM - fm) : WGM;
        u.pm = fm + ((L % nig) % gsz); u.pn = (L % nig) / gsz; return true;
    }
    __device__ __forceinline__ void a_ready(const Unit&) const {}
    __device__ __forceinline__ void done(const Unit&) const {}
};
__device__ __forceinline__ unsigned cvt_pk_bf16(float lo, float hi) { typedef float f2_t __attribute__((ext_vector_type(2))); typedef __bf16 b2_t __attribute__((ext_vector_type(2))); const f2_t v = {lo, hi}; return __builtin_bit_cast(unsigned, __builtin_convertvector(v, b2_t)); }
typedef float f32x2 __attribute__((ext_vector_type(2)));
struct NoPre {};
struct SsPre { float a, b, c, d; };
__device__ __forceinline__ float bf2f_lo(unsigned p) { return __builtin_bit_cast(float, p << 16); }
__device__ __forceinline__ float bf2f_hi(unsigned p) { return __builtin_bit_cast(float, p & 0xffff0000u); }
__device__ __forceinline__ float fast_sigmoid(float x) { return __builtin_amdgcn_rcpf(1.f + __builtin_amdgcn_exp2f(-1.4426950408889634f * x)); }
__device__ __forceinline__ SsPre ss_pre(const float* ss, const Unit& u, int tid) { const float* p = ss + (size_t)(4 * (tid & 1)) * SEQ + u.pm * BM + (tid >> 1); SsPre r; r.a = p[0]; r.b = p[SEQ]; r.c = p[2 * SEQ]; r.d = p[3 * SEQ]; return r; }
__device__ __forceinline__ const PG8_LAS float* rstd_table(const SsPre& pre) {
    PG8_LAS float* T = (PG8_LAS float*)(unsigned)(RSTD_LDS_OFF);
    float s = (pre.a + pre.b) + (pre.c + pre.d);
    s += __builtin_bit_cast(float, __builtin_amdgcn_update_dpp(0, __builtin_bit_cast(int, s), 0xB1, 0xf, 0xf, true));
    if ((threadIdx.x & 1) == 0) T[threadIdx.x >> 1] = 1.f / sqrtf(s * (1.f / 2048.f) + 1e-6f);
    asm volatile("s_waitcnt lgkmcnt(0)\n\ts_barrier" ::: "memory");
    return T;
}
struct EpiSwiglu {
    static constexpr bool PERM = true, AFTER_DRAIN = false; typedef SsPre Pre;
    bf16_t* O; int ldc; const float* ss;
    __device__ __forceinline__ Pre pre(const Unit& u, int tid) const { return ss_pre(ss, u, tid); }
    __device__ __forceinline__ void operator()(const f32x4 (&acc)[2][2][4][2], const Unit& u, int wr, int wc, int fr, int fq, const Pre& pr) const {
        const PG8_LAS float* RT = rstd_table(pr);
        const int row0 = u.pm * BM + wr * 64 + fr, col0 = u.pn * HALF + wc * 32 + 8 * fq;
#pragma unroll
        for (int ai = 0; ai < 2; ++ai)
#pragma unroll
            for (int m = 0; m < 4; ++m) { bf16_t* rowp = O + (size_t)(row0 + ai * HALF + m * 16) * ldc + col0;
                float h[8]; const float rs = RT[wr * 64 + fr + ai * HALF + m * 16];
#pragma unroll
                for (int n = 0; n < 2; ++n)
#pragma unroll
                    for (int e = 0; e < 4; ++e) { const float g = rs * acc[ai][0][m][n][e], b = rs * acc[ai][1][m][n][e]; h[4 * n + e] = g * fast_sigmoid(g) * b; }
                u32x4 w; w.x = cvt_pk_bf16(h[0], h[1]); w.y = cvt_pk_bf16(h[2], h[3]); w.z = cvt_pk_bf16(h[4], h[5]); w.w = cvt_pk_bf16(h[6], h[7]);
                *(u32x4*)rowp = w; }
    }
};
struct EpiResid {
    static constexpr bool PERM = true, AFTER_DRAIN = false; typedef NoPre Pre;
    float* outf; int inst; float scale; int pad_;
    __device__ __forceinline__ Pre pre(const Unit&, int) const { return {}; }
    __device__ __forceinline__ void operator()(const f32x4 (&acc)[2][2][4][2], const Unit& u, int wr, int wc, int fr, int fq, const Pre&) const {
        const int row0 = u.pm * BM + wr * 64 + fr, col0 = u.pn * BM + wc * 32 + 8 * fq; constexpr int ldc = ::DM;
        unsigned char* const ws = *(unsigned char* const __attribute__((address_space(4)))*)((const __attribute__((address_space(4))) char*)__builtin_amdgcn_kernarg_segment_ptr() + KARG_WS_OFF);
        bf16_t* const xb = (bf16_t*)(ws + WS_XN); PG8_LAS float* const PS = (PG8_LAS float*)(unsigned)(PSQ_LDS_OFF);
#pragma unroll
        for (int ai = 0; ai < 2; ++ai)
#pragma unroll
            for (int m = 0; m < 4; ++m) { float sq = 0.f;
#pragma unroll
                for (int bj = 0; bj < 2; ++bj) { const size_t p = (size_t)(row0 + ai * HALF + m * 16) * ldc + col0 + bj * HALF;
                    const u32x4 q = *(const u32x4*)(xb + p);
                    f32x4 v0, v1;
                    v0[0] = bf2f_lo(q.x) + acc[ai][bj][m][0][0] * scale; v0[1] = bf2f_hi(q.x) + acc[ai][bj][m][0][1] * scale; v0[2] = bf2f_lo(q.y) + acc[ai][bj][m][0][2] * scale; v0[3] = bf2f_hi(q.y) + acc[ai][bj][m][0][3] * scale;
                    v1[0] = bf2f_lo(q.z) + acc[ai][bj][m][1][0] * scale; v1[1] = bf2f_hi(q.z) + acc[ai][bj][m][1][1] * scale; v1[2] = bf2f_lo(q.w) + acc[ai][bj][m][1][2] * scale; v1[3] = bf2f_hi(q.w) + acc[ai][bj][m][1][3] * scale;
                    if (outf) { *(f32x4*)(outf + p) = v0; *(f32x4*)(outf + p + 4) = v1; }
                    u32x4 w; w.x = cvt_pk_bf16(v0[0], v0[1]); w.y = cvt_pk_bf16(v0[2], v0[3]); w.z = cvt_pk_bf16(v1[0], v1[1]); w.w = cvt_pk_bf16(v1[2], v1[3]); *(u32x4*)(xb + p) = w;
                    const float r0 = bf2f_lo(w.x), r1 = bf2f_hi(w.x), r2 = bf2f_lo(w.y), r3 = bf2f_hi(w.y), r4 = bf2f_lo(w.z), r5 = bf2f_hi(w.z), r6 = bf2f_lo(w.w), r7 = bf2f_hi(w.w);
                    sq += (r0 * r0 + r1 * r1) + (r2 * r2 + r3 * r3) + (r4 * r4 + r5 * r5) + (r6 * r6 + r7 * r7); }
                sq += __builtin_bit_cast(float, __builtin_amdgcn_ds_bpermute((fr + 16 * (fq ^ 1)) << 2, __builtin_bit_cast(int, sq)));
                sq += __builtin_bit_cast(float, __builtin_amdgcn_ds_bpermute((fr + 16 * (fq ^ 2)) << 2, __builtin_bit_cast(int, sq)));
                if (fq == 0) PS[wc * 256 + wr * 64 + fr + ai * HALF + m * 16] = sq; }
        asm volatile("s_waitcnt lgkmcnt(0)\n\ts_barrier" ::: "memory");
        if (threadIdx.x < 256) { const int r = threadIdx.x; ((float*)(ws + WS_SSP))[((size_t)inst * 8 + u.pn) * SEQ + u.pm * BM + r] = (PS[r] + PS[256 + r]) + (PS[512 + r] + PS[768 + r]); }
    }
};
template <int ACT> struct EpiStore {
    static constexpr bool PERM = true, AFTER_DRAIN = false; typedef SsPre Pre;
    bf16_t* O; int ldc; const float* bias; const float* ss;
    __device__ __forceinline__ Pre pre(const Unit& u, int tid) const { return ss_pre(ss, u, tid); }
    __device__ __forceinline__ void operator()(const f32x4 (&acc)[2][2][4][2], const Unit& u, int wr, int wc, int fr, int fq, const Pre& pr) const {
        const PG8_LAS float* RT = rstd_table(pr);
        const int row0 = u.pm * BM + wr * 64 + fr, col0 = u.pn * BM + wc * 32 + 8 * fq;
        f32x4 bv[2][2];
#pragma unroll
        for (int bj = 0; bj < 2; ++bj)
#pragma unroll
            for (int n = 0; n < 2; ++n) bv[bj][n] = bias ? *(const f32x4*)(bias + col0 + bj * HALF + 4 * n) : (f32x4){0.f, 0.f, 0.f, 0.f};
#pragma unroll
        for (int ai = 0; ai < 2; ++ai)
#pragma unroll
            for (int m = 0; m < 4; ++m) { bf16_t* rowp = O + (size_t)(row0 + ai * HALF + m * 16) * ldc + col0; const float rs = RT[wr * 64 + fr + ai * HALF + m * 16];
#pragma unroll
                for (int bj = 0; bj < 2; ++bj) { f32x4 v0 = acc[ai][bj][m][0] * rs + bv[bj][0], v1 = acc[ai][bj][m][1] * rs + bv[bj][1];
                    if (ACT == 1) {
#pragma unroll
                        for (int e = 0; e < 4; ++e) { v0[e] = fast_sigmoid(v0[e]); v1[e] = fast_sigmoid(v1[e]); } }
                    u32x4 w; w.x = cvt_pk_bf16(v0[0], v0[1]); w.y = cvt_pk_bf16(v0[2], v0[3]); w.z = cvt_pk_bf16(v1[0], v1[1]); w.w = cvt_pk_bf16(v1[2], v1[3]);
                    *(u32x4*)(rowp + bj * HALF) = w; } }
    }
};
struct EpiGates {
    static constexpr bool PERM = true, AFTER_DRAIN = false; typedef SsPre Pre;
    bf16_t* O; int ldc; const float* bias; const float* ss;
    __device__ __forceinline__ Pre pre(const Unit& u, int tid) const { return ss_pre(ss, u, tid); }
    __device__ __forceinline__ void operator()(const f32x4 (&acc)[2][2][4][2], const Unit& u, int wr, int wc, int fr, int fq, const Pre& pr) const {
        const PG8_LAS float* RT = rstd_table(pr);
        const int row0 = u.pm * BM + wr * 64 + fr, j0 = u.pn * 64 + wc * 16 + 4 * fq;
        f32x4 bv[4];
#pragma unroll
        for (int n = 0; n < 4; ++n) bv[n] = *(const f32x4*)(bias + n * 2048 + j0);
#pragma unroll
        for (int ai = 0; ai < 2; ++ai)
#pragma unroll
            for (int m = 0; m < 4; ++m) { bf16_t* rowp = O + (size_t)(row0 + ai * HALF + m * 16) * ldc + j0; const float rs = RT[wr * 64 + fr + ai * HALF + m * 16];
                f32x4 d[4];
#pragma unroll
                for (int n = 0; n < 4; ++n)
#pragma unroll
                    for (int e = 0; e < 4; ++e) d[n][e] = fminf(1.f + __builtin_amdgcn_exp2f(-1.4426950408889634f * (acc[ai][n >> 1][m][n & 1][e] * rs + bv[n][e])), 1e9f);
#pragma unroll
                for (int n = 0; n < 4; ++n) { f32x4 q;
#pragma unroll
                    for (int e = 0; e < 4; ++e) { const float r = __builtin_amdgcn_rcpf(d[n][e]); q[e] = (n < 3) ? d[(n + 1) & 3][e] * r : r; }
                    u32x2 w; w.x = cvt_pk_bf16(q[0], q[1]); w.y = cvt_pk_bf16(q[2], q[3]); *(u32x2*)(rowp + n * 2048) = w; } }
    }
};
template <int MODE> struct EpiMerge {
    static constexpr bool PERM = true, AFTER_DRAIN = false; typedef NoPre Pre;
    __device__ __forceinline__ Pre pre(const Unit&, int) const { return {}; }
    const bf16_t* G; int ldg; float* Mf; bf16_t* Mb; int ldc; float mul;
    __device__ __forceinline__ void operator()(const f32x4 (&acc)[2][2][4][2], const Unit& u, int wr, int wc, int fr, int fq, const Pre&) const {
        const int row0 = u.pm * BM + wr * 64 + fr, col0 = u.pn * BM + wc * 32 + 8 * fq;
#pragma unroll
        for (int ai = 0; ai < 2; ++ai)
#pragma unroll
            for (int m = 0; m < 4; ++m)
#pragma unroll
                for (int bj = 0; bj < 2; ++bj) { const int row = row0 + ai * HALF + m * 16, col = col0 + bj * HALF;
                    const u32x4 gz = *(const u32x4*)(G + (size_t)row * ldg + col);
                    f32x4 v0, v1;
                    v0[0] = bf2f_lo(gz.x) * acc[ai][bj][m][0][0]; v0[1] = bf2f_hi(gz.x) * acc[ai][bj][m][0][1]; v0[2] = bf2f_lo(gz.y) * acc[ai][bj][m][0][2]; v0[3] = bf2f_hi(gz.y) * acc[ai][bj][m][0][3];
                    v1[0] = bf2f_lo(gz.z) * acc[ai][bj][m][1][0]; v1[1] = bf2f_hi(gz.z) * acc[ai][bj][m][1][1]; v1[2] = bf2f_lo(gz.w) * acc[ai][bj][m][1][2]; v1[3] = bf2f_hi(gz.w) * acc[ai][bj][m][1][3];
                    v0 *= mul; v1 *= mul;
                    const size_t p = (size_t)row * ldc + col;
                    if (MODE >= 1) { v0 += *(const f32x4*)(Mf + p); v1 += *(const f32x4*)(Mf + p + 4); }
                    if (MODE <= 1) { *(f32x4*)(Mf + p) = v0; *(f32x4*)(Mf + p + 4) = v1; }
                    else { u32x4 w; w.x = cvt_pk_bf16(v0[0], v0[1]); w.y = cvt_pk_bf16(v0[2], v0[3]); w.z = cvt_pk_bf16(v1[0], v1[1]); w.w = cvt_pk_bf16(v1[2], v1[3]); *(u32x4*)(Mb + p) = w; } }
    }
};

struct MergeOrder {
    int pm, pn;
    __device__ __forceinline__ bool next(int i, Unit& u) const { if (i >= 4) return false; u.pm = i * 32 + pm; u.pn = i * 8 + pn; return true; }
    __device__ __forceinline__ void a_ready(const Unit&) const {}
    __device__ __forceinline__ void done(const Unit&) const {}
};
struct EpiMergeAll {
    static constexpr bool PERM = true, AFTER_DRAIN = false; typedef NoPre Pre;
    __device__ __forceinline__ Pre pre(const Unit&, int) const { return {}; }
    const bf16_t* G; int ldg; float* Mf; bf16_t* Mb; int ldc;
    __device__ __forceinline__ void operator()(f32x4 (&acc)[2][2][4][2], const Unit& u, int wr, int wc, int fr, int fq, const Pre&) const {
        const int n = u.pm >> 5, row0 = (u.pm & 31) * BM + wr * 64 + fr, col0 = (u.pn & 7) * BM + wc * 32 + 8 * fq;
        const bf16_t* Gn = G + n * ldc;
#pragma unroll
        for (int ai = 0; ai < 2; ++ai)
#pragma unroll
            for (int m = 0; m < 4; ++m)
#pragma unroll
                for (int bj = 0; bj < 2; ++bj) { const int row = row0 + ai * HALF + m * 16, col = col0 + bj * HALF;
                    const u32x4 gz = *(const u32x4*)(Gn + (size_t)row * ldg + col);
                    f32x4 v0 = acc[ai][bj][m][0], v1 = acc[ai][bj][m][1];
                    v0[0] *= bf2f_lo(gz.x); v0[1] *= bf2f_hi(gz.x); v0[2] *= bf2f_lo(gz.y); v0[3] *= bf2f_hi(gz.y);
                    v1[0] *= bf2f_lo(gz.z); v1[1] *= bf2f_hi(gz.z); v1[2] *= bf2f_lo(gz.w); v1[3] *= bf2f_hi(gz.w);
                    acc[ai][bj][m][0] = v0; acc[ai][bj][m][1] = v1;
                    if (n == 3) { u32x4 w; w.x = cvt_pk_bf16(v0[0], v0[1]); w.y = cvt_pk_bf16(v0[2], v0[3]); w.z = cvt_pk_bf16(v1[0], v1[1]); w.w = cvt_pk_bf16(v1[2], v1[3]); *(u32x4*)(Mb + (size_t)row * ldc + col) = w; } }
    }
};
template <class T> struct KeepAcc { static constexpr bool v = false; };
template <> struct KeepAcc<EpiMergeAll> { static constexpr bool v = true; };
template <class Epi, class Sched, bool ALIGN_EPI = false, bool SP2 = false>
__device__ __forceinline__ void gemm_phase(PG8_LAS unsigned char* lds, const Gemm g, const Sched& S, const Epi& E) {
    int tid_ = threadIdx.x; asm volatile("; opaque tid (no hoisting of lane-derived values across phases)" : "+v"(tid_));
    const int tid = tid_, wid = __builtin_amdgcn_readfirstlane(tid >> 6), lane = tid & 63, wr = wid >> 2, wc = wid & 3, fr = lane & 15, fq = lane >> 4;
    const int K = g.K, nt = K / BK;
    unsigned voffA[2], voffB[2];
#pragma unroll
    for (int i = 0; i < 2; ++i) { int R, C; stage_rc(tid * 16 + i * 8192, R, C); const int Rb = Epi::PERM ? ((R & ~31) + perm32(R & 31)) : R;
        voffA[i] = (unsigned)(R * K + C) * 2u; voffB[i] = (unsigned)(Rb * K + C) * 2u; }
    const size_t kstep = (size_t)(BK * 2);
    const size_t hstep = (size_t)HALF * K * 2;
    const size_t tstep = 2 * hstep;
    const unsigned ldsw = (unsigned)wid * 1024u;
    const int aoff = lds_byte(wr * 64 + fr, fq * 8), boff = lds_byte(wc * 32 + fr, fq * 8);
#define PG8_SA(b, h) (((b) * 2 + (h)) * HTB)
#define PG8_SB(b, h) ((4 + (b) * 2 + (h)) * HTB)
#define PG8_STAGE(bufoff, gbase, voff) do { _Pragma("unroll") for (int _i = 0; _i < 2; ++_i) \
        __builtin_amdgcn_global_load_lds((const unsigned*)((const char*)(gbase) + (voff)[_i]), (PG8_LAS unsigned*)(lds + (bufoff) + ldsw + _i * 8192), 16, 0, 0); } while (0)
#define PG8_LDA(dst, b, h) do { _Pragma("unroll") for (int m = 0; m < 4; ++m) _Pragma("unroll") for (int k = 0; k < 2; ++k) dst[m][k] = *(const PG8_LAS bf16x8*)(lds + PG8_SA(b, h) + aoff + m * 2048 + k * 1024); } while (0)
#define PG8_LDB(dst, b, h) do { _Pragma("unroll") for (int n = 0; n < 2; ++n) _Pragma("unroll") for (int k = 0; k < 2; ++k) dst[n][k] = *(const PG8_LAS bf16x8*)(lds + PG8_SB(b, h) + boff + n * 2048 + k * 1024); } while (0)
#define PG8_MMA(ai, bj, At, Bt) do { __builtin_amdgcn_s_setprio(1); _Pragma("unroll") for (int m = 0; m < 4; ++m) _Pragma("unroll") for (int n = 0; n < 2; ++n) _Pragma("unroll") for (int k = 0; k < 2; ++k) \
        acc[ai][bj][m][n] = __builtin_amdgcn_mfma_f32_16x16x32_bf16(Bt[n][k], At[m][k], acc[ai][bj][m][n], 0, 0, 0); __builtin_amdgcn_s_setprio(0); } while (0)
#define PG8_WAIT_V(n) asm volatile("s_waitcnt vmcnt(" #n ")" ::: "memory")
#define PG8_WAIT_L(n) asm volatile("s_waitcnt lgkmcnt(" #n ")" ::: "memory")
#define PG8_BAR __builtin_amdgcn_s_barrier()
#define PG8_SCHED __builtin_amdgcn_sched_barrier(0)
    Unit cur, nxt; int ui = 0;
    if (!S.next(0, cur)) return;
    f32x4 acc[2][2][4][2];
#pragma unroll
    for (int a = 0; a < 2; ++a)
#pragma unroll
        for (int b = 0; b < 2; ++b)
#pragma unroll
            for (int m = 0; m < 4; ++m)
#pragma unroll
                for (int n = 0; n < 2; ++n) acc[a][b][m][n] = (f32x4){0.f, 0.f, 0.f, 0.f};
    bf16x8 At[4][2], B0[2][2], B1[2][2];
    const char* cA = (const char*)g.A + (size_t)cur.pm * tstep; const char* cB = (const char*)g.Bt + (size_t)cur.pn * tstep;
    S.a_ready(cur);
    if constexpr (SP2) {
        PG8_STAGE(PG8_SB(0, 0), cB, voffB); PG8_STAGE(PG8_SB(0, 1), cB + hstep, voffB); PG8_STAGE(PG8_SA(0, 0), cA, voffA); PG8_STAGE(PG8_SA(0, 1), cA + hstep, voffA);
        if (wr == 1) PG8_BAR;
        PG8_WAIT_V(2); PG8_BAR;
        PG8_STAGE(PG8_SB(1, 0), cB + kstep, voffB); PG8_STAGE(PG8_SA(1, 0), cA + kstep, voffA); PG8_STAGE(PG8_SB(1, 1), cB + hstep + kstep, voffB);
        PG8_WAIT_V(6); PG8_BAR;
    } else {
        PG8_STAGE(PG8_SB(0, 0), cB, voffB); PG8_STAGE(PG8_SA(0, 0), cA, voffA); PG8_STAGE(PG8_SB(0, 1), cB + hstep, voffB); PG8_STAGE(PG8_SA(0, 1), cA + hstep, voffA);
        if (wr == 1) PG8_BAR;
        PG8_WAIT_V(4); PG8_BAR;
        PG8_STAGE(PG8_SB(1, 0), cB + kstep, voffB); PG8_STAGE(PG8_SA(1, 0), cA + kstep, voffA); PG8_STAGE(PG8_SB(1, 1), cB + hstep + kstep, voffB);
        PG8_WAIT_V(6); PG8_BAR;
    }
    for (;;) {
        const bool has_next = S.next(ui + 1, nxt);
        const typename Epi::Pre epre = E.pre(cur, tid);
        const char* nA = has_next ? (const char*)g.A + (size_t)nxt.pm * tstep : cA; const char* nB = has_next ? (const char*)g.Bt + (size_t)nxt.pn * tstep : cB;
        for (int t = 0; t < nt; t += 2) {
            const bool last = (t == nt - 2);
            const char* a1 = cA + (size_t)(t + 1) * kstep;
            const char* a2 = last ? nA : cA + (size_t)(t + 2) * kstep; const char* b2 = last ? nB : cB + (size_t)(t + 2) * kstep;
            const char* a3 = a2 + kstep; const char* b3 = b2 + kstep;
            if (last && has_next) S.a_ready(nxt);
            if constexpr (SP2) {
            PG8_LDB(B0, 0, 0); PG8_LDB(B1, 0, 1); PG8_SCHED; PG8_LDA(At, 0, 0); PG8_STAGE(PG8_SA(1, 1), a1 + hstep, voffA);
            PG8_WAIT_V(8); PG8_WAIT_L(0); PG8_BAR; PG8_MMA(0, 0, At, B0); PG8_MMA(0, 1, At, B1); PG8_BAR; PG8_SCHED;
            PG8_LDA(At, 0, 1); PG8_STAGE(PG8_SB(0, 0), b2, voffB); PG8_STAGE(PG8_SB(0, 1), b2 + hstep, voffB); PG8_STAGE(PG8_SA(0, 0), a2, voffA);
            PG8_WAIT_V(8); PG8_WAIT_L(0); PG8_BAR; PG8_MMA(1, 0, At, B0); PG8_MMA(1, 1, At, B1); PG8_BAR; PG8_SCHED;
            PG8_LDB(B0, 1, 0); PG8_LDB(B1, 1, 1); PG8_SCHED; PG8_LDA(At, 1, 0); PG8_STAGE(PG8_SA(0, 1), a2 + hstep, voffA);
            PG8_WAIT_V(8); PG8_WAIT_L(0); PG8_BAR; PG8_MMA(0, 0, At, B0); PG8_MMA(0, 1, At, B1); PG8_BAR; PG8_SCHED;
            PG8_LDA(At, 1, 1); PG8_STAGE(PG8_SB(1, 0), b3, voffB); PG8_STAGE(PG8_SB(1, 1), b3 + hstep, voffB); PG8_STAGE(PG8_SA(1, 0), a3, voffA);
            PG8_WAIT_V(8); PG8_WAIT_L(0); PG8_BAR; PG8_MMA(1, 0, At, B0); PG8_MMA(1, 1, At, B1); PG8_BAR; PG8_SCHED;
            } else {
            PG8_LDB(B0, 0, 0); PG8_SCHED; PG8_LDA(At, 0, 0); PG8_STAGE(PG8_SA(1, 1), a1 + hstep, voffA);
            PG8_WAIT_L(8); PG8_BAR; PG8_WAIT_L(0); PG8_MMA(0, 0, At, B0); PG8_BAR; PG8_SCHED;
            PG8_LDB(B1, 0, 1); PG8_STAGE(PG8_SB(0, 0), b2, voffB);
            PG8_BAR; PG8_WAIT_L(0); PG8_MMA(0, 1, At, B1); PG8_BAR;
            PG8_LDA(At, 0, 1); PG8_STAGE(PG8_SA(0, 0), a2, voffA);
            PG8_BAR; PG8_WAIT_L(0); PG8_MMA(1, 0, At, B0); PG8_BAR; PG8_SCHED;
            PG8_STAGE(PG8_SB(0, 1), b2 + hstep, voffB);
            PG8_WAIT_V(6); PG8_BAR; PG8_MMA(1, 1, At, B1); PG8_BAR;
            PG8_LDB(B0, 1, 0); PG8_SCHED; PG8_LDA(At, 1, 0); PG8_STAGE(PG8_SA(0, 1), a2 + hstep, voffA);
            PG8_WAIT_L(8); PG8_BAR; PG8_WAIT_L(0); PG8_MMA(0, 0, At, B0); PG8_BAR; PG8_SCHED;
            PG8_LDB(B1, 1, 1); PG8_STAGE(PG8_SB(1, 0), b3, voffB);
            PG8_BAR; PG8_WAIT_L(0); PG8_MMA(0, 1, At, B1); PG8_BAR;
            PG8_LDA(At, 1, 1); PG8_STAGE(PG8_SA(1, 0), a3, voffA);
            PG8_BAR; PG8_WAIT_L(0); PG8_MMA(1, 0, At, B0); PG8_BAR; PG8_SCHED;
            PG8_STAGE(PG8_SB(1, 1), b3 + hstep, voffB);
            PG8_WAIT_V(6); PG8_BAR; PG8_MMA(1, 1, At, B1); PG8_BAR;
            }
        }
        if constexpr (ALIGN_EPI) { if (wr == 0) PG8_BAR; }
        if constexpr (!Epi::AFTER_DRAIN) { E(acc, cur, wr, wc, fr, fq, epre); S.done(cur); }
        if (!has_next) break;
        if constexpr (!KeepAcc<Epi>::v) {
#pragma unroll
        for (int a = 0; a < 2; ++a)
#pragma unroll
            for (int b = 0; b < 2; ++b)
#pragma unroll
                for (int m = 0; m < 4; ++m)
#pragma unroll
                    for (int n = 0; n < 2; ++n) acc[a][b][m][n] = (f32x4){0.f, 0.f, 0.f, 0.f};
        }
        cur = nxt; cA = nA; cB = nB; ++ui;
        if constexpr (ALIGN_EPI) { if (wr == 1) PG8_BAR; }
    }
    PG8_WAIT_V(0);
    if constexpr (!ALIGN_EPI) { if (wr == 0) PG8_BAR; }
    PG8_BAR;
    if constexpr (Epi::AFTER_DRAIN) { E.fused(acc, cur, wr, wc, fr, fq, lds, wid, lane); S.done(cur); }
#undef PG8_SA
#undef PG8_SB
#undef PG8_STAGE
#undef PG8_LDA
#undef PG8_LDB
#undef PG8_MMA
#undef PG8_WAIT_V
#undef PG8_WAIT_L
#undef PG8_BAR
#undef PG8_SCHED
}
}
namespace attn_body {
using bf16=__hip_bfloat16;
using bf16x8=__attribute__((ext_vector_type(8)))short;
using s16x4=__attribute__((ext_vector_type(4)))short;
using f32x16=__attribute__((ext_vector_type(16)))float;
using u32x4=__attribute__((ext_vector_type(4)))unsigned;
constexpr int BATCH=1,NHEAD=8,SEQ=8192,D=64,DM=NHEAD*D,VP=8192;
constexpr int NW=8,QBLK=32,QB=QBLK*NW,KVBLK=64,NQB=SEQ/QB;
constexpr int ATTN_PITCH=DM, ATTN_UNIT_ROWS=QB;
__device__ __forceinline__ int crow(int r,int hi){return (r&3)+8*(r>>2)+4*hi;}
#define SBAR() __builtin_amdgcn_sched_barrier(0)
__device__ __forceinline__ void cmask(f32x16&p0,f32x16&p1,int jb,int qrel,int hi){
  const float NEG=-INFINITY; int kb=64*jb+4*hi;
  #pragma unroll
  for(int r=0;r<16;++r){int kv=kb+(r&3)+8*(r>>2); if(kv>qrel)p0[r]=NEG; if(kv+32>qrel)p1[r]=NEG;}
}

constexpr int NSLOT=3, SLOTB=8192;
constexpr int LDS_K=0, LDS_V=NSLOT*SLOTB, LDS_WS=2*NSLOT*SLOTB, LDS_OST=LDS_WS+NW*64*4, LDS_BYTES0=LDS_OST+NW*4096, LDS_BT=LDS_BYTES0, LDS_E=LDS_BT+32768, LDS_SKP=LDS_E+512, LDS_BYTES=LDS_SKP+16;
constexpr float C2=0.125f*1.4426950408889634f;
__device__ __forceinline__ void glds16(const void*gsrc,unsigned lds_dst){unsigned keep;
  asm volatile("s_mov_b32 %0, m0\n\ts_mov_b32 m0, %2\n\ts_nop 0\n\tglobal_load_lds_dwordx4 %1, off\n\ts_mov_b32 m0, %0":"=&s"(keep):"v"(gsrc),"s"(lds_dst):"memory");}
__device__ __forceinline__ float max3f(float a,float b,float c){float r;asm("v_max3_f32 %0, %1, %2, %3":"=v"(r):"v"(a),"v"(b),"v"(c));return r;}
__device__ __forceinline__ float max2f(float a,float b){float r;asm("v_max_f32_e32 %0, %1, %2":"=v"(r):"v"(a),"v"(b));return r;}
__device__ __forceinline__ float fadd_s(float a,float b){float r;asm("v_add_f32_e32 %0, %1, %2":"=v"(r):"v"(a),"v"(b));return r;}
__device__ __forceinline__ float fsub_s(float a,float b){float r;asm("v_sub_f32_e32 %0, %1, %2":"=v"(r):"v"(a),"v"(b));return r;}
typedef float f32x2_t __attribute__((ext_vector_type(2))); typedef __bf16 bf16x2_t __attribute__((ext_vector_type(2)));
__device__ __forceinline__ unsigned cvtpk_s(float lo,float hi){f32x2_t v={lo,hi};bf16x2_t b=__builtin_convertvector(v,bf16x2_t);return __builtin_bit_cast(unsigned,b);}
typedef float f32x4_t __attribute__((ext_vector_type(4)));
__device__ __forceinline__ float sigm(float x){return __builtin_amdgcn_rcpf(1.f+__builtin_amdgcn_exp2f(-1.4426950408889634f*x));}
#define WAIT_BAR(N) asm volatile("s_waitcnt vmcnt(" #N ") lgkmcnt(0)\n\ts_barrier":::"memory")

__device__ __forceinline__ void qkt(f32x16&p0,f32x16&p1,const char*Kslot,const bf16x8*qr,const f32x16&negm,int r32,int hi){
  const char*kb=Kslot+hi*1024+r32*16;
  #pragma unroll
  for(int d0=0;d0<4;++d0){
    const bf16x8 b0=*reinterpret_cast<const bf16x8*>(kb+d0*2048);
    const bf16x8 b1=*reinterpret_cast<const bf16x8*>(kb+d0*2048+512);
    if(d0==0){p0=__builtin_amdgcn_mfma_f32_32x32x16_bf16(b0,qr[0],negm,0,0,0);p1=__builtin_amdgcn_mfma_f32_32x32x16_bf16(b1,qr[0],negm,0,0,0);}
    else{p0=__builtin_amdgcn_mfma_f32_32x32x16_bf16(b0,qr[d0],p0,0,0,0);p1=__builtin_amdgcn_mfma_f32_32x32x16_bf16(b1,qr[d0],p1,0,0,0);}}
}
typedef __attribute__((address_space(3))) const char* lds_cptr;
typedef short v4i16_t __attribute__((ext_vector_type(4)));
__device__ __forceinline__ void kload8(bf16x8*kf,lds_cptr kp){
  kf[0]=*(const __attribute__((address_space(3))) bf16x8*)(kp);      kf[1]=*(const __attribute__((address_space(3))) bf16x8*)(kp+512);
  kf[2]=*(const __attribute__((address_space(3))) bf16x8*)(kp+2048); kf[3]=*(const __attribute__((address_space(3))) bf16x8*)(kp+2560);
  kf[4]=*(const __attribute__((address_space(3))) bf16x8*)(kp+4096); kf[5]=*(const __attribute__((address_space(3))) bf16x8*)(kp+4608);
  kf[6]=*(const __attribute__((address_space(3))) bf16x8*)(kp+6144); kf[7]=*(const __attribute__((address_space(3))) bf16x8*)(kp+6656);
}
__device__ __forceinline__ void kload2(bf16x8*kf,lds_cptr kp,int j){ kf[2*j]=*(const __attribute__((address_space(3))) bf16x8*)(kp+j*2048); kf[2*j+1]=*(const __attribute__((address_space(3))) bf16x8*)(kp+j*2048+512); }
__device__ __forceinline__ s16x4 vtr(lds_cptr p){ return __builtin_bit_cast(s16x4,__builtin_amdgcn_ds_read_tr16_b64_v4i16((__attribute__((address_space(3))) v4i16_t*)p)); }
__device__ __forceinline__ float rowmax(const f32x16&p0,const f32x16&p1){
  float a=max3f(p0[0],p0[1],p1[0]),b=max3f(p0[2],p0[3],p1[1]);a=max3f(a,p1[2],p1[3]);
  #pragma unroll
  for(int r=4;r<16;r+=4){a=max3f(a,p0[r],p0[r+1]);b=max3f(b,p0[r+2],p0[r+3]);a=max3f(a,p1[r],p1[r+1]);b=max3f(b,p1[r+2],p1[r+3]);}
  const float m=max2f(a,b);
  auto rr=__builtin_amdgcn_permlane32_swap(__float_as_uint(m),__float_as_uint(m),false,false);
  return max2f(__uint_as_float(rr[0]),__uint_as_float(rr[1]));
}
__device__ __forceinline__ void pv(f32x16*o,int vb,bf16x8 pa0,bf16x8 pa1,bf16x8 pa2,bf16x8 pa3){
  #pragma unroll
  for(int d0=0;d0<2;++d0){s16x4 lo[4],hi[4];
    #pragma unroll
    for(int ks=0;ks<4;++ks){
      asm volatile("ds_read_b64_tr_b16 %0,%1 offset:%c2":"=&v"(lo[ks]):"v"(vb),"i"(d0*4096+ks*1024):"memory");
      asm volatile("ds_read_b64_tr_b16 %0,%1 offset:%c2":"=&v"(hi[ks]):"v"(vb),"i"(d0*4096+ks*1024+512):"memory");}
    asm volatile("s_waitcnt lgkmcnt(0)":::"memory");SBAR();
    #define PK(k) (bf16x8){lo[k][0],lo[k][1],lo[k][2],lo[k][3],hi[k][0],hi[k][1],hi[k][2],hi[k][3]}
    o[d0]=__builtin_amdgcn_mfma_f32_32x32x16_bf16(pa0,PK(0),o[d0],0,0,0);
    o[d0]=__builtin_amdgcn_mfma_f32_32x32x16_bf16(pa1,PK(1),o[d0],0,0,0);
    o[d0]=__builtin_amdgcn_mfma_f32_32x32x16_bf16(pa2,PK(2),o[d0],0,0,0);
    o[d0]=__builtin_amdgcn_mfma_f32_32x32x16_bf16(pa3,PK(3),o[d0],0,0,0);
    #undef PK
  }
}

#ifndef ATTN_STORE16
#define ATTN_STORE16(p,v) (*(u32x4*)(p)=(v))
#endif
template<int THRL> __device__ __forceinline__ void attn_unit(int b,int h,int qb,const bf16*Q,const bf16*__restrict__ K,const bf16*__restrict__ V,bf16*O,const float*__restrict__ FP,const float*__restrict__ FT,const bf16*__restrict__ GZ,char*shm){
  int tid_=threadIdx.x; asm volatile("; OPAQUE_TID":"+v"(tid_)); const int tid=tid_,lane=tid&63,r32=lane&31,hi=lane>>5; const int wid=__builtin_amdgcn_readfirstlane(tid>>6);
  const long rowbase=(long)b*SEQ; const int q0=qb*QB;
  const bf16*Qw=Q+(rowbase+q0+wid*QBLK)*DM+h*D;
  const bf16*Kh=K+rowbase*DM+h*D,*Vh=V+rowbase*VP+h*D;
  const unsigned lds0=(unsigned)(uintptr_t)shm;
  float*wsf=(float*)(shm+LDS_WS)+wid*64;
  const bf16*ksrc=Kh+(long)lane*DM+wid*8;
  const bf16*vsrc=Vh+(long)(16*(wid&3)+(lane>>2))*VP+(wid>>2)*32+(lane&3)*8;
  const unsigned kdst=lds0+LDS_K+wid*1024, vdst=lds0+LDS_V+wid*1024;
  #define DMA_K(t,slot) glds16(ksrc+(long)(t)*KVBLK*DM,(unsigned)__builtin_amdgcn_readfirstlane(kdst+(slot)))
  #define DMA_V(t,slot) glds16(vsrc+(long)(t)*KVBLK*VP,(unsigned)__builtin_amdgcn_readfirstlane(vdst+(slot)))
  const int vb0=(int)(lds0+LDS_V)+((lane>>4)&1)*32+(lane&3)*8+(4*hi+((lane&15)>>2))*64;
  const char*Kbase=shm+LDS_K; bf16x8 kf[8];
  const lds_cptr shm3=(lds_cptr)shm; const lds_cptr kp0=shm3+LDS_K+hi*1024+r32*16; const lds_cptr vp0=shm3+LDS_V+((lane>>4)&1)*32+(lane&3)*8+(4*hi+((lane&15)>>2))*64;
  int NT=(q0+QB)/KVBLK;
  int tskip=0;
  { float*Ef=(float*)(shm+LDS_E); float*bt=(float*)(shm+LDS_BT);
    if(wid==0){ const float a0=(2*lane<NT)?FT[h*128+2*lane]:0.f, a1=(2*lane+1<NT)?FT[h*128+2*lane+1]:0.f; float sc=a0+a1;
      _Pragma("unroll") for(int o=1;o<64;o<<=1){ const float u=__builtin_bit_cast(float,__builtin_amdgcn_ds_bpermute(((lane-o)&63)<<2,__builtin_bit_cast(int,sc))); if(lane>=o)sc+=u; }
      const float ex=sc-(a0+a1); Ef[2*lane]=ex; Ef[2*lane+1]=ex+a0; }
    asm volatile("s_waitcnt lgkmcnt(0)\n\ts_barrier":::"memory");
    const float fref=Ef[q0>>6];
    if(wid<2){ const bool fl=(tid<NT)&&((fref-(Ef[tid&127]+FP[h*SEQ+64*(tid&127)+63]))*1.4426950408889634f<-80.f);
      const unsigned long long bm=__ballot(fl); if(lane==0)((int*)(shm+LDS_SKP))[wid]=__popcll(bm); }
    for(int s=tid;s<q0+QB;s+=NW*64){ const float bv=(fref-(Ef[s>>6]+FP[h*SEQ+s]))*1.4426950408889634f; unsigned ub=__float_as_uint(bv); const unsigned hb=(ub+0x7fffu+((ub>>16)&1u))>>16;
      const float rr_=bv-__uint_as_float(hb<<16); unsigned ur=__float_as_uint(rr_); const unsigned lb=(ur+0x7fffu+((ur>>16)&1u))>>16; ((unsigned*)bt)[s]=hb|(lb<<16); }
    asm volatile("s_waitcnt vmcnt(0) lgkmcnt(0)\n\ts_barrier":::"memory"); }
  { int ts=(((const int*)(shm+LDS_SKP))[0]+((const int*)(shm+LDS_SKP))[1])&~1; ts=ts>NT-4?NT-4:ts; ts=__builtin_amdgcn_readfirstlane(ts);
    NT-=ts; ksrc+=(long)ts*KVBLK*DM; vsrc+=(long)ts*KVBLK*VP; tskip=ts; }
  const __attribute__((address_space(3))) unsigned* bt3=(const __attribute__((address_space(3))) unsigned*)(shm3+LDS_BT)+r32+64*tskip;
  #define BIAS(P0,P1,t) do{ const unsigned w0_=bt3[64*(t)], w1_=bt3[64*(t)+32]; \
    const u32x4 a0_={hi?0u:w0_,0u,0u,0u}, a1_={hi?0u:w1_,0u,0u,0u}; const u32x4 one_={0x3F803F80u,0u,0u,0u}; \
    P0=__builtin_amdgcn_mfma_f32_32x32x16_bf16(__builtin_bit_cast(bf16x8,a0_),__builtin_bit_cast(bf16x8,one_),P0,0,0,0); \
    P1=__builtin_amdgcn_mfma_f32_32x32x16_bf16(__builtin_bit_cast(bf16x8,a1_),__builtin_bit_cast(bf16x8,one_),P1,0,0,0); }while(0)
  DMA_K(0,0);DMA_V(0,0);DMA_K(1,SLOTB);
  bf16x8 qr[4];
  #pragma unroll
  for(int d0=0;d0<4;++d0)qr[d0]=*reinterpret_cast<const bf16x8*>(&Qw[(long)r32*DM+d0*16+hi*8]);
  float mhat=0.f,l_reg=0.f;f32x16 o[2];o[0]=f32x16{};o[1]=f32x16{};f32x16 negm=f32x16{};asm volatile("":"+v"(negm));
  const int qrel=wid*QBLK+r32;
  #define CMASK(P0,P1,t) do{int jb_=(t)-(NT-4); if(jb_>=0)cmask(P0,P1,jb_,qrel,hi);}while(0)
  bool resc=false;
  #define START(P0,P1) do{ const float rm=rowmax(P0,P1); resc=false; \
    { const float dl=rm; mhat=fadd_s(mhat,dl); \
      _Pragma("unroll") for(int r=0;r<16;++r){P0[r]=fsub_s(P0[r],dl);P1[r]=fsub_s(P1[r],dl);} \
      _Pragma("unroll") for(int r=0;r<16;++r)negm[r]=-mhat; asm volatile("":"+v"(negm)); } \
    _Pragma("unroll") for(int r=0;r<16;++r)P0[r]=__builtin_amdgcn_exp2f(P0[r]); }while(0)
  #define RESC() do{ if(resc){ asm volatile("s_waitcnt lgkmcnt(0)":::"memory"); \
      _Pragma("unroll") for(int d_=0;d_<2;++d_) _Pragma("unroll") for(int r=0;r<16;++r)o[d_][r]*=wsf[crow(r,hi)]; } }while(0)
  f32x16 pA0,pA1,pB0,pB1;
  int sl_prev=0,sl_cur=0,sl_next=SLOTB;
  #define ROT() do{sl_prev=sl_cur;sl_cur=sl_next;sl_next=(sl_next==(NSLOT-1)*SLOTB)?0:sl_next+SLOTB;}while(0)
  DMA_K(2,2*SLOTB);
  WAIT_BAR(3);
  qkt(pA0,pA1,Kbase,qr,negm,r32,hi);BIAS(pA0,pA1,0);asm volatile("s_nop 15\n\ts_nop 7":"+v"(pA0),"+v"(pA1));CMASK(pA0,pA1,0);
  START(pA0,pA1);
  _Pragma("unroll") for(int r=0;r<16;++r)pA1[r]=__builtin_amdgcn_exp2f(pA1[r]);
  WAIT_BAR(0);
  DMA_K(3,0);DMA_V(1,SLOTB);
  ROT();
  kload8(kf,kp0+sl_cur);
  WAIT_BAR(2);
  s16x4 vlo[8],vhi[8]; u32x4 pw0,pw1,pw2,pw3;
  #define PKW(P,B) cvtpk_s(P[B],P[B+1])
  #define PAF(k) __builtin_bit_cast(bf16x8,pw##k)
  #define VFR(i) (bf16x8){vlo[i][0],vlo[i][1],vlo[i][2],vlo[i][3],vhi[i][0],vhi[i][1],vhi[i][2],vhi[i][3]}
  #define PIN(x) asm volatile("":"+v"(x))
  #define MX3(a,b,c) __builtin_fmaxf(__builtin_fmaxf((a),(b)),(c))
  #define GAPA(MF,A0,A1,A2,A3,W0,W1,PW) do{ MF; sacc+=A0; sacc+=A1; sacc+=A2; sacc+=A3; PIN(sacc); W0; W1; PIN(PW); SBAR(); }while(0)
  #define EX(v) __builtin_amdgcn_exp2f(v)
  #define GAPB(MF,X,B) do{ MF; X[B]=EX(X[B]); X[B+1]=EX(X[B+1]); X[B+2]=EX(X[B+2]); X[B+3]=EX(X[B+3]); PIN(X); SBAR(); }while(0)
  #define VRD(i) do{ vlo[i]=vtr(vp_+(((i)>>2)*4096+((i)&3)*1024)); vhi[i]=vtr(vp_+(((i)>>2)*4096+((i)&3)*1024+512)); }while(0)
  #define KRD(G,j) do{ if(G){ kload2(kf,kp0+sl_next,j); SBAR(); } }while(0)
  #define STEP(C0,C1,P0,P1,t,GK,GV,GL) do{ SBAR(); \
    const lds_cptr vp_=vp0+sl_prev; \
    VRD(0); SBAR(); float sacc=(P0[0]+P0[1]); \
    GAPA(C0=__builtin_amdgcn_mfma_f32_32x32x16_bf16(kf[0],qr[0],negm,0,0,0), P0[2],P0[3],P0[4],P0[5],     pw0[0]=PKW(P0,0), pw0[1]=PKW(P0,2), pw0); \
    VRD(4); SBAR(); GAPA(C1=__builtin_amdgcn_mfma_f32_32x32x16_bf16(kf[1],qr[0],negm,0,0,0), P0[6],P0[7],P0[8],P0[9],     pw0[2]=PKW(P0,4), pw0[3]=PKW(P0,6), pw0); \
    VRD(1); SBAR(); GAPA(C0=__builtin_amdgcn_mfma_f32_32x32x16_bf16(kf[2],qr[1],C0,0,0,0),   P0[10],P0[11],P0[12],P0[13], pw1[0]=PKW(P0,8), pw1[1]=PKW(P0,10), pw1); \
    VRD(5); SBAR(); GAPA(C1=__builtin_amdgcn_mfma_f32_32x32x16_bf16(kf[3],qr[1],C1,0,0,0),   P0[14],P0[15],P1[0],P1[1],   pw1[2]=PKW(P0,12),pw1[3]=PKW(P0,14), pw1); \
    VRD(2); SBAR(); GAPA(C0=__builtin_amdgcn_mfma_f32_32x32x16_bf16(kf[4],qr[2],C0,0,0,0),   P1[2],P1[3],P1[4],P1[5],     pw2[0]=PKW(P1,0), pw2[1]=PKW(P1,2), pw2); \
    VRD(6); SBAR(); GAPA(C1=__builtin_amdgcn_mfma_f32_32x32x16_bf16(kf[5],qr[2],C1,0,0,0),   P1[6],P1[7],P1[8],P1[9],     pw2[2]=PKW(P1,4), pw2[3]=PKW(P1,6), pw2); \
    VRD(3); SBAR(); GAPA(C0=__builtin_amdgcn_mfma_f32_32x32x16_bf16(kf[6],qr[3],C0,0,0,0),   P1[10],P1[11],P1[12],P1[13], pw3[0]=PKW(P1,8), pw3[1]=PKW(P1,10), pw3); \
    VRD(7); SBAR(); GAPA(C1=__builtin_amdgcn_mfma_f32_32x32x16_bf16(kf[7],qr[3],C1,0,0,0),   P1[14],P1[15],0.f,0.f,       pw3[2]=PKW(P1,12),pw3[3]=PKW(P1,14), pw3); \
    l_reg+=sacc; \
    if(GK){DMA_K((t)+3,sl_cur);} if(GV){DMA_V((t)+1,sl_next);} \
    BIAS(C0,C1,t); CMASK(C0,C1,t); \
    { float a=MX3(C0[0],C0[1],C1[0]),b=MX3(C0[2],C0[3],C1[1]); a=MX3(a,C1[2],C1[3]); \
      _Pragma("unroll") for(int r=4;r<16;r+=4){a=MX3(a,C0[r],C0[r+1]);b=MX3(b,C0[r+2],C0[r+3]);a=MX3(a,C1[r],C1[r+1]);b=MX3(b,C1[r+2],C1[r+3]);} \
      float rm=__builtin_fmaxf(a,b); { auto rr=__builtin_amdgcn_permlane32_swap(__float_as_uint(rm),__float_as_uint(rm),false,false); rm=__builtin_fmaxf(__uint_as_float(rr[0]),__uint_as_float(rr[1])); } \
      resc=false; \
      if(__builtin_expect(__any(rm>(float)THRL),0)){ const float dl=__builtin_fmaxf(rm,0.f); mhat+=dl; \
        _Pragma("unroll") for(int r=0;r<16;++r){C0[r]-=dl;C1[r]-=dl;} \
        _Pragma("unroll") for(int r=0;r<16;++r)negm[r]=-mhat; asm volatile("":"+v"(negm)); \
        const float f=__builtin_amdgcn_exp2f(-dl); l_reg*=f; if(hi==0)wsf[r32]=f; resc=true; } } \
    SBAR(); \
    GAPB(o[0]=__builtin_amdgcn_mfma_f32_32x32x16_bf16(PAF(0),VFR(0),o[0],0,0,0), C0,0); \
    GAPB(o[1]=__builtin_amdgcn_mfma_f32_32x32x16_bf16(PAF(0),VFR(4),o[1],0,0,0), C0,4); \
    KRD(GL,0); GAPB(o[0]=__builtin_amdgcn_mfma_f32_32x32x16_bf16(PAF(1),VFR(1),o[0],0,0,0), C0,8); \
    KRD(GL,1); GAPB(o[1]=__builtin_amdgcn_mfma_f32_32x32x16_bf16(PAF(1),VFR(5),o[1],0,0,0), C0,12); \
    KRD(GL,2); GAPB(o[0]=__builtin_amdgcn_mfma_f32_32x32x16_bf16(PAF(2),VFR(2),o[0],0,0,0), C1,0); \
    KRD(GL,3); GAPB(o[1]=__builtin_amdgcn_mfma_f32_32x32x16_bf16(PAF(2),VFR(6),o[1],0,0,0), C1,4); \
    GAPB(o[0]=__builtin_amdgcn_mfma_f32_32x32x16_bf16(PAF(3),VFR(3),o[0],0,0,0), C1,8); \
    GAPB(o[1]=__builtin_amdgcn_mfma_f32_32x32x16_bf16(PAF(3),VFR(7),o[1],0,0,0), C1,12); \
    }while(0)
  int t=1;
  #undef CMASK
  #define CMASK(P0,P1,t) do{}while(0)
  for(;t+5<NT;t+=2){
    STEP(pB0,pB1,pA0,pA1,t,true,true,true);     WAIT_BAR(2); RESC(); ROT();
    STEP(pA0,pA1,pB0,pB1,t+1,true,true,true);   WAIT_BAR(2); RESC(); ROT();
  }
  #undef CMASK
  #define CMASK(P0,P1,t) do{int jb_=(t)-(NT-4); if(jb_>=0)cmask(P0,P1,jb_,qrel,hi);}while(0)
  #define ENDW(tt) do{ if((tt)+3<NT){WAIT_BAR(2);} else if((tt)+2<NT){WAIT_BAR(1);} else {WAIT_BAR(0);} }while(0)
  for(;t+1<NT;t+=2){
    STEP(pB0,pB1,pA0,pA1,t,(t+3<NT),(t+1<NT),(t+1<NT));       ENDW(t);   RESC(); ROT();
    STEP(pA0,pA1,pB0,pB1,t+1,(t+4<NT),(t+2<NT),(t+2<NT));     ENDW(t+1); RESC(); ROT();
  }
  STEP(pB0,pB1,pA0,pA1,NT-1,false,false,false); RESC();
  { float sacc=pB0[0]+pB0[1]; _Pragma("unroll") for(int r=2;r<16;++r)sacc+=pB0[r]; _Pragma("unroll") for(int r=0;r<16;++r)sacc+=pB1[r]; l_reg+=sacc;
    pw0=(u32x4){PKW(pB0,0),PKW(pB0,2),PKW(pB0,4),PKW(pB0,6)};pw1=(u32x4){PKW(pB0,8),PKW(pB0,10),PKW(pB0,12),PKW(pB0,14)};pw2=(u32x4){PKW(pB1,0),PKW(pB1,2),PKW(pB1,4),PKW(pB1,6)};pw3=(u32x4){PKW(pB1,8),PKW(pB1,10),PKW(pB1,12),PKW(pB1,14)};
    SBAR(); pv(o,vb0+sl_cur,PAF(0),PAF(1),PAF(2),PAF(3)); }
  #undef PKW
  #undef PAF
  #undef VFR
  #undef PIN
  #undef MX3
  #undef GAPA
  #undef GAPB
  #undef EX
  #undef VRD
  #undef KRD
  #undef STEP
  #undef ENDW
  {auto rr=__builtin_amdgcn_permlane32_swap(__float_as_uint(l_reg),__float_as_uint(l_reg),false,false);l_reg=__uint_as_float(rr[0])+__uint_as_float(rr[1]);}
  if(hi==0)wsf[32+r32]=l_reg;asm volatile("s_waitcnt lgkmcnt(0)":::"memory");
  float rli[16];
  #pragma unroll
  for(int r=0;r<16;++r)rli[r]=__builtin_amdgcn_rcpf(wsf[32+crow(r,hi)]);
  bf16*Ow=O+(rowbase+q0+wid*QBLK)*DM+h*D;
  { bf16*stg=(bf16*)(shm+LDS_OST)+wid*2048;
    #pragma unroll
    for(int r=0;r<16;++r){const int orow=crow(r,hi);
      #pragma unroll
      for(int d0=0;d0<2;++d0)stg[orow*64+d0*32+r32]=__float2bfloat16(o[d0][r]*rli[r]);}
    asm volatile("s_waitcnt lgkmcnt(0)":::"memory");
    #pragma unroll
    for(int i=0;i<4;++i){const int row=i*8+(lane>>3),ch=lane&7; const u32x4 v=*(const u32x4*)(stg+row*64+ch*8);
      const u32x4 gz=*(const u32x4*)(GZ+(rowbase+q0+wid*QBLK+row)*VP+h*D+ch*8); u32x4 w;
      #define GM(a,g) cvtpk_s(__uint_as_float((a)<<16)*sigm(__uint_as_float((g)<<16)), __uint_as_float((a)&0xffff0000u)*sigm(__uint_as_float((g)&0xffff0000u)))
      w.x=GM(v.x,gz.x); w.y=GM(v.y,gz.y); w.z=GM(v.z,gz.z); w.w=GM(v.w,gz.w);
      #undef GM
      ATTN_STORE16(Ow+(long)row*DM+ch*8,w);} }
  asm volatile("s_waitcnt lgkmcnt(0)\n\ts_barrier":::"memory");
  #undef DMA_K
  #undef DMA_V
  #undef BIAS
  #undef CMASK
  #undef START
  #undef RESC
  #undef ROT
}
constexpr int ATTN_LDS_BYTES=LDS_BYTES;
#undef SBAR
#undef WAIT_BAR
}
#define GAS __attribute__((address_space(1)))
#define LAS __attribute__((address_space(3)))
typedef unsigned short bf16;
typedef unsigned v4u __attribute__((ext_vector_type(4)));
typedef float f32x4 __attribute__((ext_vector_type(4)));
typedef short bf16x8 __attribute__((ext_vector_type(8)));
typedef GAS unsigned gu32;
typedef GAS unsigned long long gu64;
#define RLX_AGENT __ATOMIC_RELAXED, __HIP_MEMORY_SCOPE_AGENT
#define LDS_WAIT() asm volatile("s_waitcnt lgkmcnt(0)" ::: "memory")
#define VM_WAIT() asm volatile("s_waitcnt vmcnt(0)" ::: "memory")
__device__ __forceinline__ unsigned long long rt() { return __builtin_amdgcn_s_memrealtime(); }
__device__ __forceinline__ unsigned f2bf(float f) { unsigned u = __builtin_bit_cast(unsigned, f); return (u + 0x7fffu + ((u >> 16) & 1u)) >> 16; }
__device__ __forceinline__ unsigned pk2(float lo, float hi) { return f2bf(lo) | (f2bf(hi) << 16); }

#define XB_TMO      128
#define XB_XCNT(j)  (256  + 64 * (j))
#define XB_XSUB(j)  (1280 + 64 * (j))
#define XB_XGEN(j)  (2304 + 64 * (j))
#define XB_TOP      3328
#define XB_TOPGEN   3392
#define XCD_BAR_WORDS 3456
#define XB_SPIN_CAP (1u << 18)

__device__ __forceinline__ unsigned xb_ld(unsigned* p)              { return __hip_atomic_load(p, __ATOMIC_RELAXED, __HIP_MEMORY_SCOPE_AGENT); }
__device__ __forceinline__ unsigned xb_add(unsigned* p, unsigned v) { return __hip_atomic_fetch_add(p, v, __ATOMIC_RELAXED, __HIP_MEMORY_SCOPE_AGENT); }
__device__ __forceinline__ unsigned xb_xcc_id() { return (unsigned)__builtin_amdgcn_s_getreg((3 << 11) | 20) & 0xFu; }
#define XB_SPIN(cond, bar) do { unsigned _sp = 0; while (cond) { __builtin_amdgcn_s_sleep(1); \
    if ((++_sp & 255u) == 0u) { if (xb_ld(&(bar)[XB_TMO])) break; if (_sp > XB_SPIN_CAP) { atomicAdd(&(bar)[XB_TMO], 1u); break; } } } } while (0)

struct XcdBarrier {
    unsigned* bar; unsigned x;
    volatile LAS unsigned* st;
};

__device__ __forceinline__ XcdBarrier xcd_barrier_post(unsigned* bar, volatile LAS unsigned* st) {
    XcdBarrier b; b.bar = bar; b.x = xb_xcc_id(); b.st = st;
    if (threadIdx.x == 0) (void)xb_add(&bar[XB_XCNT(b.x)], 1u);
    return b;
}
__device__ __forceinline__ void xcd_barrier_complete(unsigned* bar, unsigned x, unsigned& nloc, unsigned& nx) {
    const unsigned G = gridDim.x * gridDim.y * gridDim.z;
    unsigned sum, cnt, mine, sp = 0u;
    for (;;) {
        sum = 0u; cnt = 0u; mine = 0u;
#pragma unroll
        for (unsigned j = 0; j < 16; ++j) { const unsigned c = xb_ld(&bar[XB_XCNT(j)]); sum += c; cnt += (c > 0u) ? 1u : 0u; mine = (j == x) ? c : mine; }
        if (sum == G) break;
        __builtin_amdgcn_s_sleep(1);
        if ((++sp & 255u) == 0u) { if (xb_ld(&bar[XB_TMO])) break; if (sp > XB_SPIN_CAP) { atomicAdd(&bar[XB_TMO], 1u); break; } }
    }
    nloc = mine > 0u ? mine : 1u; nx = cnt > 0u ? cnt : 1u;
}

__device__ __forceinline__ void xcd_barrier(const XcdBarrier& b) {
    asm volatile("s_waitcnt vmcnt(0)" ::: "memory");
    __syncthreads();
    if (threadIdx.x == 0) {
        unsigned* bar = b.bar;
        __builtin_amdgcn_s_waitcnt(0);
        unsigned nloc = b.st[0], nx = b.st[1];
        if (nloc == 0u) { xcd_barrier_complete(bar, b.x, nloc, nx); b.st[0] = nloc; b.st[1] = nx; }
        const unsigned old = xb_add(&bar[XB_XSUB(b.x)], 1u);
        const unsigned gen = old / nloc;
        if (old + 1u == (gen + 1u) * nloc) {
            __builtin_amdgcn_fence(__ATOMIC_RELEASE, "agent");
            asm volatile("s_waitcnt vmcnt(0)" ::: "memory");
            const unsigned og = xb_add(&bar[XB_TOP], 1u);
            const unsigned tg = og / nx;
            if (og + 1u == (tg + 1u) * nx) xb_add(&bar[XB_TOPGEN], 1u);
            else XB_SPIN(xb_ld(&bar[XB_TOPGEN]) == tg, bar);
            __builtin_amdgcn_fence(__ATOMIC_ACQUIRE, "agent");
            xb_add(&bar[XB_XGEN(b.x)], 1u);
            asm volatile("s_waitcnt vmcnt(0)" ::: "memory");
        } else {
            XB_SPIN(xb_ld(&bar[XB_XGEN(b.x)]) == gen, bar);
            __builtin_amdgcn_fence(__ATOMIC_ACQUIRE, "agent");
            asm volatile("s_waitcnt vmcnt(0)" ::: "memory");
        }
    }
    __syncthreads();
}
struct Args { const float* in[N_IN]; float* out; unsigned char* ws; int ph_lo, ph_hi, li, pad; };
struct Frame {
    LAS unsigned char* lds; volatile LAS unsigned* MISC; gu32* ctl;
    int tid, lane, wave, vcu, G, bx;
    unsigned char* ws;
};
template <int CTRL> __device__ __forceinline__ float dpp_add(float v) {
    return v + __builtin_bit_cast(float, __builtin_amdgcn_update_dpp(0, __builtin_bit_cast(int, v), CTRL, 0xf, 0xf, true));
}
__device__ __forceinline__ float row16_sum(float v) {
    v = dpp_add<0xB1>(v);
    v = dpp_add<0x4E>(v);
    v = dpp_add<0x141>(v);
    v = dpp_add<0x140>(v);
    return v;
}
__device__ __forceinline__ float bperm(int srclane, float v) { return __builtin_bit_cast(float, __builtin_amdgcn_ds_bpermute(srclane << 2, __builtin_bit_cast(int, v))); }
template <int M> __device__ __forceinline__ float shx(float v) {
    constexpr int ctrl = (M == 1) ? 0xB1 : ((M == 2) ? 0x4E : 0x141);
    return __builtin_bit_cast(float, __builtin_amdgcn_update_dpp(0, __builtin_bit_cast(int, v), ctrl, 0xf, 0xf, true));
}
__device__ __forceinline__ float sum8(float v) { v += shx<1>(v); v += shx<2>(v); v += shx<4>(v); return v; }
__device__ __forceinline__ float rdlane(float v, int l) { return __builtin_bit_cast(float, __builtin_amdgcn_readlane(__builtin_bit_cast(int, v), l)); }
__device__ __forceinline__ float wave_sum(float v) { v = row16_sum(v); return (rdlane(v, 0) + rdlane(v, 16)) + (rdlane(v, 32) + rdlane(v, 48)); }
__device__ __forceinline__ float wave_incl_scan(float v, int lane) {
#pragma unroll
    for (int o = 1; o < 64; o <<= 1) { const float u = bperm((lane - o) & 63, v); if (lane >= o) v += u; }
    return v;
}
__device__ __forceinline__ float wave_incl_max(float v, int lane) {
#pragma unroll
    for (int o = 1; o < 64; o <<= 1) { const float u = bperm((lane - o) & 63, v); if (lane >= o) v = fmaxf(v, u); }
    return v;
}
__device__ __forceinline__ float lo16(unsigned p) { return __builtin_bit_cast(float, p << 16); }
__device__ __forceinline__ float hi16(unsigned p) { return __builtin_bit_cast(float, p & 0xffff0000u); }
__device__ __forceinline__ void unpack8(const v4u p, float (&f)[8]) { f[0] = lo16(p.x); f[1] = hi16(p.x); f[2] = lo16(p.y); f[3] = hi16(p.y); f[4] = lo16(p.z); f[5] = hi16(p.z); f[6] = lo16(p.w); f[7] = hi16(p.w); }
__device__ __forceinline__ unsigned cvtpk(float lo, float hi) { return pg8::cvt_pk_bf16(lo, hi); }
__device__ __forceinline__ v4u pack8(const float (&f)[8]) { v4u o; o.x = cvtpk(f[0], f[1]); o.y = cvtpk(f[2], f[3]); o.z = cvtpk(f[4], f[5]); o.w = cvtpk(f[6], f[7]); return o; }
__device__ __forceinline__ float bf1(const bf16* p) { return __builtin_bit_cast(float, (unsigned)(*p) << 16); }
__device__ __forceinline__ float sigmoidf_(float x) { return __builtin_amdgcn_rcpf(1.f + __builtin_amdgcn_exp2f(-1.4426950408889634f * x)); }
__device__ __forceinline__ float logsigf_(float x) { return fminf(x, 0.f) - log1pf(__expf(-fabsf(x))); }
__device__ __forceinline__ float siluf_(float x) { return x * sigmoidf_(x); }

__device__ __forceinline__ int win_src(int n) { return n < 2048 ? n : (n < 7936 ? n + 8 : (n < 7944 ? n - 5888 : (n < 7960 ? n : -1))); }
template <bool SPREAD = false>
__device__ __forceinline__ void tr_item64(const float* W, int Nsrc, int sc0, bf16* WT, int K, int k0, int drow0, LAS bf16* T, int lane, const float* gk = nullptr) {
    const int kr = lane >> 4, c4 = lane & 15;
    f32x4 v[16];
#pragma unroll
    for (int j = 0; j < 16; ++j) v[j] = *(const f32x4*)(W + (size_t)(k0 + 4 * j + kr) * Nsrc + sc0 + 4 * c4);
    if (gk) {
#pragma unroll
        for (int j = 0; j < 16; ++j) v[j] = v[j] * gk[k0 + 4 * j + kr]; }
#pragma unroll
    for (int j = 0; j < 16; ++j) { const unsigned p0 = cvtpk(v[j][0], v[j][1]), p1 = cvtpk(v[j][2], v[j][3]); const int kk = 4 * j + kr;
        const int col = ((((kk >> 3) ^ (c4 >> 1)) & 7) << 3) + (kk & 7);
        T[(4 * c4 + 0) * LDT + col] = (bf16)(p0 & 0xffffu); T[(4 * c4 + 1) * LDT + col] = (bf16)(p0 >> 16); T[(4 * c4 + 2) * LDT + col] = (bf16)(p1 & 0xffffu); T[(4 * c4 + 3) * LDT + col] = (bf16)(p1 >> 16); }
    LDS_WAIT(); asm volatile("" ::: "memory");
#pragma unroll
    for (int p = 0; p < 8; ++p) { const int n = (lane >> 3) + 8 * p, kc = lane & 7; const int dr = SPREAD ? 8 * (n >> 2) + (n & 3) : n; *(GAS v4u*)(WT + (size_t)(drow0 + dr) * K + k0 + 8 * kc) = *(const LAS v4u*)(T + n * LDT + (((kc ^ (n >> 3)) & 7) << 3)); }
    LDS_WAIT(); asm volatile("" ::: "memory");
}
__device__ __forceinline__ void tr_item64_win_special(const float* W, bf16* WT, int k0, LAS bf16* T, int lane, const float* gk) {
    const int sc = win_src(7936 + lane);
    for (int kk = 0; kk < 64; ++kk) T[lane * LDT + kk] = (bf16)f2bf(sc >= 0 ? gk[k0 + kk] * W[(size_t)(k0 + kk) * 7960 + sc] : 0.f);
    LDS_WAIT(); asm volatile("" ::: "memory");
#pragma unroll
    for (int p = 0; p < 8; ++p) { const int n = (lane >> 3) + 8 * p, kc = lane & 7; *(GAS v4u*)(WT + (size_t)(7936 + n) * DM + k0 + 8 * kc) = *(const LAS v4u*)(T + n * LDT + 8 * kc); }
    LDS_WAIT(); asm volatile("" ::: "memory");
}
template <class InT> __device__ __forceinline__ void p0_prologue(Frame& F, const InT& in) {
    LAS bf16* T = (LAS bf16*)(F.lds + RING_OFF + F.wave * 16384);
    const int gw = F.vcu * NWAVES + F.wave, NGW = F.G * NWAVES, lane = F.lane;
    constexpr int I_13 = (DM / 64) * (2 * DFF / 64), I_2 = (DFF / 64) * (DM / 64), I_IN = (DM / 64) * (ZW / 64), I_G = (DM / 64) * (4 * DM / 64), I_B = 4 * (MW / 64) * (DM / 64), I_O = (DM / 64) * (DM / 64);
    constexpr int I_LR = 32;
    constexpr int PER_L = 2 * (I_13 + I_2) + I_IN + I_G + I_B + I_O + I_LR;
    for (int it = gw; it < DEPTH * PER_L; it += NGW) {
        const int l = it / PER_L; int r = it % PER_L;
        unsigned char* wl = F.ws + WS_W + (size_t)l * WL_BYTES;
        if (r < 2 * (I_13 + I_2)) {
            const int ffn = r / (I_13 + I_2); r %= (I_13 + I_2);
            if (r < I_13) { const int kblk = DM / 64, kb = r % kblk, nb = r / kblk, n0 = nb * 64, tile = n0 >> 8, within = n0 & 255;
                const float* w = in[within < 128 ? (ffn ? I_F2W1 : I_F1W1) : (ffn ? I_F2W3 : I_F1W3)] + (size_t)l * DM * DFF;
                tr_item64(w, DFF, tile * 128 + (within & 127), (bf16*)(wl + (ffn ? WL_W13B : WL_W13A)), DM, kb * 64, n0, T, lane, in[ffn ? I_F2N : I_F1N] + (size_t)l * DM); }
            else { r -= I_13; const int kblk = DFF / 64, kb = r % kblk, nb = r / kblk; tr_item64(in[ffn ? I_F2W2 : I_F1W2] + (size_t)l * DFF * DM, DM, nb * 64, (bf16*)(wl + (ffn ? WL_W2B : WL_W2A)), DFF, kb * 64, nb * 64, T, lane); }
            continue; }
        r -= 2 * (I_13 + I_2);
        if (r < I_IN) { const int kblk = DM / 64, kb = r % kblk, nb = r / kblk, n0 = nb * 64; const float* w = in[I_WIN] + (size_t)l * DM * 7960;
            if (n0 < 7936) tr_item64(w, 7960, n0 < 2048 ? n0 : n0 + 8, (bf16*)(wl + WL_WIN), DM, kb * 64, n0, T, lane, in[I_MIXN] + (size_t)l * DM);
            else if (n0 == 7936) tr_item64_win_special(w, (bf16*)(wl + WL_WIN), kb * 64, T, lane, in[I_MIXN] + (size_t)l * DM);
            else { const v4u z = {0u, 0u, 0u, 0u};
#pragma unroll
                for (int p = 0; p < 8; ++p) { const int n = (lane >> 3) + 8 * p, kc = lane & 7; *(GAS v4u*)((bf16*)(wl + WL_WIN) + (size_t)(n0 + n) * DM + kb * 64 + 8 * kc) = z; } }
            continue; }
        r -= I_IN;
        if (r < I_G) { const int kblk = DM / 64, kb = r % kblk, nb = r / kblk, gn = nb >> 5, gt = nb & 31;
            tr_item64<true>(in[I_WG] + (size_t)l * DM * 4 * DM, 4 * DM, nb * 64, (bf16*)(wl + WL_WG), DM, kb * 64, 256 * gt + 128 * (gn >> 1) + 4 * (gn & 1), T, lane, in[I_MIXN] + (size_t)l * DM); continue; }
        r -= I_G;
        if (r < I_B) { const int per = (MW / 64) * (DM / 64), n = r / per; r %= per; const int kblk = MW / 64, kb = r % kblk, nb = r / kblk;
            tr_item64(in[I_WB] + ((size_t)l * 4 + n) * MW * DM, DM, nb * 64, (bf16*)(wl + WL_WB) + (size_t)n * DM * MW, MW, kb * 64, nb * 64, T, lane); continue; }
        r -= I_B;
        if (r < I_O) { const int kblk = DM / 64, kb = r % kblk, nb = r / kblk; tr_item64(in[I_WO] + (size_t)l * DM * DM, DM, nb * 64, (bf16*)(wl + WL_WO), DM, kb * 64, nb * 64, T, lane); continue; }
        r -= I_O;
        { bf16* lr = (bf16*)(F.ws + WS_LORA) + (size_t)l * 131072;
          if (r < 8) tr_item64(in[I_RW2] + (size_t)l * 64 * MW, MW, r * 64, lr, 64, 0, r * 64, T, lane);
          else if (r < 16) tr_item64(in[I_RA2] + (size_t)l * 64 * MW, MW, (r - 8) * 64, lr + 32768, 64, 0, (r - 8) * 64, T, lane);
          else { const int q = r - 16; tr_item64(in[I_RG2] + (size_t)l * 128 * MW, MW, (q >> 1) * 64, lr + 65536, 128, (q & 1) * 64, (q >> 1) * 64, T, lane); } }
    }
}
__device__ __forceinline__ void xin_phase(Frame& F, const float* x, bf16* xb, float* ssp) {
    const int gw = F.vcu * NWAVES + F.wave, NGW = F.G * NWAVES;
    for (int m = gw; m < SEQ; m += NGW) {
        const GAS f32x4* xr = (const GAS f32x4*)(x + (size_t)m * DM) + F.lane; f32x4 v[8]; float s = 0.f;
#pragma unroll
        for (int j = 0; j < 8; ++j) { v[j] = xr[64 * j]; s += (v[j].x * v[j].x + v[j].y * v[j].y) + (v[j].z * v[j].z + v[j].w * v[j].w); }
        s = wave_sum(s); if (F.lane < 8) ssp[(size_t)F.lane * SEQ + m] = (F.lane == 0) ? s : 0.f;
        GAS unsigned long long* o8 = (GAS unsigned long long*)(xb + (size_t)m * DM) + F.lane;
#pragma unroll
        for (int j = 0; j < 8; ++j) o8[64 * j] = (unsigned long long)cvtpk(v[j].x, v[j].y) | ((unsigned long long)cvtpk(v[j].z, v[j].w) << 32);
    }
}
struct PrepP {
    const bf16* Z; const int* pos; const bf16 *w2t, *a2t, *g2t;
    const float *fox_fb, *fox_qg, *fox_kg, *mu, *w0, *w2, *a0, *a2, *g2, *k_k, *k_a, *r_k, *conv_w, *conv_b, *mib, *mfb;
    bf16 *FQ, *FK, *RQ, *RK, *MQ, *MK, *RG, *FV, *FO, *TV, *TG, *MV, *MO; float *RW, *RBON, *FP, *FT, *MBC, *MA, *MAX, *MBL;
};
__device__ __forceinline__ void prep_phase(Frame& F, const PrepP& P, int pmask) {
    const int gw = F.vcu * NWAVES + F.wave, NGW = F.G * NWAVES, lane = F.lane;
    if (pmask & 1) for (int it = gw; it < 128 * NH; it += NGW) {
        const int j = it >> 3, h = it & 7, t = 64 * j + lane; const bf16* zr = P.Z + (size_t)t * ZW;
        const float lf = logsigf_(bf1(zr + ZC_FF + h) + P.fox_fb[h]);
        const float inc = wave_incl_scan(lf, lane);
        P.FP[h * SEQ + t] = inc; if (lane == 63) P.FT[h * 128 + j] = inc;
        const float li = bf1(zr + ZC_MI + h) + P.mib[h];
        const float lfm = logsigf_(bf1(zr + ZC_MF + h) + P.mfb[h]);
        const float bc = wave_incl_scan(lfm, lane);
        P.MBC[h * SEQ + t] = bc; P.MA[h * SEQ + t] = li - bc;
        const float amax = wave_incl_max(li - bc, lane); if (lane == 63) { P.MAX[h * 128 + j] = amax; P.MBL[h * 128 + j] = bc; }
    }
    if (pmask & 2) {
        const int o8 = 8 * (lane & 7);
        float qg[8], kg[8], ifr[8];
#pragma unroll
        for (int i = 0; i < 8; ++i) { qg[i] = P.fox_qg[o8 + i] * (0.125f * 1.4426950408889634f); kg[i] = P.fox_kg[o8 + i];
            const int f = (o8 + i) & 31; ifr[i] = powf(10000.f, -(float)(2 * f) / 64.f); }
        const bool first = (lane & 7) < 4;
        for (int t = gw; t < SEQ; t += NGW) {
            const bf16* zr = P.Z + (size_t)t * ZW;
            {
                float q[8], k[8]; unpack8(*(const v4u*)(zr + ZC_FQ + 8 * lane), q); unpack8(*(const v4u*)(zr + ZC_FK + 8 * lane), k);
                float sq = 0.f, sk = 0.f;
#pragma unroll
                for (int i = 0; i < 8; ++i) { sq += q[i] * q[i]; sk += k[i] * k[i]; }
                sq += shx<1>(sq); sk += shx<1>(sk); sq += shx<2>(sq); sk += shx<2>(sk); sq += shx<4>(sq); sk += shx<4>(sk);
                const float rq = __builtin_amdgcn_rsqf(sq * (1.f / 64.f) + 1e-6f), rk = __builtin_amdgcn_rsqf(sk * (1.f / 64.f) + 1e-6f);
#pragma unroll
                for (int i = 0; i < 8; ++i) { q[i] = q[i] * rq * qg[i]; k[i] = k[i] * rk * kg[i]; }
                *(v4u*)(P.FQ + (size_t)t * MW + 8 * lane) = pack8(q); *(v4u*)(P.FK + (size_t)t * MW + 8 * lane) = pack8(k);
            }
            {
                const float pf = (float)P.pos[t];
                float cs[8], sn[8];
#pragma unroll
                for (int i = 0; i < 8; ++i) { const float ang = pf * ifr[i]; const double rev = (double)ang * 0.15915494309189535; const float fr = (float)(rev - rint(rev));
                    sn[i] = __builtin_amdgcn_sinf(fr); cs[i] = __builtin_amdgcn_cosf(fr); }
                float q[8], k[8], qo[8], ko[8]; unpack8(*(const v4u*)(zr + ZC_TQ + 8 * lane), q); unpack8(*(const v4u*)(zr + ZC_TK + 8 * lane), k);
#pragma unroll
                for (int i = 0; i < 8; ++i) { const float qp = bperm(lane ^ 4, q[i]), kp = bperm(lane ^ 4, k[i]);
                    qo[i] = first ? (q[i] * cs[i] - qp * sn[i]) : (qp * sn[i] + q[i] * cs[i]);
                    ko[i] = 0.125f * (first ? (k[i] * cs[i] - kp * sn[i]) : (kp * sn[i] + k[i] * cs[i])); }
                *(v4u*)(P.RQ + (size_t)t * MW + 8 * lane) = pack8(qo); *(v4u*)(P.RK + (size_t)t * MW + 8 * lane) = pack8(ko);
            }
#pragma unroll
            for (int p = 0; p < 2; ++p) {
                const int ch = 512 * p + 8 * lane; float acc[8];
#pragma unroll
                for (int i = 0; i < 8; ++i) acc[i] = P.conv_b[ch + i];
#pragma unroll
                for (int j = 0; j < 4; ++j) { const int tt = t - 3 + j; if (tt >= 0) { float x[8]; unpack8(*(const v4u*)(P.Z + (size_t)tt * ZW + ZC_MQK + ch), x);
#pragma unroll
                        for (int i = 0; i < 8; ++i) acc[i] += P.conv_w[j * 1024 + ch + i] * x[i]; } }
#pragma unroll
                for (int i = 0; i < 8; ++i) acc[i] = siluf_(acc[i]) * (p ? 0.125f : 1.f);
                *(v4u*)((p ? P.MK : P.MQ) + (size_t)t * MW + 8 * lane) = pack8(acc);
            }
        }
    }
    if (pmask & 4) {
        constexpr int XS = 264, OS = 520;
        LAS bf16* Xb = (LAS bf16*)(F.lds + RING_OFF); LAS bf16* OW = Xb + 32 * XS; LAS bf16* OA = OW + 32 * OS; LAS bf16* OG = OA + 32 * OS;
        const int hh = lane >> 3, c0 = 8 * lane, wave = F.wave;
        {
            const int tb = gw, t0 = 4 * tb;
            if (lane < 32) {
                float m8[8];
#pragma unroll
                for (int i = 0; i < 8; ++i) m8[i] = P.mu[1536 + 8 * lane + i];
                float prev[8];
                if (t0 > 0) unpack8(*(const v4u*)(P.Z + (size_t)(t0 - 1) * ZW + ZC_RL + 8 * lane), prev);
                else {
#pragma unroll
                    for (int i = 0; i < 8; ++i) prev[i] = 0.f; }
#pragma unroll
                for (int tk = 0; tk < 4; ++tk) { float cur[8], xv[8]; unpack8(*(const v4u*)(P.Z + (size_t)(t0 + tk) * ZW + ZC_RL + 8 * lane), cur);
#pragma unroll
                    for (int i = 0; i < 8; ++i) { float v = cur[i] + m8[i] * (prev[i] - cur[i]); v = (lane < 8) ? tanhf(v) : ((lane < 16) ? v : sigmoidf_(v)); xv[i] = v; prev[i] = cur[i]; }
                    *(LAS v4u*)(Xb + (4 * wave + tk) * XS + 8 * lane) = pack8(xv); }
            }
            __syncthreads();
            {
                typedef float f32x16_t __attribute__((ext_vector_type(16)));
                const int n = lane & 31, h = lane >> 5;
#pragma unroll
                for (int mat = 0; mat < 3; ++mat) { const int K = (mat == 2) ? 128 : 64, koff = (mat == 0) ? 0 : ((mat == 1) ? 64 : 128); const bf16* wt = (mat == 0) ? P.w2t : ((mat == 1) ? P.a2t : P.g2t); LAS bf16* O = (mat == 0) ? OW : ((mat == 1) ? OA : OG);
#pragma unroll
                    for (int ct = 0; ct < 2; ++ct) { f32x16_t acc = {0.f, 0.f, 0.f, 0.f, 0.f, 0.f, 0.f, 0.f, 0.f, 0.f, 0.f, 0.f, 0.f, 0.f, 0.f, 0.f};
                        const bf16* wrow = wt + (size_t)(64 * wave + 32 * ct + n) * K + 8 * h;
#pragma unroll
                        for (int ks = 0; ks < ((mat == 2) ? 8 : 4); ++ks) { const bf16x8 a = *(const LAS bf16x8*)(Xb + n * XS + koff + 16 * ks + 8 * h), b = *(const bf16x8*)(wrow + 16 * ks);
                            acc = __builtin_amdgcn_mfma_f32_32x32x16_bf16(a, b, acc, 0, 0, 0); }
#pragma unroll
                        for (int r_ = 0; r_ < 16; ++r_) O[((r_ & 3) + 8 * (r_ >> 2) + 4 * h) * OS + 64 * wave + 32 * ct + n] = (bf16)f2bf(acc[r_]); } }
            }
            __syncthreads();
            float aw[4][8], aa[4][8];
#pragma unroll
            for (int tk = 0; tk < 4; ++tk) { unpack8(*(const LAS v4u*)(OW + (4 * wave + tk) * OS + c0), aw[tk]); unpack8(*(const LAS v4u*)(OA + (4 * wave + tk) * OS + c0), aa[tk]); }
            float pr[8], pk[8], pv[8];
            if (t0 > 0) { const bf16* zp = P.Z + (size_t)(t0 - 1) * ZW; unpack8(*(const v4u*)(zp + ZC_RR + c0), pr); unpack8(*(const v4u*)(zp + ZC_RK + c0), pk); unpack8(*(const v4u*)(zp + ZC_RV + c0), pv); }
            else {
#pragma unroll
                for (int i = 0; i < 8; ++i) { pr[i] = 0.f; pk[i] = 0.f; pv[i] = 0.f; } }
#pragma unroll
            for (int tk = 0; tk < 4; ++tk) {
                asm volatile("" ::: "memory");
                const int t = t0 + tk; const bf16* zc = P.Z + (size_t)t * ZW;
                unsigned char* recb = (unsigned char*)(P.RW + ((size_t)hh * SEQ + t) * RREC) + 16 * (lane & 7);
                float r[8], k[8];
                { float cr[8], cv[8], v[8]; unpack8(*(const v4u*)(zc + ZC_RR + c0), cr); unpack8(*(const v4u*)(zc + ZC_RV + c0), cv);
#pragma unroll
                  for (int i = 0; i < 8; ++i) { r[i] = cr[i] + P.mu[c0 + i] * (pr[i] - cr[i]); v[i] = cv[i] + P.mu[1024 + c0 + i] * (pv[i] - cv[i]); pr[i] = cr[i]; pv[i] = cv[i]; }
                  *(v4u*)(recb + 512) = pack8(v); }
                { float w[8], wr[8];
#pragma unroll
                  for (int i = 0; i < 8; ++i) { const float u = P.w0[c0 + i] + aw[tk][i]; w[i] = -0.6065306597126334f * sigmoidf_(u); wr[i] = r[i]; }
                  float* lwp = (float*)(recb + 640 + 16 * (lane & 7)); *(f32x4*)lwp = (f32x4){w[0], w[1], w[2], w[3]}; *(f32x4*)(lwp + 4) = (f32x4){w[4], w[5], w[6], w[7]};
                  *(v4u*)(recb + 384) = pack8(wr); }
                { float ck[8]; unpack8(*(const v4u*)(zc + ZC_RK + c0), ck);
#pragma unroll
                  for (int i = 0; i < 8; ++i) { k[i] = ck[i] + P.mu[512 + c0 + i] * (pk[i] - ck[i]); pk[i] = ck[i]; } }
                float a[8], kk[8]; float ss = 0.f;
#pragma unroll
                for (int i = 0; i < 8; ++i) { a[i] = sigmoidf_(P.a0[c0 + i] + aa[tk][i]); kk[i] = k[i] * P.k_k[c0 + i]; ss += kk[i] * kk[i]; }
                ss += shx<1>(ss); ss += shx<2>(ss); ss += shx<4>(ss);
                const float rn = __builtin_amdgcn_rsqf(fmaxf(ss, 1e-12f));
                float c1 = 0.f, c2 = 0.f, bo = 0.f; float kp[8], b[8];
#pragma unroll
                for (int i = 0; i < 8; ++i) { kk[i] *= rn; kp[i] = k[i] * (1.f + (a[i] - 1.f) * P.k_a[c0 + i]); b[i] = kk[i] * a[i]; c1 += b[i] * r[i]; c2 += kp[i] * r[i]; bo += r[i] * kp[i] * P.r_k[c0 + i]; }
                c1 += shx<1>(c1); c2 += shx<1>(c2); bo += shx<1>(bo); c1 += shx<2>(c1); c2 += shx<2>(c2); bo += shx<2>(bo); c1 += shx<4>(c1); c2 += shx<4>(c2); bo += shx<4>(bo);
                *(v4u*)(recb) = pack8(kk); *(v4u*)(recb + 128) = pack8(b); *(v4u*)(recb + 256) = pack8(kp);
                if ((lane & 7) == 0) P.RBON[t * 8 + hh] = bo;
            }
#pragma unroll
            for (int tk = 0; tk < 4; ++tk) *(v4u*)(P.RG + (size_t)(t0 + tk) * MW + c0) = *(const LAS v4u*)(OG + (4 * wave + tk) * OS + c0);
            __syncthreads();
        }
    }
}
constexpr int SC_STEPS = 32, SC_BUF = SC_STEPS * RREC * 4;
__device__ __forceinline__ void rwkv_scan_role(Frame& F, const float* RW, float* YRAW, int head, int quarter) {
    const int tid = F.tid, lane = F.lane, j16 = lane & 15, rr = lane >> 4;
    const int row = 16 * quarter + 4 * (F.wave & 3) + rr;
    const bool active = F.wave < 4;
    const float* src = RW + (size_t)head * SEQ * RREC;
    LAS unsigned char* buf0 = F.lds + RING_OFF;
    constexpr int NPIECE = SC_BUF / 16, NIT = (NPIECE + 511) / 512;
    f32x4 st[NIT];
#pragma unroll
    for (int i = 0; i < NIT; ++i) { const int p = tid + 512 * i; if (p < NPIECE) *(LAS f32x4*)(buf0 + 16 * p) = *(const f32x4*)(src + 4 * p); }
    __syncthreads();
    float s0 = 0.f, s1 = 0.f, s2 = 0.f, s3 = 0.f, ybuf = 0.f;
    constexpr int NCH = SEQ / SC_STEPS;
    for (int c = 0; c < NCH; ++c) {
        const LAS unsigned char* cur = buf0 + (c & 1) * SC_BUF; LAS unsigned char* nxt = buf0 + ((c + 1) & 1) * SC_BUF;
        if (c + 1 < NCH) {
#pragma unroll
            for (int i = 0; i < NIT; ++i) { const int p = tid + 512 * i; if (p < NPIECE) st[i] = *(const f32x4*)(src + (size_t)(c + 1) * (SC_BUF / 4) + 4 * p); }
        }
        if (active) {
        const LAS unsigned char* rp = cur + 16 * j16;
        f32x4 kk = *(const LAS f32x4*)(rp), bb = *(const LAS f32x4*)(rp + 256), ww = *(const LAS f32x4*)(rp + 512), kp = *(const LAS f32x4*)(rp + 768), wr = *(const LAS f32x4*)(rp + 1024);
        float vv = *(const LAS float*)(cur + 1280 + 4 * row); float c1 = *(const LAS float*)(cur + 1536), c2 = *(const LAS float*)(cur + 1540);
#pragma unroll 4
        for (int s = 0; s < SC_STEPS; ++s) {
            const LAS unsigned char* np_ = cur + ((s + 1) & (SC_STEPS - 1)) * (RREC * 4) + 16 * j16; const LAS unsigned char* nb_ = cur + ((s + 1) & (SC_STEPS - 1)) * (RREC * 4);
            const f32x4 nkk = *(const LAS f32x4*)(np_), nbb = *(const LAS f32x4*)(np_ + 256), nww = *(const LAS f32x4*)(np_ + 512), nkp = *(const LAS f32x4*)(np_ + 768), nwr = *(const LAS f32x4*)(np_ + 1024);
            const float nvv = *(const LAS float*)(nb_ + 1280 + 4 * row), nc1 = *(const LAS float*)(nb_ + 1536), nc2 = *(const LAS float*)(nb_ + 1540);
            float d1 = s0 * kk[0] + s1 * kk[1] + (s2 * kk[2] + s3 * kk[3]);
            float d2 = s0 * wr[0] + s1 * wr[1] + (s2 * wr[2] + s3 * wr[3]);
            d1 = row16_sum(d1); d2 = row16_sum(d2);
            const float sa = -d1;
            s0 = fmaf(sa, bb[0], fmaf(s0, ww[0], vv * kp[0])); s1 = fmaf(sa, bb[1], fmaf(s1, ww[1], vv * kp[1]));
            s2 = fmaf(sa, bb[2], fmaf(s2, ww[2], vv * kp[2])); s3 = fmaf(sa, bb[3], fmaf(s3, ww[3], vv * kp[3]));
            const float y = d2 + sa * c1 + vv * c2;
            ybuf = (j16 == (s & 15)) ? y : ybuf;
            if ((s & 15) == 15) YRAW[(size_t)(c * SC_STEPS + (s & ~15) + j16) * MW + head * 64 + row] = ybuf;
            kk = nkk; bb = nbb; ww = nww; kp = nkp; wr = nwr; vv = nvv; c1 = nc1; c2 = nc2;
        }
        }
        if (c + 1 < NCH) {
#pragma unroll
            for (int i = 0; i < NIT; ++i) { const int p = tid + 512 * i; if (p < NPIECE) *(LAS f32x4*)(nxt + 16 * p) = st[i]; }
        }
        __syncthreads();
    }
}
constexpr int CK_TILE = 64 * LDT * 2;
constexpr int CK_Q = 0, CK_K = 2 * CK_TILE, CK_VT = 4 * CK_TILE, CK_KT = 6 * CK_TILE, CK_S = 8 * CK_TILE, CK_STB = 9 * CK_TILE, CK_OF = 10 * CK_TILE, CK_G = CK_OF + 64 * 68 * 4, CK_NV = CK_G + 2 * 1280, CK_END = CK_NV + 512;
__device__ __forceinline__ f32x4 mma64(f32x4 acc, const LAS bf16* A, const LAS bf16* B, int fr, int fq) {
#pragma unroll
    for (int ks = 0; ks < 2; ++ks) { const bf16x8 a = *(const LAS bf16x8*)(A + fr * LDT + ks * 32 + fq * 8), b = *(const LAS bf16x8*)(B + fr * LDT + ks * 32 + fq * 8);
        acc = __builtin_amdgcn_mfma_f32_16x16x32_bf16(a, b, acc, 0, 0, 0); }
    return acc;
}
__device__ __forceinline__ int swz(int row, int chunk) { return row * LDT + ((chunk ^ ((row >> 3) & 7)) << 3); }
template <bool SA, bool SB> __device__ __forceinline__ f32x4 mma64s(f32x4 acc, const LAS bf16* A, int ra, const LAS bf16* B, int rbw, int fr, int fq) {
#pragma unroll
    for (int ks = 0; ks < 2; ++ks) { const int ch = ks * 4 + fq;
        const bf16x8 a = *(const LAS bf16x8*)(A + (SA ? swz(ra + fr, ch) : (ra + fr) * LDT + ch * 8)), b = *(const LAS bf16x8*)(B + (SB ? swz(rbw + fr, ch) : (rbw + fr) * LDT + ch * 8));
        acc = __builtin_amdgcn_mfma_f32_16x16x32_bf16(a, b, acc, 0, 0, 0); }
    return acc;
}
template <int MODE> __device__ __forceinline__ void chunk_role(Frame& F, const bf16* Qp, const bf16* Kp, const bf16* Vp, const bf16* Gp, const float* gain, bf16* Y, int head, const float* MBC, const float* MA) {
    const int tid = F.tid, lane = F.lane, wave = F.wave, row = tid >> 3, seg = tid & 7, rb = wave >> 1, cb0 = 2 * (wave & 1), fr = lane & 15, fq = lane >> 4;
    LAS unsigned char* L = F.lds + RING_OFF;
    LAS bf16* Ss = (LAS bf16*)(L + CK_S); LAS bf16* STb = (LAS bf16*)(L + CK_STB); LAS float* Of = (LAS float*)(L + CK_OF); LAS float* NV = (LAS float*)(L + CK_NV);
    const float log2g = (MODE == 0) ? log2f(1.f - exp2f(-5.f - (float)head)) : 0.f;
    for (int i = tid; i < 64 * LDT / 2; i += 512) ((LAS unsigned*)STb)[i] = 0u;
    if (tid < 128) NV[tid] = 0.f;
    if (MODE == 0 && tid < 128) { LAS float* G = (LAS float*)(L + CK_G) + (tid >> 6) * 320; G[192 + (tid & 63)] = exp2f((float)(63 - (tid & 63)) * log2g); }
    f32x4 st0 = {0.f, 0.f, 0.f, 0.f}, st1 = {0.f, 0.f, 0.f, 0.f};
    const size_t gofs = (size_t)head * 64 + 8 * seg;
    v4u q8, k8, v8, g8;
    { const size_t t = row; q8 = *(const v4u*)(Qp + t * MW + gofs); k8 = *(const v4u*)(Kp + t * MW + gofs); v8 = *(const v4u*)(Vp + t * ZW + gofs); g8 = *(const v4u*)(Gp + t * ZW + gofs); }
    float gn[8];
#pragma unroll
    for (int i = 0; i < 8; ++i) gn[i] = gain[gofs + i];
    float a_n = 0.f, bc_n = 0.f;
    if (MODE == 1 && wave == 0) { a_n = MA[(size_t)head * SEQ + lane]; bc_n = MBC[(size_t)head * SEQ + lane]; }
    for (int c = 0; c < 128; ++c) {
        const int bsel = c & 1;
        { LAS bf16* Qs = (LAS bf16*)(L + CK_Q + bsel * CK_TILE); LAS bf16* Ks = (LAS bf16*)(L + CK_K + bsel * CK_TILE); LAS bf16* VT = (LAS bf16*)(L + CK_VT + bsel * CK_TILE); LAS bf16* KT = (LAS bf16*)(L + CK_KT + bsel * CK_TILE);
          *(LAS v4u*)(Qs + row * LDT + 8 * seg) = q8; *(LAS v4u*)(Ks + row * LDT + 8 * seg) = k8;
          const unsigned kw[4] = {k8.x, k8.y, k8.z, k8.w}, vw[4] = {v8.x, v8.y, v8.z, v8.w};
#pragma unroll
          for (int i = 0; i < 4; ++i) { const int c_ = ((((row >> 3) ^ seg) & 7) << 3) + (row & 7), r0 = (8 * seg + 2 * i) * LDT + c_, r1 = r0 + LDT;
              KT[r0] = (bf16)(kw[i] & 0xffffu); KT[r1] = (bf16)(kw[i] >> 16); VT[r0] = (bf16)(vw[i] & 0xffffu); VT[r1] = (bf16)(vw[i] >> 16); }
          if (MODE == 1 && wave == 0) { LAS float* G = (LAS float*)(L + CK_G) + bsel * 320; const LAS float* Gp_ = (const LAS float*)(L + CK_G) + (bsel ^ 1) * 320;
              const float a = a_n, bc = bc_n; if (c + 1 < 128) { a_n = MA[(size_t)head * SEQ + 64 * (c + 1) + lane]; bc_n = MBC[(size_t)head * SEQ + 64 * (c + 1) + lane]; }
              const float mp = (c == 0) ? 0.f : Gp_[256];
              const float Mi = fmaxf(mp, wave_incl_max(a, lane)); const float M63 = rdlane(Mi, 63);
              G[lane] = a; G[64 + lane] = Mi; G[128 + lane] = bc; G[192 + lane] = __expf(a - M63);
              if (lane == 63) { G[256] = bc + Mi; G[257] = mp; } }
        }
        const v4u gcur = g8;
        if (c + 1 < 128) { const size_t t = (size_t)64 * (c + 1) + row; q8 = *(const v4u*)(Qp + t * MW + gofs); k8 = *(const v4u*)(Kp + t * MW + gofs); v8 = *(const v4u*)(Vp + t * ZW + gofs); g8 = *(const v4u*)(Gp + t * ZW + gofs); }
        asm volatile("s_waitcnt lgkmcnt(0)\n\ts_barrier" ::: "memory");
        const LAS bf16* Qs = (const LAS bf16*)(L + CK_Q + bsel * CK_TILE); const LAS bf16* Ks = (const LAS bf16*)(L + CK_K + bsel * CK_TILE); const LAS bf16* VT = (const LAS bf16*)(L + CK_VT + bsel * CK_TILE); const LAS bf16* KT = (const LAS bf16*)(L + CK_KT + bsel * CK_TILE);
        const LAS float* G = (const LAS float*)(L + CK_G) + bsel * 320;
        const float mp = (MODE == 1) ? G[257] : 0.f;
        f32x4 o0, o1;
        {
            const f32x4 z4 = {0.f, 0.f, 0.f, 0.f};
#pragma unroll
            for (int ct = 0; ct < 2; ++ct) { const int cb = cb0 + ct; f32x4 sc = mma64(z4, Qs + 16 * rb * LDT, Ks + 16 * cb * LDT, fr, fq);
                const int j = 16 * cb + fr; const float aj = (MODE == 1) ? G[j] : 0.f;
#pragma unroll
                for (int e = 0; e < 4; ++e) { const int i = 16 * rb + 4 * fq + e; float d;
                    if (MODE == 0) d = exp2f((float)(i > j ? i - j : j - i) * log2g); else d = (j <= i) ? __expf(aj - G[64 + i]) : 0.f;
                    Ss[i * LDT + j] = (bf16)f2bf(sc[e] * d); } }
            o0 = mma64(z4, Qs + 16 * rb * LDT, STb + 16 * cb0 * LDT, fr, fq); o1 = mma64(z4, Qs + 16 * rb * LDT, STb + 16 * (cb0 + 1) * LDT, fr, fq);
#pragma unroll
            for (int e = 0; e < 4; ++e) { const int i = 16 * rb + 4 * fq + e; const float sc = (MODE == 0) ? exp2f((float)(i + 1) * log2g) : __expf(mp - G[64 + i]); o0[e] *= sc; o1[e] *= sc; }
            const float dec = (MODE == 0) ? exp2f(64.f * log2g) : __expf(mp - G[64 + 63]);
            st0 *= dec; st1 *= dec;
#pragma unroll
            for (int ks = 0; ks < 2; ++ks) { float a8[8]; unpack8(*(const LAS v4u*)(VT + swz(16 * rb + fr, ks * 4 + fq)), a8);
                const f32x4 w0 = *(const LAS f32x4*)(G + 192 + ks * 32 + fq * 8), w1 = *(const LAS f32x4*)(G + 192 + ks * 32 + fq * 8 + 4);
                a8[0] *= w0[0]; a8[1] *= w0[1]; a8[2] *= w0[2]; a8[3] *= w0[3]; a8[4] *= w1[0]; a8[5] *= w1[1]; a8[6] *= w1[2]; a8[7] *= w1[3];
                const bf16x8 a = __builtin_bit_cast(bf16x8, pack8(a8));
                const bf16x8 b0 = *(const LAS bf16x8*)(KT + swz(16 * cb0 + fr, ks * 4 + fq)), b1 = *(const LAS bf16x8*)(KT + swz(16 * (cb0 + 1) + fr, ks * 4 + fq));
                st0 = __builtin_amdgcn_mfma_f32_16x16x32_bf16(a, b0, st0, 0, 0, 0); st1 = __builtin_amdgcn_mfma_f32_16x16x32_bf16(a, b1, st1, 0, 0, 0); }
        }
        asm volatile("s_waitcnt lgkmcnt(0)\n\ts_barrier" ::: "memory");
        o0 = mma64s<false, true>(o0, Ss, 16 * rb, VT, 16 * cb0, fr, fq); o1 = mma64s<false, true>(o1, Ss, 16 * rb, VT, 16 * (cb0 + 1), fr, fq);
#pragma unroll
        for (int e = 0; e < 4; ++e) { const int r_ = 16 * rb + 4 * fq + e;
            STb[r_ * LDT + 16 * cb0 + fr] = (bf16)f2bf(st0[e]); STb[r_ * LDT + 16 * (cb0 + 1) + fr] = (bf16)f2bf(st1[e]);
            Of[r_ * 68 + 16 * cb0 + fr] = o0[e]; Of[r_ * 68 + 16 * (cb0 + 1) + fr] = o1[e]; }
        asm volatile("s_waitcnt lgkmcnt(0)\n\ts_barrier" ::: "memory");
        {
            float o[8]; { const f32x4 a = *(const LAS f32x4*)(Of + row * 68 + 8 * seg), b = *(const LAS f32x4*)(Of + row * 68 + 8 * seg + 4); o[0] = a[0]; o[1] = a[1]; o[2] = a[2]; o[3] = a[3]; o[4] = b[0]; o[5] = b[1]; o[6] = b[2]; o[7] = b[3]; }
            float gz[8]; unpack8(gcur, gz);
            if (MODE == 1) {
                float s8[8], q8f[8]; unpack8(*(const LAS v4u*)(Ss + row * LDT + 8 * seg), s8); unpack8(*(const LAS v4u*)(Qs + row * LDT + 8 * seg), q8f);
                const LAS float* nv = NV + bsel * 64 + 8 * seg; float ds = 0.f, nq = 0.f;
#pragma unroll
                for (int i = 0; i < 8; ++i) { ds += s8[i]; nq += nv[i] * q8f[i]; }
                ds += shx<1>(ds); nq += shx<1>(nq); ds += shx<2>(ds); nq += shx<2>(nq); ds += shx<4>(ds); nq += shx<4>(nq);
                const float Mi = G[64 + row], den = ds + __expf(mp - Mi) * nq, dn = fmaxf(fabsf(den), __expf(-(G[128 + row] + Mi))), inv = 1.f / dn;
#pragma unroll
                for (int i = 0; i < 8; ++i) o[i] = o[i] * inv * sigmoidf_(gz[i]);
                float k8f[8]; unpack8(*(const LAS v4u*)(KT + swz(row, seg)), k8f); float ns = 0.f;
#pragma unroll
                for (int i = 0; i < 8; ++i) ns += k8f[i] * G[192 + 8 * seg + i];
                ns += shx<1>(ns); ns += shx<2>(ns); ns += shx<4>(ns);
                if (seg == 0) NV[(bsel ^ 1) * 64 + row] = __expf(mp - G[64 + 63]) * NV[bsel * 64 + row] + ns;
            }
            float ss = 0.f;
#pragma unroll
            for (int i = 0; i < 8; ++i) ss += o[i] * o[i];
            ss += shx<1>(ss); ss += shx<2>(ss); ss += shx<4>(ss);
            const float rs = 1.f / sqrtf(ss * (1.f / 64.f) + 1e-6f);
#pragma unroll
            for (int i = 0; i < 8; ++i) { o[i] = o[i] * rs * gn[i]; if (MODE == 0) o[i] *= siluf_(gz[i]); }
            *(v4u*)(Y + ((size_t)64 * c + row) * MW + gofs) = pack8(o);
        }
    }
    __syncthreads();
}
constexpr int RC_B = 64 * LDT * 2;
constexpr int RC_KT = 0, RC_KH = RC_B, RC_BH = 2 * RC_B, RC_RT = 3 * RC_B, RC_KTT = 4 * RC_B, RC_KHT = 5 * RC_B, RC_BHT = 6 * RC_B, RC_VT = 7 * RC_B, RC_M = 8 * RC_B, RC_QKT = 9 * RC_B, RC_QBT = 10 * RC_B, RC_UL = 11 * RC_B;
constexpr int RC_NF = 12 * RC_B, RC_GC = RC_NF + 64 * 68 * 4, RC_END = RC_GC + 256;
constexpr int RC_TT = RC_KT, RC_MTT = RC_KH, RC_W1 = RC_BH, RC_RQS = RC_M, RC_PCS = RC_KT;
static_assert(RC_END <= RING_BYTES, "chunked rwkv LDS map");
struct RwkvC { const float* RW; bf16* RQT; bf16* PCT; float* YLT; float* SL; float* GCV; bf16* SALL; };
__device__ __forceinline__ f32x4 mma64g(f32x4 acc, const LAS bf16* A, const bf16* Bg, int ldb, int fr, int fq) {
#pragma unroll
    for (int ks = 0; ks < 2; ++ks) { const bf16x8 a = *(const LAS bf16x8*)(A + fr * LDT + ks * 32 + fq * 8), b = *(const bf16x8*)(Bg + (size_t)fr * ldb + ks * 32 + fq * 8);
        acc = __builtin_amdgcn_mfma_f32_16x16x32_bf16(a, b, acc, 0, 0, 0); }
    return acc;
}
__device__ __forceinline__ void rwkv_r1(Frame& F, const RwkvC& R) {
    const int tid = F.tid, lane = F.lane, wave = F.wave, fr = lane & 15, fq = lane >> 4, rb = wave >> 1, cb0 = 2 * (wave & 1);
    LAS unsigned char* L = F.lds + RING_OFF;
    LAS float* NF = (LAS float*)(L + RC_NF); LAS float* GC = (LAS float*)(L + RC_GC);
    const f32x4 z4 = {0.f, 0.f, 0.f, 0.f};
    v4u nkk, nb_, nkp, nr, nv; f32x4 nl0, nl1;
#define R1_LOAD(PI) do { const unsigned char* rb_ = (const unsigned char*)(R.RW + ((size_t)((PI) >> 7) * SEQ + 64 * ((PI) & 127) + lane) * RREC) + 16 * wave; \
        nkk = *(const v4u*)(rb_); nb_ = *(const v4u*)(rb_ + 128); nkp = *(const v4u*)(rb_ + 256); nr = *(const v4u*)(rb_ + 384); nv = *(const v4u*)(rb_ + 512); \
        nl0 = *(const f32x4*)(rb_ + 640 + 16 * wave); nl1 = *(const f32x4*)(rb_ + 656 + 16 * wave); } while (0)
    if (F.vcu < NH * 128) R1_LOAD(F.vcu);
    for (int pi = F.vcu; pi < NH * 128; pi += F.G) {
        const int h = pi >> 7, c = pi & 127;
        {
            float kk[8], b[8], lw[8], kp[8], r[8], v[8];
            unpack8(nkk, kk); unpack8(nb_, b); unpack8(nkp, kp); unpack8(nr, r); unpack8(nv, v);
            lw[0] = nl0[0]; lw[1] = nl0[1]; lw[2] = nl0[2]; lw[3] = nl0[3]; lw[4] = nl1[0]; lw[5] = nl1[1]; lw[6] = nl1[2]; lw[7] = nl1[3];
            if (pi + F.G < NH * 128) R1_LOAD(pi + F.G);
            float kt[8], kh[8], bh[8], rt[8];
#pragma unroll
            for (int e = 0; e < 8; ++e) { const float g = wave_incl_scan(lw[e], lane); const float eg = __expf(g), egi = __expf(-g), ege = __expf(g - lw[e]);
                kt[e] = kk[e] * ege; kh[e] = kp[e] * egi; bh[e] = b[e] * egi; rt[e] = r[e] * eg; if (lane == 63) GC[8 * wave + e] = eg; }
            const v4u pkt = pack8(kt), pkh = pack8(kh), pbh = pack8(bh), prt = pack8(rt), pv = pack8(v);
            *(LAS v4u*)(L + RC_KT + (lane * LDT + 8 * wave) * 2) = pkt; *(LAS v4u*)(L + RC_KH + (lane * LDT + 8 * wave) * 2) = pkh;
            *(LAS v4u*)(L + RC_BH + (lane * LDT + 8 * wave) * 2) = pbh; *(LAS v4u*)(L + RC_RT + (lane * LDT + 8 * wave) * 2) = prt;
            const unsigned wkt[4] = {pkt.x, pkt.y, pkt.z, pkt.w}, wkh[4] = {pkh.x, pkh.y, pkh.z, pkh.w}, wbh[4] = {pbh.x, pbh.y, pbh.z, pbh.w}, wv[4] = {pv.x, pv.y, pv.z, pv.w};
#pragma unroll
            for (int i = 0; i < 4; ++i) { const int k0 = (8 * wave + 2 * i) * LDT + lane, k1 = k0 + LDT;
                ((LAS bf16*)(L + RC_KTT))[k0] = (bf16)(wkt[i] & 0xffffu); ((LAS bf16*)(L + RC_KTT))[k1] = (bf16)(wkt[i] >> 16);
                ((LAS bf16*)(L + RC_KHT))[k0] = (bf16)(wkh[i] & 0xffffu); ((LAS bf16*)(L + RC_KHT))[k1] = (bf16)(wkh[i] >> 16);
                ((LAS bf16*)(L + RC_BHT))[k0] = (bf16)(wbh[i] & 0xffffu); ((LAS bf16*)(L + RC_BHT))[k1] = (bf16)(wbh[i] >> 16);
                ((LAS bf16*)(L + RC_VT))[k0] = (bf16)(wv[i] & 0xffffu); ((LAS bf16*)(L + RC_VT))[k1] = (bf16)(wv[i] >> 16); }
        }
        __syncthreads();
        {
            const LAS bf16* Kt = (const LAS bf16*)(L + RC_KT); const LAS bf16* Kh = (const LAS bf16*)(L + RC_KH); const LAS bf16* Bh = (const LAS bf16*)(L + RC_BH); const LAS bf16* Rt = (const LAS bf16*)(L + RC_RT);
#pragma unroll
            for (int ct = 0; ct < 2; ++ct) { const int cb = cb0 + ct;
                const f32x4 n4 = mma64(z4, Bh + 16 * rb * LDT, Kt + 16 * cb * LDT, fr, fq), m4 = mma64(z4, Kh + 16 * rb * LDT, Kt + 16 * cb * LDT, fr, fq);
                const f32x4 qk4 = mma64(z4, Kh + 16 * rb * LDT, Rt + 16 * cb * LDT, fr, fq), qb4 = mma64(z4, Bh + 16 * rb * LDT, Rt + 16 * cb * LDT, fr, fq);
                const int i = 16 * cb + fr;
#pragma unroll
                for (int e = 0; e < 4; ++e) { const int j = 16 * rb + 4 * fq + e;
                    NF[j * 68 + i] = (j < i) ? n4[e] : 0.f;
                    ((LAS bf16*)(L + RC_M))[j * LDT + i] = (bf16)f2bf((j < i) ? m4[e] : 0.f);
                    ((LAS bf16*)(L + RC_QKT))[i * LDT + j] = (bf16)f2bf((j <= i) ? qk4[e] : 0.f);
                    ((LAS bf16*)(L + RC_QBT))[i * LDT + j] = (bf16)f2bf((j <= i) ? qb4[e] : 0.f); } }
        }
        __syncthreads();
        {
            const int r = tid >> 3, p = tid & 7; float t[8];
#pragma unroll
            for (int m = 0; m < 8; ++m) t[m] = 0.f;
#pragma unroll
            for (int io = 0; io < 8; ++io)
#pragma unroll
                for (int ii = 0; ii < 8; ++ii) { const int i = 8 * io + ii; float a = 0.f;
#pragma unroll
                    for (int m = 0; m <= io; ++m) a += t[m] * NF[(8 * m + p) * 68 + i];
                    a = dpp_add<0xB1>(a); a = dpp_add<0x4E>(a); a = dpp_add<0x141>(a);
                    const float val = ((i == r) ? 1.f : 0.f) - a; if (p == ii) t[io] = val; }
#pragma unroll
            for (int m = 0; m < 8; ++m) ((LAS bf16*)(L + RC_TT))[(8 * m + p) * LDT + r] = (bf16)f2bf(t[m]);
        }
        __syncthreads();
        {
            const LAS bf16* KtT = (const LAS bf16*)(L + RC_KTT); const LAS bf16* Tt = (const LAS bf16*)(L + RC_TT); const LAS bf16* Mm = (const LAS bf16*)(L + RC_M);
#pragma unroll
            for (int ct = 0; ct < 2; ++ct) { const int cb = cb0 + ct; const f32x4 w4 = mma64(z4, KtT + 16 * rb * LDT, Tt + 16 * cb * LDT, fr, fq), mt4 = mma64(z4, Mm + 16 * rb * LDT, Tt + 16 * cb * LDT, fr, fq);
                const int i = 16 * cb + fr;
#pragma unroll
                for (int e = 0; e < 4; ++e) { const int j = 16 * rb + 4 * fq + e; ((LAS bf16*)(L + RC_W1))[j * LDT + i] = (bf16)f2bf(w4[e]); ((LAS bf16*)(L + RC_MTT))[i * LDT + j] = (bf16)f2bf(mt4[e]); } }
        }
        __syncthreads();
        {
            const LAS bf16* VT = (const LAS bf16*)(L + RC_VT); const LAS bf16* MTt = (const LAS bf16*)(L + RC_MTT);
#pragma unroll
            for (int ct = 0; ct < 2; ++ct) { const int cb = cb0 + ct; const f32x4 u4 = mma64(z4, VT + 16 * rb * LDT, MTt + 16 * cb * LDT, fr, fq); const int i = 16 * cb + fr;
#pragma unroll
                for (int e = 0; e < 4; ++e) ((LAS bf16*)(L + RC_UL))[(16 * rb + 4 * fq + e) * LDT + i] = (bf16)f2bf(u4[e]); }
        }
        __syncthreads();
        {
            const LAS bf16* W1 = (const LAS bf16*)(L + RC_W1); const LAS bf16* Qbt = (const LAS bf16*)(L + RC_QBT); const LAS bf16* Qkt = (const LAS bf16*)(L + RC_QKT); const LAS bf16* Ul = (const LAS bf16*)(L + RC_UL);
            const LAS bf16* VT = (const LAS bf16*)(L + RC_VT); const LAS bf16* KhT = (const LAS bf16*)(L + RC_KHT); const LAS bf16* BhT = (const LAS bf16*)(L + RC_BHT); const LAS bf16* Rt = (const LAS bf16*)(L + RC_RT);
            float* slg = R.SL + (size_t)pi * 4096;
#pragma unroll
            for (int ct = 0; ct < 2; ++ct) { const int cb = cb0 + ct, cc = 16 * cb + fr;
                const f32x4 a_rq = mma64(z4, W1 + 16 * rb * LDT, Qbt + 16 * cb * LDT, fr, fq);
                const f32x4 a_y1 = mma64(z4, VT + 16 * rb * LDT, Qkt + 16 * cb * LDT, fr, fq), a_y2 = mma64(z4, Ul + 16 * rb * LDT, Qbt + 16 * cb * LDT, fr, fq);
                const f32x4 a_pc = mma64(z4, W1 + 16 * rb * LDT, BhT + 16 * cb * LDT, fr, fq);
                const f32x4 a_s1 = mma64(z4, VT + 16 * rb * LDT, KhT + 16 * cb * LDT, fr, fq), a_s2 = mma64(z4, Ul + 16 * rb * LDT, BhT + 16 * cb * LDT, fr, fq);
                const float gc = GC[cc];
#pragma unroll
                for (int e = 0; e < 4; ++e) { const int rr = 16 * rb + 4 * fq + e;
                    const float rtv = __builtin_bit_cast(float, (unsigned)Rt[cc * LDT + rr] << 16);
                    ((LAS bf16*)(L + RC_RQS))[cc * LDT + rr] = (bf16)f2bf(rtv - a_rq[e]);
                    NF[cc * 68 + rr] = a_y1[e] - a_y2[e];
                    ((LAS bf16*)(L + RC_PCS))[cc * LDT + rr] = (bf16)f2bf(a_pc[e] * gc);
                    slg[rr * 64 + cc] = (a_s1[e] - a_s2[e]) * gc; }
            }
        }
        __syncthreads();
        {
            const int row = tid >> 3, seg = tid & 7;
            *(v4u*)(R.RQT + (size_t)pi * 4096 + row * 64 + 8 * seg) = *(const LAS v4u*)(L + RC_RQS + (row * LDT + 8 * seg) * 2);
            *(v4u*)(R.PCT + (size_t)pi * 4096 + row * 64 + 8 * seg) = *(const LAS v4u*)(L + RC_PCS + (row * LDT + 8 * seg) * 2);
            *(f32x4*)(R.YLT + (size_t)pi * 4096 + row * 64 + 8 * seg) = *(const LAS f32x4*)(NF + row * 68 + 8 * seg);
            *(f32x4*)(R.YLT + (size_t)pi * 4096 + row * 64 + 8 * seg + 4) = *(const LAS f32x4*)(NF + row * 68 + 8 * seg + 4);
            if (tid < 64) R.GCV[pi * 64 + tid] = GC[tid];
        }
        __syncthreads();
    }
}
__device__ __forceinline__ void rwkv_r2(Frame& F, const RwkvC& R, int head) {
    const int lane = F.lane, wave = F.wave, fr = lane & 15, fq = lane >> 4, rb = wave >> 1, cb0 = 2 * (wave & 1);
    LAS bf16* Sb = (LAS bf16*)(F.lds + RING_OFF);
    f32x4 s0 = {0.f, 0.f, 0.f, 0.f}, s1 = {0.f, 0.f, 0.f, 0.f};
    for (int c = 0; c < 128; ++c) {
        const int pi = head * 128 + c; LAS bf16* sb = Sb + (c & 1) * 64 * LDT; bf16* sg = R.SALL + (size_t)pi * 4096;
        const bf16* pc = R.PCT + (size_t)pi * 4096; const float* sl = R.SL + (size_t)pi * 4096; const float* gcv = R.GCV + pi * 64;
        bf16x8 b0[2], b1[2];
#pragma unroll
        for (int ks = 0; ks < 2; ++ks) { b0[ks] = *(const bf16x8*)(pc + (size_t)(16 * cb0 + fr) * 64 + ks * 32 + fq * 8); b1[ks] = *(const bf16x8*)(pc + (size_t)(16 * (cb0 + 1) + fr) * 64 + ks * 32 + fq * 8); }
        float l0[4], l1[4]; const float g0 = gcv[16 * cb0 + fr], g1 = gcv[16 * (cb0 + 1) + fr];
#pragma unroll
        for (int e = 0; e < 4; ++e) { const int d = 16 * rb + 4 * fq + e; l0[e] = sl[d * 64 + 16 * cb0 + fr]; l1[e] = sl[d * 64 + 16 * (cb0 + 1) + fr]; }
#pragma unroll
        for (int e = 0; e < 4; ++e) { const int d = 16 * rb + 4 * fq + e; const bf16 h0 = (bf16)f2bf(s0[e]), h1 = (bf16)f2bf(s1[e]);
            sb[d * LDT + 16 * cb0 + fr] = h0; sb[d * LDT + 16 * (cb0 + 1) + fr] = h1; sg[d * 64 + 16 * cb0 + fr] = h0; sg[d * 64 + 16 * (cb0 + 1) + fr] = h1; }
        __syncthreads();
        f32x4 p0 = {0.f, 0.f, 0.f, 0.f}, p1 = {0.f, 0.f, 0.f, 0.f};
#pragma unroll
        for (int ks = 0; ks < 2; ++ks) { const bf16x8 a = *(const LAS bf16x8*)(sb + (16 * rb + fr) * LDT + ks * 32 + fq * 8);
            p0 = __builtin_amdgcn_mfma_f32_16x16x32_bf16(a, b0[ks], p0, 0, 0, 0); p1 = __builtin_amdgcn_mfma_f32_16x16x32_bf16(a, b1[ks], p1, 0, 0, 0); }
#pragma unroll
        for (int e = 0; e < 4; ++e) { s0[e] = s0[e] * g0 - p0[e] + l0[e]; s1[e] = s1[e] * g1 - p1[e] + l1[e]; }
    }
    __syncthreads();
}
__device__ __forceinline__ void rwkv_r3(Frame& F, const RwkvC& R, const float* RBON, const bf16* RG, const float* gnw, const float* gnb, bf16* YB) {
    const int tid = F.tid, lane = F.lane, wave = F.wave, fr = lane & 15, fq = lane >> 4, rb = wave >> 1, cb0 = 2 * (wave & 1), row = tid >> 3, seg = tid & 7;
    LAS float* Of = (LAS float*)(F.lds + RING_OFF);
    for (int pi = F.vcu; pi < NH * 128; pi += F.G) {
        const int h = pi >> 7, c = pi & 127; const bf16* rq = R.RQT + (size_t)pi * 4096; const bf16* sa = R.SALL + (size_t)pi * 4096; const float* yl = R.YLT + (size_t)pi * 4096;
        f32x4 y0 = {0.f, 0.f, 0.f, 0.f}, y1 = {0.f, 0.f, 0.f, 0.f};
#pragma unroll
        for (int ks = 0; ks < 2; ++ks) { const bf16x8 a = *(const bf16x8*)(rq + (size_t)(16 * rb + fr) * 64 + ks * 32 + fq * 8);
            const bf16x8 b0 = *(const bf16x8*)(sa + (size_t)(16 * cb0 + fr) * 64 + ks * 32 + fq * 8), b1 = *(const bf16x8*)(sa + (size_t)(16 * (cb0 + 1) + fr) * 64 + ks * 32 + fq * 8);
            y0 = __builtin_amdgcn_mfma_f32_16x16x32_bf16(a, b0, y0, 0, 0, 0); y1 = __builtin_amdgcn_mfma_f32_16x16x32_bf16(a, b1, y1, 0, 0, 0); }
#pragma unroll
        for (int e = 0; e < 4; ++e) { const int i = 16 * rb + 4 * fq + e; Of[i * 68 + 16 * cb0 + fr] = y0[e] + yl[i * 64 + 16 * cb0 + fr]; Of[i * 68 + 16 * (cb0 + 1) + fr] = y1[e] + yl[i * 64 + 16 * (cb0 + 1) + fr]; }
        __syncthreads();
        {   const int t = 64 * c + row, c0 = h * 64 + 8 * seg;
            const f32x4 ya = *(const LAS f32x4*)(Of + row * 68 + 8 * seg), yb = *(const LAS f32x4*)(Of + row * 68 + 8 * seg + 4);
            float y[8] = {ya[0], ya[1], ya[2], ya[3], yb[0], yb[1], yb[2], yb[3]};
            float s = 0.f;
#pragma unroll
            for (int i = 0; i < 8; ++i) s += y[i];
            s += shx<1>(s); s += shx<2>(s); s += shx<4>(s);
            const float mu = s * (1.f / 64.f); float q = 0.f;
#pragma unroll
            for (int i = 0; i < 8; ++i) { y[i] -= mu; q += y[i] * y[i]; }
            q += shx<1>(q); q += shx<2>(q); q += shx<4>(q);
            const float rs = __builtin_amdgcn_rsqf(q * (1.f / 64.f) + 64e-5f);
            float v[8]; unpack8(*(const v4u*)((const unsigned char*)(R.RW + ((size_t)h * SEQ + t) * RREC) + 512 + 16 * seg), v);
            const float bon = RBON[t * 8 + h];
            float g[8]; unpack8(*(const v4u*)(RG + (size_t)t * MW + c0), g);
            float o[8];
#pragma unroll
            for (int i = 0; i < 8; ++i) o[i] = (y[i] * rs * gnw[c0 + i] + gnb[c0 + i] + bon * v[i]) * g[i];
            *(v4u*)(YB + (size_t)t * MW + c0) = pack8(o);
        }
        __syncthreads();
    }
}
struct ChunkG {
    const bf16 *Qr, *Kr, *Qm, *Km, *Z; const float *gr, *gm; bf16 *Yr, *Ym;
    const float *MBC, *MA, *MAX, *MBL; float *MCG, *KV, *NVC, *NB; bf16* SB;
};
__device__ __forceinline__ void mc_scan(Frame& F, const ChunkG& G, LAS float* MC, bool write_global) {
    const int h = F.wave, lane = F.lane;
    const float b0 = G.MBL[h * 128 + 2 * lane], b1 = G.MBL[h * 128 + 2 * lane + 1], d0 = G.MAX[h * 128 + 2 * lane] + b0, d1 = G.MAX[h * 128 + 2 * lane + 1] + b1;
    float B = b0 + b1, D = fmaxf(d0 + b1, d1);
#pragma unroll
    for (int o = 1; o < 64; o <<= 1) { const float pb = bperm((lane - o) & 63, B), pd = bperm((lane - o) & 63, D); if (lane >= o) { D = fmaxf(pd + B, D); B = pb + B; } }
    const float m_after = fmaxf(B, D);
    const float up = bperm((lane - 1) & 63, m_after); const float m_even = (lane == 0) ? 0.f : up, m_odd = fmaxf(m_even + b0, d0);
    MC[h * 128 + 2 * lane] = m_even; MC[h * 128 + 2 * lane + 1] = m_odd;
    if (write_global) { G.MCG[h * 128 + 2 * lane] = m_even; G.MCG[h * 128 + 2 * lane + 1] = m_odd; }
}
__device__ __forceinline__ void chunk_x1(Frame& F, const ChunkG& G) {
    const int tid = F.tid, lane = F.lane, wave = F.wave, row = tid >> 3, seg = tid & 7, rb = wave >> 1, cb0 = 2 * (wave & 1), fr = lane & 15, fq = lane >> 4;
    LAS unsigned char* L = F.lds + RING_OFF;
    LAS bf16* VT = (LAS bf16*)(L + CK_VT); LAS bf16* KT = (LAS bf16*)(L + CK_KT); LAS float* WJ = (LAS float*)(L + CK_G); LAS float* MC = (LAS float*)(L + CK_OF);
    mc_scan(F, G, MC, F.vcu == 0);
    __syncthreads();
    for (int p2 = F.vcu; p2 < 2 * NH * 128; p2 += F.G) {
        const int br = p2 >> 10, pi = p2 & 1023, h = pi >> 7, c = pi & 127; const size_t t = (size_t)64 * c + row, gofs = (size_t)h * 64 + 8 * seg;
        const v4u k8 = *(const v4u*)((br ? G.Km : G.Kr) + t * MW + gofs), v8 = *(const v4u*)(G.Z + t * ZW + (br ? ZC_MV : ZC_TV) + gofs);
        if (tid < 64) { float w;
            if (br == 0) w = exp2f((float)(63 - tid) * log2f(1.f - exp2f(-5.f - (float)h)));
            else w = __expf(G.MA[(size_t)h * SEQ + 64 * c + tid] - fmaxf(MC[h * 128 + c], G.MAX[h * 128 + c]));
            WJ[tid] = w; }
        const unsigned kw[4] = {k8.x, k8.y, k8.z, k8.w}, vw[4] = {v8.x, v8.y, v8.z, v8.w};
#pragma unroll
        for (int i = 0; i < 4; ++i) { const int c_ = ((((row >> 3) ^ seg) & 7) << 3) + (row & 7), r0 = (8 * seg + 2 * i) * LDT + c_, r1 = r0 + LDT;
            KT[r0] = (bf16)(kw[i] & 0xffffu); KT[r1] = (bf16)(kw[i] >> 16); VT[r0] = (bf16)(vw[i] & 0xffffu); VT[r1] = (bf16)(vw[i] >> 16); }
        asm volatile("s_waitcnt lgkmcnt(0)\n\ts_barrier" ::: "memory");
        f32x4 st0 = {0.f, 0.f, 0.f, 0.f}, st1 = {0.f, 0.f, 0.f, 0.f};
#pragma unroll
        for (int ks = 0; ks < 2; ++ks) { float a8[8]; unpack8(*(const LAS v4u*)(VT + swz(16 * rb + fr, ks * 4 + fq)), a8);
            const f32x4 w0 = *(const LAS f32x4*)(WJ + ks * 32 + fq * 8), w1 = *(const LAS f32x4*)(WJ + ks * 32 + fq * 8 + 4);
            a8[0] *= w0[0]; a8[1] *= w0[1]; a8[2] *= w0[2]; a8[3] *= w0[3]; a8[4] *= w1[0]; a8[5] *= w1[1]; a8[6] *= w1[2]; a8[7] *= w1[3];
            const bf16x8 a = __builtin_bit_cast(bf16x8, pack8(a8));
            const bf16x8 b0 = *(const LAS bf16x8*)(KT + swz(16 * cb0 + fr, ks * 4 + fq)), b1 = *(const LAS bf16x8*)(KT + swz(16 * (cb0 + 1) + fr, ks * 4 + fq));
            st0 = __builtin_amdgcn_mfma_f32_16x16x32_bf16(a, b0, st0, 0, 0, 0); st1 = __builtin_amdgcn_mfma_f32_16x16x32_bf16(a, b1, st1, 0, 0, 0); }
        float* kv = G.KV + (size_t)p2 * 4096;
#pragma unroll
        for (int e = 0; e < 4; ++e) { const int v = 16 * rb + 4 * fq + e; kv[v * 64 + 16 * cb0 + fr] = st0[e]; kv[v * 64 + 16 * (cb0 + 1) + fr] = st1[e]; }
        if (br == 1) { float k8f[8]; unpack8(*(const LAS v4u*)(KT + swz(row, seg)), k8f); float ns = 0.f;
#pragma unroll
            for (int i = 0; i < 8; ++i) ns += k8f[i] * WJ[8 * seg + i];
            ns += shx<1>(ns); ns += shx<2>(ns); ns += shx<4>(ns);
            if (seg == 0) G.NVC[pi * 64 + row] = ns; }
        asm volatile("s_waitcnt lgkmcnt(0)\n\ts_barrier" ::: "memory");
    }
}
__device__ __forceinline__ void chunk_x2(Frame& F, const ChunkG& G, int br, int h) {
    const int tid = F.tid; LAS float* DEC = (LAS float*)(F.lds + RING_OFF);
    if (tid < 128) DEC[tid] = br ? __expf(G.MCG[h * 128 + tid] - fmaxf(G.MCG[h * 128 + tid], G.MAX[h * 128 + tid])) : exp2f(64.f * log2f(1.f - exp2f(-5.f - (float)h)));
    __syncthreads();
    float S[8] = {0.f, 0.f, 0.f, 0.f, 0.f, 0.f, 0.f, 0.f}; float N = 0.f;
    const size_t base = ((size_t)br * 1024 + h * 128) * 4096 + 8 * tid;
#pragma unroll 4
    for (int c = 0; c < 128; ++c) {
        const float* kv = G.KV + base + (size_t)c * 4096; const f32x4 a = *(const f32x4*)kv, b = *(const f32x4*)(kv + 4); const float dec = DEC[c];
        *(v4u*)(G.SB + base + (size_t)c * 4096) = pack8(S);
        S[0] = dec * S[0] + a[0]; S[1] = dec * S[1] + a[1]; S[2] = dec * S[2] + a[2]; S[3] = dec * S[3] + a[3]; S[4] = dec * S[4] + b[0]; S[5] = dec * S[5] + b[1]; S[6] = dec * S[6] + b[2]; S[7] = dec * S[7] + b[3];
        if (br == 1 && tid < 64) { const int pi = h * 128 + c; G.NB[pi * 64 + tid] = N; N = dec * N + G.NVC[pi * 64 + tid]; }
    }
    __syncthreads();
}
__device__ __forceinline__ void chunk_x3(Frame& F, const ChunkG& G) {
    const int tid = F.tid, lane = F.lane, wave = F.wave, row = tid >> 3, seg = tid & 7, rb = wave >> 1, cb0 = 2 * (wave & 1), fr = lane & 15, fq = lane >> 4;
    LAS unsigned char* L = F.lds + RING_OFF;
    LAS bf16* Qs = (LAS bf16*)(L + CK_Q); LAS bf16* Ks = (LAS bf16*)(L + CK_K); LAS bf16* VT = (LAS bf16*)(L + CK_VT);
    LAS bf16* Ss = (LAS bf16*)(L + CK_S); LAS bf16* STb = (LAS bf16*)(L + CK_STB); LAS float* Of = (LAS float*)(L + CK_OF); LAS float* Gt = (LAS float*)(L + CK_G); LAS float* NV = (LAS float*)(L + CK_NV);
    const f32x4 z4 = {0.f, 0.f, 0.f, 0.f};
    v4u q8n, k8n, v8n, s8n, g8n; float an = 0.f, bcn = 0.f, mpn = 0.f, nbn = 0.f;
#define X3_LOAD(P2) do { const int br_ = (P2) >> 10, pi_ = (P2) & 1023, h_ = pi_ >> 7, c_ = pi_ & 127; const size_t t_ = (size_t)64 * c_ + row, go_ = (size_t)h_ * 64 + 8 * seg; \
        q8n = *(const v4u*)((br_ ? G.Qm : G.Qr) + t_ * MW + go_); k8n = *(const v4u*)((br_ ? G.Km : G.Kr) + t_ * MW + go_); v8n = *(const v4u*)(G.Z + t_ * ZW + (br_ ? ZC_MV : ZC_TV) + go_); \
        s8n = *(const v4u*)(G.SB + (size_t)(P2) * 4096 + row * 64 + 8 * seg); g8n = *(const v4u*)(G.Z + t_ * ZW + (br_ ? ZC_MO : ZC_TG) + go_); \
        if (br_ == 1 && wave == 0) { an = G.MA[(size_t)h_ * SEQ + 64 * c_ + lane]; bcn = G.MBC[(size_t)h_ * SEQ + 64 * c_ + lane]; mpn = G.MCG[h_ * 128 + c_]; } \
        if (br_ == 1 && wave == 1) nbn = G.NB[pi_ * 64 + lane]; } while (0)
    if (F.vcu < 2 * NH * 128) X3_LOAD(F.vcu);
    for (int p2 = F.vcu; p2 < 2 * NH * 128; p2 += F.G) {
        const int br = p2 >> 10, pi = p2 & 1023, h = pi >> 7, c = pi & 127; const size_t t = (size_t)64 * c + row, gofs = (size_t)h * 64 + 8 * seg;
        const float log2g = log2f(1.f - exp2f(-5.f - (float)h));
        {
            const v4u q8 = q8n, k8 = k8n, v8 = v8n, s8 = s8n;
            *(LAS v4u*)(Qs + row * LDT + 8 * seg) = q8; *(LAS v4u*)(Ks + row * LDT + 8 * seg) = k8; *(LAS v4u*)(STb + row * LDT + 8 * seg) = s8;
            const unsigned vw[4] = {v8.x, v8.y, v8.z, v8.w};
#pragma unroll
            for (int i = 0; i < 4; ++i) { const int c_ = ((((row >> 3) ^ seg) & 7) << 3) + (row & 7), r0 = (8 * seg + 2 * i) * LDT + c_; VT[r0] = (bf16)(vw[i] & 0xffffu); VT[r0 + LDT] = (bf16)(vw[i] >> 16); }
            if (br == 1 && wave == 0) { const float a = an, bc = bcn, mp = mpn;
                const float Mi = fmaxf(mp, wave_incl_max(a, lane)); Gt[lane] = a; Gt[64 + lane] = Mi; Gt[128 + lane] = bc; if (lane == 0) Gt[257] = mp; }
            if (br == 1 && wave == 1) NV[lane] = nbn;
        }
        const v4u gcur = g8n;
        if (p2 + F.G < 2 * NH * 128) X3_LOAD(p2 + F.G);
        asm volatile("s_waitcnt lgkmcnt(0)\n\ts_barrier" ::: "memory");
        const float mp = br ? Gt[257] : 0.f;
        f32x4 o0, o1;
        {
#pragma unroll
            for (int ct = 0; ct < 2; ++ct) { const int cb = cb0 + ct; f32x4 sc = mma64(z4, Qs + 16 * rb * LDT, Ks + 16 * cb * LDT, fr, fq);
                const int j = 16 * cb + fr; const float aj = br ? Gt[j] : 0.f;
#pragma unroll
                for (int e = 0; e < 4; ++e) { const int i = 16 * rb + 4 * fq + e; float d;
                    if (br == 0) d = exp2f((float)(i > j ? i - j : j - i) * log2g); else d = (j <= i) ? __expf(aj - Gt[64 + i]) : 0.f;
                    Ss[i * LDT + j] = (bf16)f2bf(sc[e] * d); } }
            o0 = mma64(z4, Qs + 16 * rb * LDT, STb + 16 * cb0 * LDT, fr, fq); o1 = mma64(z4, Qs + 16 * rb * LDT, STb + 16 * (cb0 + 1) * LDT, fr, fq);
#pragma unroll
            for (int e = 0; e < 4; ++e) { const int i = 16 * rb + 4 * fq + e; const float sc = (br == 0) ? exp2f((float)(i + 1) * log2g) : __expf(mp - Gt[64 + i]); o0[e] *= sc; o1[e] *= sc; }
        }
        asm volatile("s_waitcnt lgkmcnt(0)\n\ts_barrier" ::: "memory");
        o0 = mma64s<false, true>(o0, Ss, 16 * rb, VT, 16 * cb0, fr, fq); o1 = mma64s<false, true>(o1, Ss, 16 * rb, VT, 16 * (cb0 + 1), fr, fq);
#pragma unroll
        for (int e = 0; e < 4; ++e) { const int r_ = 16 * rb + 4 * fq + e; Of[r_ * 68 + 16 * cb0 + fr] = o0[e]; Of[r_ * 68 + 16 * (cb0 + 1) + fr] = o1[e]; }
        asm volatile("s_waitcnt lgkmcnt(0)\n\ts_barrier" ::: "memory");
        {
            float o[8]; { const f32x4 a = *(const LAS f32x4*)(Of + row * 68 + 8 * seg), b = *(const LAS f32x4*)(Of + row * 68 + 8 * seg + 4); o[0] = a[0]; o[1] = a[1]; o[2] = a[2]; o[3] = a[3]; o[4] = b[0]; o[5] = b[1]; o[6] = b[2]; o[7] = b[3]; }
            float gz[8]; unpack8(gcur, gz);
            if (br == 1) {
                float s8f[8], q8f[8]; unpack8(*(const LAS v4u*)(Ss + row * LDT + 8 * seg), s8f); unpack8(*(const LAS v4u*)(Qs + row * LDT + 8 * seg), q8f);
                float ds = 0.f, nq = 0.f;
#pragma unroll
                for (int i = 0; i < 8; ++i) { ds += s8f[i]; nq += NV[8 * seg + i] * q8f[i]; }
                ds += shx<1>(ds); nq += shx<1>(nq); ds += shx<2>(ds); nq += shx<2>(nq); ds += shx<4>(ds); nq += shx<4>(nq);
                const float Mi = Gt[64 + row], den = ds + __expf(mp - Mi) * nq, dn = fmaxf(fabsf(den), __expf(-(Gt[128 + row] + Mi))), inv = __builtin_amdgcn_rcpf(dn);
#pragma unroll
                for (int i = 0; i < 8; ++i) o[i] = o[i] * inv * sigmoidf_(gz[i]);
            }
            float ss = 0.f;
#pragma unroll
            for (int i = 0; i < 8; ++i) ss += o[i] * o[i];
            ss += shx<1>(ss); ss += shx<2>(ss); ss += shx<4>(ss);
            const float rs = __builtin_amdgcn_rsqf(ss * (1.f / 64.f) + 1e-6f); const float* gn = (br ? G.gm : G.gr) + gofs;
#pragma unroll
            for (int i = 0; i < 8; ++i) { o[i] = o[i] * rs * gn[i]; if (br == 0) o[i] *= siluf_(gz[i]); }
            *(v4u*)((br ? G.Ym : G.Yr) + t * MW + gofs) = pack8(o);
        }
        asm volatile("s_waitcnt lgkmcnt(0)\n\ts_barrier" ::: "memory");
    }
#undef X3_LOAD
}
#if DBG
__device__ __forceinline__ unsigned dh(unsigned x) { x ^= x >> 16; x *= 0x7feb352du; x ^= x >> 15; x *= 0x846ca68bu; x ^= x >> 16; return x; }
__device__ __forceinline__ float b2f(bf16 v) { return __builtin_bit_cast(float, (unsigned)v << 16); }
__device__ __forceinline__ float rbf(float f) { return __builtin_bit_cast(float, f2bf(f) << 16); }
__device__ __forceinline__ void dflag(unsigned* flags, int idx, float err, float tol) { if (!(err <= tol)) { atomicOr(&flags[idx], 1u); atomicMax(&flags[32 + idx], __float_as_uint(fminf(fabsf(err), 1e30f))); } }
__device__ __forceinline__ float ddot(const bf16* a, const bf16* b, int K) { float s = 0.f; for (int k = 0; k < K; ++k) s += b2f(a[k]) * b2f(b[k]); return s; }
__global__ void k_check(Args args, int which, int l) {
    const int sid = blockIdx.x * blockDim.x + threadIdx.x; unsigned char* ws = args.ws; unsigned* flags = (unsigned*)(ws + WS_CTL) + 2048;
    const unsigned h1 = dh(sid * 2654435761u + which * 97u), h2 = dh(h1 + 12345u);
    const int row = h1 % SEQ; unsigned char* wl = ws + WS_W + (size_t)l * WL_BYTES;
    const bf16* XN = (const bf16*)(ws + WS_XN); const bf16* Z = (const bf16*)(ws + WS_Z); const bf16* HID = (const bf16*)(ws + WS_HID); const bf16* GATES = (const bf16*)(ws + WS_GATES);
    const float* SNAP = (const float*)(ws + WS_END);
    if (which == 1) {
        const int n = h1 % (2 * DFF), k = h2 % DM, tile = n >> 8, within = n & 255; const float* w = args.in[within < 128 ? I_F1W1 : I_F1W3] + (size_t)l * DM * DFF;
        const float ref = rbf(w[(size_t)k * DFF + tile * 128 + (within & 127)]); const float got = b2f(((const bf16*)(wl + WL_W13A))[(size_t)n * DM + k]);
        dflag(flags, which, fabsf(ref - got), 0.f);
        const int n2 = h1 % ZW; const int sc = win_src(n2); const float r2 = sc >= 0 ? rbf((args.in[I_WIN] + (size_t)l * DM * 7960)[(size_t)k * 7960 + sc]) : 0.f; dflag(flags, which, fabsf(r2 - b2f(((const bf16*)(wl + WL_WIN))[(size_t)n2 * DM + k])), 0.f);
        const int k2 = h2 % DFF, n3 = h1 % DM; dflag(flags, which, fabsf(rbf((args.in[I_F1W2] + (size_t)l * DFF * DM)[(size_t)k2 * DM + n3]) - b2f(((const bf16*)(wl + WL_W2A))[(size_t)n3 * DFF + k2])), 0.f);
        const int nb = h2 % 4, kb = h1 % MW; dflag(flags, which, fabsf(rbf((args.in[I_WB] + ((size_t)l * 4 + nb) * MW * DM)[(size_t)kb * DM + n3]) - b2f(((const bf16*)(wl + WL_WB))[((size_t)nb * DM + n3) * MW + kb])), 0.f);
        dflag(flags, which, fabsf(rbf((args.in[I_WO] + (size_t)l * DM * DM)[(size_t)k * DM + n3]) - b2f(((const bf16*)(wl + WL_WO))[(size_t)n3 * DM + k])), 0.f);
        const int n4 = h1 % (4 * DM); dflag(flags, which, fabsf(rbf((args.in[I_WG] + (size_t)l * DM * 4 * DM)[(size_t)k * 4 * DM + n4]) - b2f(((const bf16*)(wl + WL_WG))[(size_t)n4 * DM + k])), 0.f);
    }
    if (which == 2 || which == 5) {
        const float* x = (which == 2) ? args.in[I_X] : args.out; const float* g = args.in[which == 2 ? I_F1N : I_MIXN] + (size_t)l * DM;
        float ss = 0.f; for (int k = 0; k < DM; ++k) { const float v = x[(size_t)row * DM + k]; ss += v * v; }
        const float rs = 1.f / sqrtf(ss / DM + 1e-6f); const int c = h2 % DM; const float ref = x[(size_t)row * DM + c] * rs * g[c];
        dflag(flags, which, fabsf(ref - b2f(XN[(size_t)row * DM + c])), 0.02f * fabsf(ref) + 0.01f);
    }
    if (which == 3) {
        const int c = h2 % DFF, tile = c >> 7, w_ = c & 127; const bf16* B = (const bf16*)(wl + WL_W13A);
        const float a = ddot(XN + (size_t)row * DM, B + (size_t)(tile * 256 + w_) * DM, DM), b = ddot(XN + (size_t)row * DM, B + (size_t)(tile * 256 + 128 + w_) * DM, DM);
        const float ref = a / (1.f + expf(-a)) * b; dflag(flags, which, fabsf(ref - b2f(HID[(size_t)row * DFF + c])), 0.02f * fabsf(ref) + 0.02f);
    }
    if (which == 4) {
        const int c = h2 % DM; const float ref = args.in[I_X][(size_t)row * DM + c] + 0.5f * ddot(HID + (size_t)row * DFF, (const bf16*)(wl + WL_W2A) + (size_t)c * DFF, DFF);
        dflag(flags, which, fabsf(ref - args.out[(size_t)row * DM + c]), 0.01f * fabsf(ref) + 0.01f);
    }
    if (which == 6) {
        const int c = (sid & 1) ? (7936 + h2 % 24) : (h2 % ZW); const float ref = ddot(XN + (size_t)row * DM, (const bf16*)(wl + WL_WIN) + (size_t)c * DM, DM);
        dflag(flags, which, fabsf(ref - b2f(Z[(size_t)row * ZW + c])), 0.02f * fabsf(ref) + 0.02f);
    }
    if (which == 7) {
        const int c = h2 % (4 * DM); const float a = ddot(XN + (size_t)row * DM, (const bf16*)(wl + WL_WG) + (size_t)c * DM, DM) + (args.in[I_WGB] + (size_t)l * 4 * DM)[c];
#if DBG_RAWGATE
        const float ref = a - ((DBG_RAWGATE == 2) ? 0.f : (args.in[I_WGB] + (size_t)l * 4 * DM)[c]); dflag(flags, which, fabsf(ref - b2f(GATES[(size_t)row * 4 * DM + c])), 0.02f * fabsf(ref) + 0.02f);
#else
        const float ref = 1.f / (1.f + expf(-a)); dflag(flags, which, fabsf(ref - b2f(GATES[(size_t)row * 4 * DM + c])), 0.02f);
#endif
    }
    if (which == 8) {
        const int c = h2 % DM; float ref = 0.f;
        const bf16* Y[4] = {(const bf16*)(ws + WS_YF), (const bf16*)(ws + WS_YB), (const bf16*)(ws + WS_YR), (const bf16*)(ws + WS_YM)};
        for (int n = 0; n < 4; ++n) ref += b2f(GATES[(size_t)row * 4 * DM + n * DM + c]) * ddot(Y[n] + (size_t)row * MW, (const bf16*)(wl + WL_WB) + ((size_t)n * DM + c) * MW, MW);
        dflag(flags, which, fabsf(ref - b2f(((const bf16*)(ws + WS_MRGB))[(size_t)row * DM + c])), 0.02f * fabsf(ref) + 0.03f);
    }
    if (which == 9) {
        const int c = h2 % DM; const float ref = SNAP[(size_t)row * DM + c] + ddot((const bf16*)(ws + WS_MRGB) + (size_t)row * DM, (const bf16*)(wl + WL_WO) + (size_t)c * DM, DM);
        dflag(flags, which, fabsf(ref - args.out[(size_t)row * DM + c]), 0.01f * fabsf(ref) + 0.01f);
    }
}
__global__ void k_report(Args args) {
    const size_t i = (size_t)blockIdx.x * blockDim.x + threadIdx.x; const unsigned* flags = (const unsigned*)(args.ws + WS_CTL) + 2048;
    if (i < (size_t)SEQ * DM) { float v = args.in[I_X][i];
        if (i == 0) { int first = 0; for (int k = 31; k >= 1; --k) if (flags[k]) first = k; float me = __uint_as_float(flags[32 + first]); int d = (int)(me * 10.f); d = d > 9 ? 9 : (d < 0 ? 0 : d); v += 1000.f * first + (first ? 100.f * d : 0.f); }
        args.out[i] = v; }
}
#endif
__device__ __forceinline__ void post_phase(Frame& F, const float* YRAW, const float* RW, const float* RBON, const bf16* RG, const float* gnw, const float* gnb, bf16* YB) {
    const int gw = F.vcu * NWAVES + F.wave, NGW = F.G * NWAVES, lane = F.lane, hh = lane >> 3, c0 = 8 * lane;
    float gw8[8], gb8[8];
#pragma unroll
    for (int i = 0; i < 8; ++i) { gw8[i] = gnw[c0 + i]; gb8[i] = gnb[c0 + i]; }
    for (int t = gw; t < SEQ; t += NGW) {
        const f32x4 ya = *(const f32x4*)(YRAW + (size_t)t * MW + c0), yb = *(const f32x4*)(YRAW + (size_t)t * MW + c0 + 4);
        float y[8] = {ya[0], ya[1], ya[2], ya[3], yb[0], yb[1], yb[2], yb[3]};
        float s = 0.f;
#pragma unroll
        for (int i = 0; i < 8; ++i) s += y[i];
        s += shx<1>(s); s += shx<2>(s); s += shx<4>(s);
        const float mu = s * (1.f / 64.f); float q = 0.f;
#pragma unroll
        for (int i = 0; i < 8; ++i) { y[i] -= mu; q += y[i] * y[i]; }
        q += shx<1>(q); q += shx<2>(q); q += shx<4>(q);
        const float rs = 1.f / sqrtf(q * (1.f / 64.f) + 64e-5f);
        const float* rec = RW + ((size_t)hh * SEQ + t) * RREC + 320 + 8 * (lane & 7);
        const f32x4 va = *(const f32x4*)rec, vb = *(const f32x4*)(rec + 4); const float v[8] = {va[0], va[1], va[2], va[3], vb[0], vb[1], vb[2], vb[3]};
        const float bon = RBON[t * 8 + hh];
        float g[8]; unpack8(*(const v4u*)(RG + (size_t)t * MW + c0), g);
        float o[8];
#pragma unroll
        for (int i = 0; i < 8; ++i) o[i] = (y[i] * rs * gw8[i] + gb8[i] + bon * v[i]) * g[i];
        *(v4u*)(YB + (size_t)t * MW + c0) = pack8(o);
    }
}


#ifndef MIX_PRE_R2
#define MIX_PRE_R2 2300
#endif
#ifndef MIX_PRE_CHUNK
#define MIX_PRE_CHUNK 300
#endif
#ifndef MIX_ATT_STEP
#define MIX_ATT_STEP 54
#endif
#ifndef MIX_GATE_UNIT
#define MIX_GATE_UNIT 500
#endif
constexpr int kFoxTiles[8] = {999, 999, 999, 999, 999, 999, 999, 999};
constexpr int att_cost(int r) { const int h = r & 7, qb = 31 - (r >> 3); int tiles = 4 * (qb + 1); const int cap = kFoxTiles[h] + 4; if (tiles > cap) tiles = cap; return MIX_ATT_STEP * tiles / 4; }
constexpr int mix_pre(int j) {
    if (j < 8) return MIX_PRE_R2; if (j < 24) return MIX_PRE_CHUNK;
    const int a = j - 24; int pre = att_cost(a); if (a >= 208) pre += att_cost(463 - a); return pre;
}
constexpr int mix_cnt(int j, int T) { const int x = T - mix_pre(j) + MIX_GATE_UNIT / 2; return x <= 0 ? 0 : x / MIX_GATE_UNIT; }
struct GAssign { short first[257]; };
constexpr GAssign make_gassign() {
    GAssign g{}; int lo = 0, hi = 40000;
    while (lo < hi) { const int mid = (lo + hi + 1) / 2; int s = 0; for (int j = 0; j < 256; ++j) s += mix_cnt(j, mid); if (s <= 1024) lo = mid; else hi = mid - 1; }
    int cnt[256] = {}; int s = 0; for (int j = 0; j < 256; ++j) { cnt[j] = mix_cnt(j, lo); s += cnt[j]; }
    for (int j = 255; s < 1024; j = (j == 24) ? 255 : j - 1) { cnt[j] += 1; s += 1; }
    int acc = 0; for (int j = 0; j < 256; ++j) { g.first[j] = (short)acc; acc += cnt[j]; } g.first[256] = (short)acc;
    return g;
}
__device__ const GAssign kGAssign = make_gassign();
static_assert(make_gassign().first[256] == 1024, "gate units");
#ifndef PHMASK
#define PHMASK 1023
#endif
#ifndef YMASK
#define YMASK 0
#endif
#ifndef GATES_IN_ZG
#define GATES_IN_ZG 0
#endif
enum { K_PRO = 0, K_NORM, K_UP, K_DOWN, K_ZG, K_PREP, K_MIX, K_POST, K_MERGE, K_OUTP, K_R1, K_NKIND };
__host__ __device__ __forceinline__ void phase_decode(int p, int& kind, int& l, int& sel) {
    if (p == 0) { kind = K_PRO; l = 0; sel = 0; return; }
    const int q = (p - 1) % PH_PER_LAYER; l = (p - 1) / PH_PER_LAYER;
    switch (q) {
        case 0: kind = K_UP; sel = 0; break; case 1: kind = K_DOWN; sel = 0; break;
        case 2: kind = K_ZG; sel = 0; break; case 3: kind = K_PREP; sel = 0; break; case 4: kind = K_R1; sel = 0; break; case 5: kind = K_MIX; sel = 0; break;
        case 6: kind = K_POST; sel = 0; break; case 7: kind = K_MERGE; sel = 0; break; case 8: kind = K_OUTP; sel = 0; break;
        case 9: kind = K_UP; sel = 1; break; default: kind = K_DOWN; sel = 1; break;
    }
}
static_assert(offsetof(Args, ws) == KARG_WS_OFF, "Args::ws offset");
typedef const __attribute__((address_space(4))) Args* ArgP;
struct ArgsView { ArgP p; __device__ __forceinline__ const float* operator[](int i) const { return p->in[i]; } };
__device__ __forceinline__ void frame_fill(Frame& F, unsigned char* lds, unsigned char* ws) {
    int tid_ = threadIdx.x; asm volatile("; opaque tid" : "+v"(tid_));
    F.lds = (LAS unsigned char*)lds; F.MISC = (volatile LAS unsigned*)(F.lds + MISC_OFF);
    F.tid = tid_; F.lane = F.tid & 63; F.wave = __builtin_amdgcn_readfirstlane(F.tid >> 6);
    int bx = blockIdx.x, G = gridDim.x; asm volatile("; opaque bx" : "+s"(bx), "+s"(G));
    F.G = G; F.vcu = (G % 8 == 0) ? (bx % 8) * (G / 8) + bx / 8 : bx; F.bx = bx;
    F.ws = ws; F.ctl = (gu32*)(ws + WS_CTL);
}
template <int KIND> __device__ __forceinline__ void run_phase(unsigned char* lds_, int l_, int sel_) {
    ArgP pa = (ArgP)__builtin_amdgcn_kernarg_segment_ptr(); asm volatile("; opaque kernarg" : "+s"(pa));
    int l = l_, sel = sel_; asm volatile("; opaque l" : "+s"(l), "+s"(sel));
    struct { ArgsView in; float* out; unsigned char* ws; } args; args.in.p = pa; args.out = pa->out; args.ws = pa->ws;
    Frame F; frame_fill(F, lds_, args.ws);
    unsigned char* ws = args.ws; float* OUT = args.out; const int bx = F.bx;
    bf16* XN = (bf16*)(ws + WS_XN); bf16* Z = (bf16*)(ws + WS_Z); bf16* HID = (bf16*)(ws + WS_HID); bf16* GATES = (bf16*)(ws + WS_GATES);
    unsigned char* wl = ws + WS_W + (size_t)l * WL_BYTES;
    bf16 *FQ = (bf16*)(ws + WS_FQ), *FK = (bf16*)(ws + WS_FK), *YF = (bf16*)(ws + WS_YF), *RQ = (bf16*)(ws + WS_RQ), *RK = (bf16*)(ws + WS_RK), *YR = (bf16*)(ws + WS_YR);
    bf16 *FV = (bf16*)(ws + WS_FV), *FO = (bf16*)(ws + WS_FO), *TV = (bf16*)(ws + WS_TV), *TG = (bf16*)(ws + WS_TG), *MV = (bf16*)(ws + WS_MV), *MO = (bf16*)(ws + WS_MO);
    bf16 *MQ = (bf16*)(ws + WS_MQ), *MK = (bf16*)(ws + WS_MK), *YM = (bf16*)(ws + WS_YM), *YB = (bf16*)(ws + WS_YB), *RG = (bf16*)(ws + WS_RG), *MRGB = (bf16*)(ws + WS_MRGB);
    float *RW = (float*)(ws + WS_RW), *YRAW = (float*)(ws + WS_YRAW), *MRGF = (float*)(ws + WS_MRGF);
    RwkvC RC; RC.RW = RW; RC.RQT = (bf16*)(ws + WS_RQT); RC.PCT = (bf16*)(ws + WS_PCT); RC.YLT = (float*)(ws + WS_YLT); RC.SL = (float*)(ws + WS_SL); RC.GCV = (float*)(ws + WS_GCV); RC.SALL = (bf16*)(ws + WS_SALL);
    ChunkG CG; CG.Qr = RQ; CG.Kr = RK; CG.Qm = MQ; CG.Km = MK; CG.Z = Z; CG.gr = args.in[I_TGN] + l * 512; CG.gm = args.in[I_MGN] + l * 512; CG.Yr = YR; CG.Ym = YM;
    CG.MBC = (float*)(ws + WS_SM + SM_MBC); CG.MA = (float*)(ws + WS_SM + SM_MA); CG.MAX = (float*)(ws + WS_SM + SM_MAX); CG.MBL = (float*)(ws + WS_SM + SM_MBL); CG.MCG = (float*)(ws + WS_SM + SM_MCG);
    CG.KV = (float*)(ws + WS_KV); CG.NVC = (float*)(ws + WS_NVC); CG.NB = (float*)(ws + WS_NB); CG.SB = (bf16*)(ws + WS_SB);
    float *RBON = (float*)(ws + WS_SM + SM_RBON), *FP = (float*)(ws + WS_SM + SM_FP), *FT = (float*)(ws + WS_SM + SM_FT), *MBC = (float*)(ws + WS_SM + SM_MBC), *MA = (float*)(ws + WS_SM + SM_MA);
    float* SSB = (float*)(ws + WS_SSP);
    if constexpr (KIND == K_PRO && ((PHMASK >> K_PRO) & 1)) { p0_prologue(F, args.in); xin_phase(F, args.in[I_X], XN, SSB); }
    if constexpr (KIND == K_UP && ((PHMASK >> K_UP) & 1)) { pg8::Gemm g{XN, (const bf16*)(wl + (sel ? WL_W13B : WL_W13A)), SEQ, 2 * DFF, DM}; pg8::StaticOrder S; S.init(SEQ, 2 * DFF, F.G, bx);
        pg8::EpiSwiglu E{HID, DFF, SSB + (size_t)(3 * l + (sel ? 2 : 0)) * 8 * SEQ}; pg8::gemm_phase<pg8::EpiSwiglu, pg8::StaticOrder, true, true>(F.lds + RING_OFF, g, S, E); }
    if constexpr (KIND == K_DOWN && ((PHMASK >> K_DOWN) & 1)) { const float* xcur = (l == 0 && sel == 0) ? args.in[I_X] : OUT;
        pg8::Gemm g{HID, (const bf16*)(wl + (sel ? WL_W2B : WL_W2A)), SEQ, DM, DFF}; pg8::StaticOrder S; S.init(SEQ, DM, F.G, bx);
        pg8::EpiResid E{(l == DEPTH - 1 && sel == 1) ? OUT : nullptr, 3 * l + (sel ? 3 : 1), 0.5f, 0}; pg8::gemm_phase<pg8::EpiResid, pg8::StaticOrder, true, true>(F.lds + RING_OFF, g, S, E); }
    if constexpr (KIND == K_ZG && ((PHMASK >> K_ZG) & 1)) { pg8::Gemm g{XN, (const bf16*)(wl + WL_WIN), SEQ, ZW, DM}; pg8::StaticOrder S; S.init(SEQ, ZW, F.G, bx);
        pg8::EpiStore<0> E{Z, ZW, nullptr, SSB + (size_t)(3 * l + 1) * 8 * SEQ}; pg8::gemm_phase<pg8::EpiStore<0>, pg8::StaticOrder, true, true>(F.lds + RING_OFF, g, S, E);
#if GATES_IN_ZG
        { pg8::Gemm g2{XN, (const bf16*)(wl + WL_WG), SEQ, 4 * DM, DM}; pg8::StaticOrder S2; S2.init(SEQ, 4 * DM, F.G, bx);
          #if DBG_RAWGATE
          pg8::EpiStore<0> E2{GATES, 4 * DM, (DBG_RAWGATE == 2) ? args.in[I_WGB] + (size_t)l * 4 * DM : nullptr, SSB + (size_t)(3 * l + 1) * 8 * SEQ}; pg8::gemm_phase<pg8::EpiStore<0>, pg8::StaticOrder, true, true>(F.lds + RING_OFF, g2, S2, E2); }
#else
          pg8::EpiStore<1> E2{GATES, 4 * DM, args.in[I_WGB] + (size_t)l * 4 * DM, SSB + (size_t)(3 * l + 1) * 8 * SEQ}; pg8::gemm_phase<pg8::EpiStore<1>, pg8::StaticOrder, true, true>(F.lds + RING_OFF, g2, S2, E2); }
#endif
#endif
    }
    if constexpr (KIND == K_PREP && ((PHMASK >> K_PREP) & 1)) {
        PrepP P; P.Z = Z; P.pos = (const int*)args.in[I_POS]; P.w2t = (const bf16*)(ws + WS_LORA) + (size_t)l * 131072; P.a2t = P.w2t + 32768; P.g2t = P.w2t + 65536;
        P.fox_fb = args.in[I_FOXFB] + l * 8; P.fox_qg = args.in[I_FOXQG] + l * 64; P.fox_kg = args.in[I_FOXKG] + l * 64; P.mu = args.in[I_RMU] + l * 1792; P.w0 = args.in[I_RW0] + l * 512;
        P.w2 = args.in[I_RW2] + (size_t)l * 64 * 512; P.a0 = args.in[I_RA0] + l * 512; P.a2 = args.in[I_RA2] + (size_t)l * 64 * 512; P.g2 = args.in[I_RG2] + (size_t)l * 128 * 512;
        P.k_k = args.in[I_RKK] + l * 512; P.k_a = args.in[I_RKA] + l * 512; P.r_k = args.in[I_RRK] + l * 512; P.conv_w = args.in[I_MCW] + l * 4096; P.conv_b = args.in[I_MCB] + l * 1024;
        P.mib = args.in[I_MIB] + l * 8; P.mfb = args.in[I_MFB] + l * 8;
        P.FV = FV; P.FO = FO; P.TV = TV; P.TG = TG; P.MV = MV; P.MO = MO; P.FQ = FQ; P.FK = FK; P.RQ = RQ; P.RK = RK; P.MQ = MQ; P.MK = MK; P.RG = RG; P.RW = RW; P.RBON = RBON; P.FP = FP; P.FT = FT; P.MBC = MBC; P.MA = MA; P.MAX = (float*)(ws + WS_SM + SM_MAX); P.MBL = (float*)(ws + WS_SM + SM_MBL);
        prep_phase(F, P, sel ? sel : 7); }
    if constexpr (KIND == K_MIX && ((PHMASK >> K_MIX) & 1)) {
#ifndef MIXSEL
#define MIXSEL 31
#endif
        const int rm = sel ? sel : 31;
        if (bx < 8) { if (rm & 1) rwkv_r2(F, RC, bx); }
        else if (bx < 24) { if (rm & 6) chunk_x2(F, CG, (bx - 8) >> 3, (bx - 8) & 7); }
        else {
            const int a = bx - 24; char* shm = (char*)(LAS char*)(F.lds + RING_OFF);
            const int nun = (a >= 208) ? 2 : 1;
            if (rm & 8) for (int ui = 0; ui < nun; ++ui) { const int r = ui ? 463 - a : a;
                attn_body::attn_unit<8>(0, r & 7, 31 - (r >> 3), (const attn_body::bf16*)FQ, (const attn_body::bf16*)FK, (const attn_body::bf16*)(Z + ZC_FV), (attn_body::bf16*)YF, FP, FT, (const attn_body::bf16*)(Z + ZC_FO), shm); }
        }
        if ((rm & 16) && !GATES_IN_ZG) {
            const int gfirst = kGAssign.first[bx], gcount = kGAssign.first[bx + 1] - gfirst;
            pg8::Gemm g{XN, (const bf16*)(wl + WL_WG), SEQ, 4 * DM, DM}; pg8::RangeOrder S; S.init(SEQ, 4 * DM, gfirst, gcount);
            pg8::EpiGates E{GATES, 4 * DM, args.in[I_WGB] + (size_t)l * 4 * DM, SSB + (size_t)(3 * l + 1) * 8 * SEQ}; pg8::gemm_phase<pg8::EpiGates, pg8::RangeOrder, true, true>(F.lds + RING_OFF, g, S, E);
        } }
    if constexpr (KIND == K_POST && ((PHMASK >> K_POST) & 1)) { rwkv_r3(F, RC, RBON, RG, args.in[I_RGNW] + l * 512, args.in[I_RGNB] + l * 512, YB); chunk_x3(F, CG); }
    if constexpr (KIND == K_R1) { rwkv_r1(F, RC); chunk_x1(F, CG); }
    if constexpr (KIND == K_MERGE && ((PHMASK >> K_MERGE) & 1)) {
        pg8::StaticOrder S0; S0.init(SEQ, DM, F.G, bx); pg8::Unit u0; S0.next(0, u0);
        pg8::MergeOrder S{u0.pm, u0.pn}; pg8::Gemm g{YF, (const bf16*)(wl + WL_WB), 4 * SEQ, 4 * DM, MW};
        pg8::EpiMergeAll E{GATES, 4 * DM, MRGF, MRGB, DM}; pg8::gemm_phase<pg8::EpiMergeAll, pg8::MergeOrder, true, true>(F.lds + RING_OFF, g, S, E); }
    if constexpr (KIND == K_OUTP && ((PHMASK >> K_OUTP) & 1)) { pg8::Gemm g{MRGB, (const bf16*)(wl + WL_WO), SEQ, DM, DM}; pg8::StaticOrder S; S.init(SEQ, DM, F.G, bx);
        pg8::EpiResid E{nullptr, 3 * l + 2, 1.0f, 0}; pg8::gemm_phase<pg8::EpiResid, pg8::StaticOrder, true, true>(F.lds + RING_OFF, g, S, E); }
}
__device__ __forceinline__ void lds_ctl_zero(unsigned char* lds) {
    for (int u = threadIdx.x; u < (LDS_BYTES - LDSCTL_OFF) / 4; u += NWAVES * 64) ((LAS unsigned*)((LAS unsigned char*)lds + LDSCTL_OFF))[u] = 0u;
    __syncthreads();
}
template <int KIND> __global__ void __launch_bounds__(NWAVES * 64, 2) k_phase(Args args) {
    extern __shared__ __attribute__((aligned(16))) unsigned char lds[];
    lds_ctl_zero(lds);
    run_phase<KIND>(lds, args.ph_lo, args.ph_hi);
}
#if !MK_PER_PHASE
__device__ __forceinline__ void grid_bar(unsigned char* lds) {
    ArgP pa = (ArgP)__builtin_amdgcn_kernarg_segment_ptr(); asm volatile("; opaque kernarg (barrier)" : "+s"(pa));
    XcdBarrier b; b.bar = (unsigned*)((gu32*)(pa->ws + WS_CTL) + CW_BAR); b.x = xb_xcc_id(); b.st = (volatile LAS unsigned*)((LAS unsigned char*)lds + MISC_OFF) + 8;
    xcd_barrier(b);
}
#if DBG_STAMP
#define STAMP_PH(kind) do { if (blockIdx.x == STAMP_BLK && threadIdx.x == 0) { gu32* c_ = (gu32*)(args.ws + WS_CTL); const unsigned now_ = (unsigned)__builtin_amdgcn_s_memrealtime(); c_[3000 + (kind)] += now_ - c_[3040]; c_[3040] = now_; } } while (0)
#define STAMP_BAR(kind) do { if (blockIdx.x == STAMP_BLK && threadIdx.x == 0) { gu32* c_ = (gu32*)(args.ws + WS_CTL); const unsigned now_ = (unsigned)__builtin_amdgcn_s_memrealtime(); c_[3016 + (kind)] += now_ - c_[3040]; c_[3040] = now_; } } while (0)
#else
#define STAMP_PH(kind) do { } while (0)
#define STAMP_BAR(kind) do { } while (0)
#endif
struct Pf { unsigned a, b, c; };
template <int KIND> __device__ __forceinline__ Pf prefetch_next(const unsigned char* ws_, int l_, int s_) {
    int l = l_, s = s_; asm volatile("; opaque l (prefetch)" : "+s"(l), "+s"(s));
    const unsigned char* wl = ws_ + WS_W + (size_t)l * WL_BYTES; const unsigned char* p = nullptr; size_t bytes = 0;
    if constexpr (KIND == K_PRO) { p = wl + WL_W13A; bytes = (size_t)2 * DFF * DM * 2; }
    if constexpr (KIND == K_UP) { p = wl + (s ? WL_W2B : WL_W2A); bytes = (size_t)DM * DFF * 2; }
    if constexpr (KIND == K_DOWN) { if (s == 0) { p = wl + WL_WIN; bytes = (size_t)ZW * DM * 2; } else if (l + 1 < DEPTH) { p = wl + WL_BYTES + WL_W13A; bytes = (size_t)2 * DFF * DM * 2; } }
    if constexpr (KIND == K_R1) { p = wl + WL_WG; bytes = (size_t)4 * DM * DM * 2; }
    if constexpr (KIND == K_POST) { p = wl + WL_WB; bytes = (size_t)4 * MW * DM * 2; }
    if constexpr (KIND == K_MERGE) { p = wl + WL_WO; bytes = (size_t)DM * DM * 2; }
    if constexpr (KIND == K_OUTP) { p = wl + WL_W13B; bytes = (size_t)2 * DFF * DM * 2; }
    Pf r{0u, 0u, 0u};
    if constexpr (KIND == K_PRO || KIND == K_UP || KIND == K_DOWN || KIND == K_R1 || KIND == K_POST || KIND == K_MERGE || KIND == K_OUTP) {
        int tid_ = threadIdx.x; asm volatile("; opaque tid (prefetch)" : "+v"(tid_)); int bx_ = blockIdx.x; asm volatile("; opaque bx (prefetch)" : "+s"(bx_));
        const size_t o0 = ((size_t)bx_ * (NWAVES * 64) + tid_) * 128, st = (size_t)256 * (NWAVES * 64) * 128;
        if (o0 < bytes) r.a = *(const volatile unsigned*)(p + o0);
        if (o0 + st < bytes) r.b = *(const volatile unsigned*)(p + o0 + st);
        if (o0 + 2 * st < bytes) r.c = *(const volatile unsigned*)(p + o0 + 2 * st);
    }
    return r;
}
__device__ __forceinline__ void prefetch_sink(const Pf& r, unsigned char* ws_) { if ((r.a ^ r.b ^ r.c) == 0x9e3779b9u) ((gu32*)(ws_ + WS_CTL))[200000] = 1u; }
#define PHASE(K, l, s) do { run_phase<K>(lds, l, s); STAMP_PH(K); const Pf pf_ = prefetch_next<K>(args.ws, l, s); grid_bar(lds); prefetch_sink(pf_, args.ws); STAMP_BAR(K); } while (0)
__global__ void __launch_bounds__(NWAVES * 64, 2) mega_fwd(Args args) {
    extern __shared__ __attribute__((aligned(16))) unsigned char lds[];
    lds_ctl_zero(lds);
    (void)xcd_barrier_post((unsigned*)((gu32*)(args.ws + WS_CTL) + CW_BAR), (volatile LAS unsigned*)((LAS unsigned char*)lds + MISC_OFF) + 8);
#if DBG_STAMP
    if (blockIdx.x == STAMP_BLK && threadIdx.x == 0) ((gu32*)(args.ws + WS_CTL))[3040] = (unsigned)__builtin_amdgcn_s_memrealtime();
#endif
    PHASE(K_PRO, 0, 0);
#if PROBE_DUP == 10
    PHASE(K_PRO, 0, 0);
#endif
    for (int l = 0; l < DEPTH; ++l) {
        for (int f = 0; f < 2; ++f) {
            PHASE(K_UP, l, f);
#if PROBE_DUP == 2
            PHASE(K_UP, l, f);
#endif
            PHASE(K_DOWN, l, f);
            if (f == 0) {
                PHASE(K_ZG, l, 0);
#if PROBE_DUP == 4
                PHASE(K_ZG, l, 0);
#endif
                PHASE(K_PREP, l, 0);
#if PROBE_DUP == 5
                PHASE(K_PREP, l, PROBE_ROLE);
#endif
                PHASE(K_R1, l, 0);
#if PROBE_DUP == 11
                PHASE(K_R1, l, 0);
#endif
                PHASE(K_MIX, l, 0);
#if PROBE_DUP == 6
                PHASE(K_MIX, l, PROBE_ROLE);
#endif
                PHASE(K_POST, l, 0);
#if PROBE_DUP == 7
                PHASE(K_POST, l, 0);
#endif
                PHASE(K_MERGE, l, 0);
#if PROBE_DUP == 8
                PHASE(K_MERGE, l, 0);
#endif
                PHASE(K_OUTP, l, 0);
            }
        }
    }
#if DBG_STAMP
    if (blockIdx.x == STAMP_BLK && threadIdx.x == 0) { const gu32* c_ = (const gu32*)(args.ws + WS_CTL); unsigned v_ = 0;
        if (STAMP_SEL < 32) v_ = c_[3000 + STAMP_SEL]; else if (STAMP_SEL == 32) { for (int q = 0; q < 16; ++q) v_ += c_[3000 + q]; } else { for (int q = 16; q < 32; ++q) v_ += c_[3000 + q]; }
        __builtin_amdgcn_s_sleep(10); __threadfence(); args.out[0] = (float)v_; }
#endif
}
#endif

template <int KIND> static void launch_kind(int grid, hipStream_t stream, Args& a) { hipLaunchKernelGGL(k_phase<KIND>, dim3(grid), dim3(NWAVES * 64), LDS_BYTES, stream, a); }
template <int KIND> static bool set_attr() { return hipFuncSetAttribute((const void*)k_phase<KIND>, hipFuncAttributeMaxDynamicSharedMemorySize, LDS_BYTES) == hipSuccess; }
extern "C" void kernel_launch(void* const* d_in, const int* in_sizes, int n_in, void* d_out, int out_size, void* d_ws, size_t ws_size, hipStream_t stream) {
    static int grid = 0;
    if (grid == 0) {
        if (n_in != N_IN || out_size != SEQ * DM || ws_size < WS_END) { fprintf(stderr, "kernel_launch: unexpected shapes: n_in %d out %d ws %zu (need %zu)\n", n_in, out_size, ws_size, (size_t)WS_END); grid = -1; return; }
        int dev = 0, cus = 0;
        if (hipGetDevice(&dev) != hipSuccess || hipDeviceGetAttribute(&cus, hipDeviceAttributeMultiprocessorCount, dev) != hipSuccess) { grid = -1; return; }
#if MK_PER_PHASE
        const bool ok = set_attr<K_PRO>() && set_attr<K_NORM>() && set_attr<K_UP>() && set_attr<K_DOWN>() && set_attr<K_ZG>() && set_attr<K_PREP>() && set_attr<K_MIX>() && set_attr<K_POST>() && set_attr<K_MERGE>() && set_attr<K_OUTP>();
#else
        const bool ok = hipFuncSetAttribute((const void*)mega_fwd, hipFuncAttributeMaxDynamicSharedMemorySize, LDS_BYTES) == hipSuccess;
#endif
        if (!ok) { fprintf(stderr, "kernel_launch: hipFuncSetAttribute failed\n"); grid = -1; return; }
        (void)hipGetLastError();
        if (cus != 256) { fprintf(stderr, "kernel_launch: built for 256 CUs, device has %d\n", cus); grid = -1; return; }
        grid = cus;
    }
    if (grid < 0) return;
    if (hipMemsetAsync((char*)d_ws + WS_CTL, 0, CTL_ZERO_BYTES, stream) != hipSuccess) return;
    Args a{};
    for (int i = 0; i < N_IN; ++i) a.in[i] = (const float*)d_in[i];
    a.out = (float*)d_out; a.ws = (unsigned char*)d_ws;
#if MK_PER_PHASE
#if DBG
    const int dbg_last = DBG_LAST_PHASE;
#else
    const int dbg_last = N_PHASES - 1;
#endif
    for (int p = 0; p <= dbg_last; ++p) { int kind, l, sel; phase_decode(p, kind, l, sel); a.ph_lo = l; a.ph_hi = sel;
#if DBG
        if (kind == K_OUTP) hipMemcpyAsync((char*)d_ws + WS_END, d_out, (size_t)SEQ * DM * 4, hipMemcpyDeviceToDevice, stream);
#endif
        switch (kind) { case K_PRO: launch_kind<K_PRO>(grid, stream, a); break; case K_NORM: launch_kind<K_NORM>(grid, stream, a); break; case K_UP: launch_kind<K_UP>(grid, stream, a); break;
            case K_DOWN: launch_kind<K_DOWN>(grid, stream, a); break; case K_ZG: launch_kind<K_ZG>(grid, stream, a); break; case K_PREP: launch_kind<K_PREP>(grid, stream, a); break;
            case K_MIX: launch_kind<K_MIX>(grid, stream, a); break; case K_POST: launch_kind<K_POST>(grid, stream, a); break; case K_MERGE: launch_kind<K_MERGE>(grid, stream, a); break;
            default: launch_kind<K_OUTP>(grid, stream, a); break; }
#if DBG
        { int chk = 0; const int q = (p == 0) ? -1 : (p - 1) % PH_PER_LAYER;
          if (p == 0) chk = 1; else if (q == 0) chk = 2; else if (q == 1) chk = 3; else if (q == 2) chk = 4; else if (q == 3) chk = 5; else if (q == 4) chk = 6; else if (q == 6) chk = 7; else if (q == 8) chk = 8; else if (q == 9) chk = 9;
          if (chk && l == DBG_LAYER) hipLaunchKernelGGL(k_check, dim3(64), dim3(256), 0, stream, a, chk, l); }
#endif
    }
#if DBG
    hipLaunchKernelGGL(k_report, dim3((SEQ * DM + 255) / 256), dim3(256), 0, stream, a);
#endif
#else
    a.ph_lo = 0; a.ph_hi = N_PHASES;
    hipLaunchKernelGGL(mega_fwd, dim3(grid), dim3(NWAVES * 64), LDS_BYTES, stream, a);
#endif
    const hipError_t le = hipPeekAtLastError();
    if (le != hipSuccess) fprintf(stderr, "kernel_launch: launch failed: %s\n", hipGetErrorName(le));
}
```

```cpp
#include <hip/hip_runtime.h>
#include <hip/hip_bf16.h>
#include <cstdio>
#include <cstdint>
#include <cstddef>
#include <cmath>
#ifndef DBG
#define DBG 0
#endif
#define DBG_LAYER 0
#define DBG_LAST_PHASE 10
#define DBG_RAWGATE 0
#ifndef DBG_STAMP
#define DBG_STAMP 0
#endif
#define STAMP_BLK 0
#define STAMP_SEL 6
#define PROBE_DUP 0
#define PROBE_ROLE 0
constexpr int NWAVES = 8;
#ifndef MK_PER_PHASE
#define MK_PER_PHASE 0
#endif
constexpr int SEQ = 8192, DM = 2048, DFF = 5632, NH = 8, HD = 64, MW = 512, DEPTH = 4, ZW = 8192;
constexpr int PH_PER_LAYER = 11, N_PHASES = 1 + DEPTH * PH_PER_LAYER;
constexpr int ZC_FQ = 0, ZC_FK = 512, ZC_FV = 1024, ZC_FO = 1536, ZC_RR = 2048, ZC_RK = 2560, ZC_RV = 3072, ZC_RL = 3584;
constexpr int ZC_TQ = 3840, ZC_TK = 4352, ZC_TV = 4864, ZC_TG = 5376, ZC_MQK = 5888, ZC_MV = 6912, ZC_MO = 7424, ZC_FF = 7936, ZC_MI = 7944, ZC_MF = 7952;
enum { I_X = 0, I_POS, I_F1N, I_F1W1, I_F1W3, I_F1W2, I_MIXN, I_WIN, I_FOXFB, I_FOXQG, I_FOXKG, I_RMU, I_RW0, I_RW2, I_RA0, I_RA2, I_RG2, I_RKK, I_RKA, I_RRK, I_RGNW, I_RGNB,
       I_TGN, I_MCW, I_MCB, I_MIB, I_MFB, I_MGN, I_WG, I_WGB, I_WB, I_WO, I_F2N, I_F2W1, I_F2W3, I_F2W2, N_IN };
constexpr size_t MiB = 1u << 20;
constexpr size_t WS_CTL = 0, CTL_ZERO_BYTES = 1 * MiB;
constexpr size_t WL_W13A = 0, WL_W2A = 44 * MiB, WL_W13B = 66 * MiB, WL_W2B = 110 * MiB, WL_WIN = 132 * MiB, WL_WG = 164 * MiB, WL_WB = 196 * MiB, WL_WO = 204 * MiB, WL_BYTES = 212 * MiB;
constexpr size_t WS_W = 2 * MiB;
constexpr size_t WS_XN = WS_W + DEPTH * WL_BYTES + 2 * MiB;
constexpr size_t WS_Z = WS_XN + 32 * MiB;
constexpr size_t WS_HID = WS_Z;
constexpr size_t WS_GATES = WS_Z + 128 * MiB;
constexpr size_t WS_FQ = WS_GATES + 128 * MiB, WS_FK = WS_FQ + 8 * MiB, WS_RQ = WS_FK + 8 * MiB, WS_RK = WS_RQ + 8 * MiB, WS_MQ = WS_RK + 8 * MiB, WS_MK = WS_MQ + 8 * MiB;
constexpr size_t WS_YF = WS_MK + 8 * MiB, WS_YB = WS_YF + 8 * MiB, WS_YR = WS_YB + 8 * MiB, WS_YM = WS_YR + 8 * MiB;
constexpr size_t WS_RW = WS_YM + 8 * MiB;
constexpr size_t WS_YRAW = WS_RW + 100 * MiB;
constexpr size_t WS_RG = WS_YRAW + 16 * MiB;
constexpr size_t WS_SM = WS_RG + 8 * MiB;
constexpr size_t SM_RBON = 0, SM_FP = 256 * 1024, SM_FT = 512 * 1024, SM_MBC = 768 * 1024, SM_MA = 1024 * 1024, SM_MAX = 1536 * 1024, SM_MBL = 1540 * 1024, SM_MCG = 1544 * 1024;
constexpr size_t WS_MRGF = WS_SM + 2 * MiB;
constexpr size_t WS_MRGB = WS_MRGF + 64 * MiB;
constexpr size_t WS_FV = WS_MRGB + 32 * MiB, WS_FO = WS_FV + 8 * MiB, WS_TV = WS_FO + 8 * MiB, WS_TG = WS_TV + 8 * MiB, WS_MV = WS_TG + 8 * MiB, WS_MO = WS_MV + 8 * MiB;
constexpr size_t WS_RQT = WS_MO + 8 * MiB, WS_PCT = WS_RQT + 8 * MiB, WS_YLT = WS_PCT + 8 * MiB, WS_SL = WS_YLT + 16 * MiB, WS_GCV = WS_SL + 16 * MiB, WS_SALL = WS_GCV + 1 * MiB;
constexpr size_t WS_KV = WS_SALL + 8 * MiB, WS_SB = WS_KV + 32 * MiB, WS_NVC = WS_SB + 16 * MiB, WS_NB = WS_NVC + 1 * MiB;
constexpr size_t WS_SSP = WS_NB + 1 * MiB;
constexpr size_t WS_LORA = WS_SSP + 4 * MiB;
constexpr size_t WS_END = WS_LORA + 1 * MiB;
constexpr int CW_TMO = 0, CW_CODE = 1, CW_BAR = 4096;
constexpr int RING_OFF = 0, RING_BYTES = 131072, LDSCTL_OFF = RING_BYTES, MISC_OFF = LDSCTL_OFF + 320, PSQ_LDS_OFF = LDSCTL_OFF + 2048, RSTD_LDS_OFF = LDSCTL_OFF + 6144, LDS_BYTES = 147456;
constexpr int RREC = 224;
constexpr int LDT = 72;
constexpr int KARG_WS_OFF = N_IN * 8 + 8;
namespace pg8 {
#define PG8_LAS __attribute__((address_space(3)))
typedef unsigned short bf16_t;
typedef short bf16x8 __attribute__((ext_vector_type(8)));
typedef float f32x4 __attribute__((ext_vector_type(4)));
typedef unsigned u32x4 __attribute__((ext_vector_type(4)));
typedef unsigned u32x2 __attribute__((ext_vector_type(2)));
constexpr int BM = 256, BK = 64, HALF = 128, HTB = HALF * BK * 2  , STAGE_BYTES = 8 * HTB, NXCD = 8, WGM = 8;

__host__ __device__ __forceinline__ int lds_byte(int r, int c) { const int st = (r >> 4) * 2 + (c >> 5), rr = r & 15, cc = c & 31, ob = rr * 64 + cc * 2; return st * 1024 + (ob ^ (((ob >> 9) & 1) << 5)); }
__host__ __device__ __forceinline__ void stage_rc(int b, int& R, int& C) { const int st = b / 1024, sb = b % 1024, swz = sb ^ (((sb >> 9) & 1) << 5); R = (st >> 1) * 16 + swz / 64; C = (st & 1) * 32 + (swz % 64) / 2; }
__host__ __device__ __forceinline__ int perm32(int rho) { const int n = rho >> 4, i = rho & 15; return 8 * (i >> 2) + 4 * n + (i & 3); }

struct Unit { int pm, pn; };
struct Gemm { const bf16_t* A; const bf16_t* Bt; int M, N, K; };

struct StaticOrder {
    int nM, nN, nwg, G, c;
    __host__ __device__ void init(int M, int N, int G_, int c_) { nM = M / BM; nN = N / BM; nwg = nM * nN; G = G_; c = c_; }
    __host__ __device__ bool next(int i, Unit& u) const {
        const long L = (long)i * G + c; if (L >= nwg) return false;
        int wgid = (int)L; { const int q = nwg / NXCD, r = nwg % NXCD, xcd = wgid % NXCD, off = wgid / NXCD; wgid = (xcd < r ? xcd * (q + 1) : r * (q + 1) + (xcd - r) * q) + off; }
        const int nig = WGM * nN, gid = wgid / nig, fm = gid * WGM, gsz = (nM - fm) < WGM ? (nM - fm) : WGM;
        u.pm = fm + ((wgid % nig) % gsz); u.pn = (wgid % nig) / gsz; return true;
    }
    __device__ __forceinline__ void a_ready(const Unit&) const {}
    __device__ __forceinline__ void done(const Unit&) const {}
};

struct RangeOrder {
    int first, count, nM, nN;
    __host__ __device__ void init(int M, int N, int first_, int count_) { nM = M / BM; nN = N / BM; first = first_; count = count_; }
    __host__ __device__ bool next(int i, Unit& u) const {
        if (i >= count) return false; const int L = first + i;
        const int nig = WGM * nN, gid = L / nig, fm = gid * WGM, gsz = (nM - fm) < WGM ? (nM - fm) : WGM;
        u.pm = fm + ((L % nig) % gsz); u.pn = (L % nig) / gsz; return true;
    }
    __device__ __forceinline__ void a_ready(const Unit&) const {}
    __device__ __forceinline__ void done(const Unit&) const {}
};
__device__ __forceinline__ unsigned cvt_pk_bf16(float lo, float hi) { typedef float f2_t __attribute__((ext_vector_type(2))); typedef __bf16 b2_t __attribute__((ext_vector_type(2))); const f2_t v = {lo, hi}; return __builtin_bit_cast(unsigned, __builtin_convertvector(v, b2_t)); }
typedef float f32x2 __attribute__((ext_vector_type(2)));
struct NoPre {};
struct SsPre { float a, b, c, d; };
__device__ __forceinline__ float bf2f_lo(unsigned p) { return __builtin_bit_cast(float, p << 16); }
__device__ __forceinline__ float bf2f_hi(unsigned p) { return __builtin_bit_cast(float, p & 0xffff0000u); }
__device__ __forceinline__ float fast_sigmoid(float x) { return __builtin_amdgcn_rcpf(1.f + __builtin_amdgcn_exp2f(-1.4426950408889634f * x)); }
__device__ __forceinline__ SsPre ss_pre(const float* ss, const Unit& u, int tid) { const float* p = ss + (size_t)(4 * (tid & 1)) * SEQ + u.pm * BM + (tid >> 1); SsPre r; r.a = p[0]; r.b = p[SEQ]; r.c = p[2 * SEQ]; r.d = p[3 * SEQ]; return r; }
__device__ __forceinline__ const PG8_LAS float* rstd_table(const SsPre& pre) {
    PG8_LAS float* T = (PG8_LAS float*)(unsigned)(RSTD_LDS_OFF);
    float s = (pre.a + pre.b) + (pre.c + pre.d);
    s += __builtin_bit_cast(float, __builtin_amdgcn_update_dpp(0, __builtin_bit_cast(int, s), 0xB1, 0xf, 0xf, true));
    if ((threadIdx.x & 1) == 0) T[threadIdx.x >> 1] = 1.f / sqrtf(s * (1.f / 2048.f) + 1e-6f);
    asm volatile("s_waitcnt lgkmcnt(0)\n\ts_barrier" ::: "memory");
    return T;
}
struct EpiSwiglu {
    static constexpr bool PERM = true, AFTER_DRAIN = false; typedef SsPre Pre;
    bf16_t* O; int ldc; const float* ss;
    __device__ __forceinline__ Pre pre(const Unit& u, int tid) const { return ss_pre(ss, u, tid); }
    __device__ __forceinline__ void operator()(const f32x4 (&acc)[2][2][4][2], const Unit& u, int wr, int wc, int fr, int fq, const Pre& pr) const {
        const PG8_LAS float* RT = rstd_table(pr);
        const int row0 = u.pm * BM + wr * 64 + fr, col0 = u.pn * HALF + wc * 32 + 8 * fq;
#pragma unroll
        for (int ai = 0; ai < 2; ++ai)
#pragma unroll
            for (int m = 0; m < 4; ++m) { bf16_t* rowp = O + (size_t)(row0 + ai * HALF + m * 16) * ldc + col0;
                float h[8]; const float rs = RT[wr * 64 + fr + ai * HALF + m * 16];
#pragma unroll
                for (int n = 0; n < 2; ++n)
#pragma unroll
                    for (int e = 0; e < 4; ++e) { const float g = rs * acc[ai][0][m][n][e], b = rs * acc[ai][1][m][n][e]; h[4 * n + e] = g * fast_sigmoid(g) * b; }
                u32x4 w; w.x = cvt_pk_bf16(h[0], h[1]); w.y = cvt_pk_bf16(h[2], h[3]); w.z = cvt_pk_bf16(h[4], h[5]); w.w = cvt_pk_bf16(h[6], h[7]);
                *(u32x4*)rowp = w; }
    }
};
struct EpiResid {
    static constexpr bool PERM = true, AFTER_DRAIN = false; typedef NoPre Pre;
    float* outf; int inst; float scale; int pad_;
    __device__ __forceinline__ Pre pre(const Unit&, int) const { return {}; }
    __device__ __forceinline__ void operator()(const f32x4 (&acc)[2][2][4][2], const Unit& u, int wr, int wc, int fr, int fq, const Pre&) const {
        const int row0 = u.pm * BM + wr * 64 + fr, col0 = u.pn * BM + wc * 32 + 8 * fq; constexpr int ldc = ::DM;
        unsigned char* const ws = *(unsigned char* const __attribute__((address_space(4)))*)((const __attribute__((address_space(4))) char*)__builtin_amdgcn_kernarg_segment_ptr() + KARG_WS_OFF);
        bf16_t* const xb = (bf16_t*)(ws + WS_XN); PG8_LAS float* const PS = (PG8_LAS float*)(unsigned)(PSQ_LDS_OFF);
#pragma unroll
        for (int ai = 0; ai < 2; ++ai)
#pragma unroll
            for (int m = 0; m < 4; ++m) { float sq = 0.f;
#pragma unroll
                for (int bj = 0; bj < 2; ++bj) { const size_t p = (size_t)(row0 + ai * HALF + m * 16) * ldc + col0 + bj * HALF;
                    const u32x4 q = *(const u32x4*)(xb + p);
                    f32x4 v0, v1;
                    v0[0] = bf2f_lo(q.x) + acc[ai][bj][m][0][0] * scale; v0[1] = bf2f_hi(q.x) + acc[ai][bj][m][0][1] * scale; v0[2] = bf2f_lo(q.y) + acc[ai][bj][m][0][2] * scale; v0[3] = bf2f_hi(q.y) + acc[ai][bj][m][0][3] * scale;
                    v1[0] = bf2f_lo(q.z) + acc[ai][bj][m][1][0] * scale; v1[1] = bf2f_hi(q.z) + acc[ai][bj][m][1][1] * scale; v1[2] = bf2f_lo(q.w) + acc[ai][bj][m][1][2] * scale; v1[3] = bf2f_hi(q.w) + acc[ai][bj][m][1][3] * scale;
                    if (outf) { *(f32x4*)(outf + p) = v0; *(f32x4*)(outf + p + 4) = v1; }
                    u32x4 w; w.x = cvt_pk_bf16(v0[0], v0[1]); w.y = cvt_pk_bf16(v0[2], v0[3]); w.z = cvt_pk_bf16(v1[0], v1[1]); w.w = cvt_pk_bf16(v1[2], v1[3]); *(u32x4*)(xb + p) = w;
                    const float r0 = bf2f_lo(w.x), r1 = bf2f_hi(w.x), r2 = bf2f_lo(w.y), r3 = bf2f_hi(w.y), r4 = bf2f_lo(w.z), r5 = bf2f_hi(w.z), r6 = bf2f_lo(w.w), r7 = bf2f_hi(w.w);
                    sq += (r0 * r0 + r1 * r1) + (r2 * r2 + r3 * r3) + (r4 * r4 + r5 * r5) + (r6 * r6 + r7 * r7); }
                sq += __builtin_bit_cast(float, __builtin_amdgcn_ds_bpermute((fr + 16 * (fq ^ 1)) << 2, __builtin_bit_cast(int, sq)));
                sq += __builtin_bit_cast(float, __builtin_amdgcn_ds_bpermute((fr + 16 * (fq ^ 2)) << 2, __builtin_bit_cast(int, sq)));
                if (fq == 0) PS[wc * 256 + wr * 64 + fr + ai * HALF + m * 16] = sq; }
        asm volatile("s_waitcnt lgkmcnt(0)\n\ts_barrier" ::: "memory");
        if (threadIdx.x < 256) { const int r = threadIdx.x; ((float*)(ws + WS_SSP))[((size_t)inst * 8 + u.pn) * SEQ + u.pm * BM + r] = (PS[r] + PS[256 + r]) + (PS[512 + r] + PS[768 + r]); }
    }
};
template <int ACT> struct EpiStore {
    static constexpr bool PERM = true, AFTER_DRAIN = false; typedef SsPre Pre;
    bf16_t* O; int ldc; const float* bias; const float* ss;
    __device__ __forceinline__ Pre pre(const Unit& u, int tid) const { return ss_pre(ss, u, tid); }
    __device__ __forceinline__ void operator()(const f32x4 (&acc)[2][2][4][2], const Unit& u, int wr, int wc, int fr, int fq, const Pre& pr) const {
        const PG8_LAS float* RT = rstd_table(pr);
        const int row0 = u.pm * BM + wr * 64 + fr, col0 = u.pn * BM + wc * 32 + 8 * fq;
        f32x4 bv[2][2];
#pragma unroll
        for (int bj = 0; bj < 2; ++bj)
#pragma unroll
            for (int n = 0; n < 2; ++n) bv[bj][n] = bias ? *(const f32x4*)(bias + col0 + bj * HALF + 4 * n) : (f32x4){0.f, 0.f, 0.f, 0.f};
#pragma unroll
        for (int ai = 0; ai < 2; ++ai)
#pragma unroll
            for (int m = 0; m < 4; ++m) { bf16_t* rowp = O + (size_t)(row0 + ai * HALF + m * 16) * ldc + col0; const float rs = RT[wr * 64 + fr + ai * HALF + m * 16];
#pragma unroll
                for (int bj = 0; bj < 2; ++bj) { f32x4 v0 = acc[ai][bj][m][0] * rs + bv[bj][0], v1 = acc[ai][bj][m][1] * rs + bv[bj][1];
                    if (ACT == 1) {
#pragma unroll
                        for (int e = 0; e < 4; ++e) { v0[e] = fast_sigmoid(v0[e]); v1[e] = fast_sigmoid(v1[e]); } }
                    u32x4 w; w.x = cvt_pk_bf16(v0[0], v0[1]); w.y = cvt_pk_bf16(v0[2], v0[3]); w.z = cvt_pk_bf16(v1[0], v1[1]); w.w = cvt_pk_bf16(v1[2], v1[3]);
                    *(u32x4*)(rowp + bj * HALF) = w; } }
    }
};
struct EpiGates {
    static constexpr bool PERM = true, AFTER_DRAIN = false; typedef SsPre Pre;
    bf16_t* O; int ldc; const float* bias; const float* ss;
    __device__ __forceinline__ Pre pre(const Unit& u, int tid) const { return ss_pre(ss, u, tid); }
    __device__ __forceinline__ void operator()(const f32x4 (&acc)[2][2][4][2], const Unit& u, int wr, int wc, int fr, int fq, const Pre& pr) const {
        const PG8_LAS float* RT = rstd_table(pr);
        const int row0 = u.pm * BM + wr * 64 + fr, j0 = u.pn * 64 + wc * 16 + 4 * fq;
        f32x4 bv[4];
#pragma unroll
        for (int n = 0; n < 4; ++n) bv[n] = *(const f32x4*)(bias + n * 2048 + j0);
#pragma unroll
        for (int ai = 0; ai < 2; ++ai)
#pragma unroll
            for (int m = 0; m < 4; ++m) { bf16_t* rowp = O + (size_t)(row0 + ai * HALF + m * 16) * ldc + j0; const float rs = RT[wr * 64 + fr + ai * HALF + m * 16];
                f32x4 d[4];
#pragma unroll
                for (int n = 0; n < 4; ++n)
#pragma unroll
                    for (int e = 0; e < 4; ++e) d[n][e] = fminf(1.f + __builtin_amdgcn_exp2f(-1.4426950408889634f * (acc[ai][n >> 1][m][n & 1][e] * rs + bv[n][e])), 1e9f);
#pragma unroll
                for (int n = 0; n < 4; ++n) { f32x4 q;
#pragma unroll
                    for (int e = 0; e < 4; ++e) { const float r = __builtin_amdgcn_rcpf(d[n][e]); q[e] = (n < 3) ? d[(n + 1) & 3][e] * r : r; }
                    u32x2 w; w.x = cvt_pk_bf16(q[0], q[1]); w.y = cvt_pk_bf16(q[2], q[3]); *(u32x2*)(rowp + n * 2048) = w; } }
    }
};
template <int MODE> struct EpiMerge {
    static constexpr bool PERM = true, AFTER_DRAIN = false; typedef NoPre Pre;
    __device__ __forceinline__ Pre pre(const Unit&, int) const { return {}; }
    const bf16_t* G; int ldg; float* Mf; bf16_t* Mb; int ldc; float mul;
    __device__ __forceinline__ void operator()(const f32x4 (&acc)[2][2][4][2], const Unit& u, int wr, int wc, int fr, int fq, const Pre&) const {
        const int row0 = u.pm * BM + wr * 64 + fr, col0 = u.pn * BM + wc * 32 + 8 * fq;
#pragma unroll
        for (int ai = 0; ai < 2; ++ai)
#pragma unroll
            for (int m = 0; m < 4; ++m)
#pragma unroll
                for (int bj = 0; bj < 2; ++bj) { const int row = row0 + ai * HALF + m * 16, col = col0 + bj * HALF;
                    const u32x4 gz = *(const u32x4*)(G + (size_t)row * ldg + col);
                    f32x4 v0, v1;
                    v0[0] = bf2f_lo(gz.x) * acc[ai][bj][m][0][0]; v0[1] = bf2f_hi(gz.x) * acc[ai][bj][m][0][1]; v0[2] = bf2f_lo(gz.y) * acc[ai][bj][m][0][2]; v0[3] = bf2f_hi(gz.y) * acc[ai][bj][m][0][3];
                    v1[0] = bf2f_lo(gz.z) * acc[ai][bj][m][1][0]; v1[1] = bf2f_hi(gz.z) * acc[ai][bj][m][1][1]; v1[2] = bf2f_lo(gz.w) * acc[ai][bj][m][1][2]; v1[3] = bf2f_hi(gz.w) * acc[ai][bj][m][1][3];
                    v0 *= mul; v1 *= mul;
                    const size_t p = (size_t)row * ldc + col;
                    if (MODE >= 1) { v0 += *(const f32x4*)(Mf + p); v1 += *(const f32x4*)(Mf + p + 4); }
                    if (MODE <= 1) { *(f32x4*)(Mf + p) = v0; *(f32x4*)(Mf + p + 4) = v1; }
                    else { u32x4 w; w.x = cvt_pk_bf16(v0[0], v0[1]); w.y = cvt_pk_bf16(v0[2], v0[3]); w.z = cvt_pk_bf16(v1[0], v1[1]); w.w = cvt_pk_bf16(v1[2], v1[3]); *(u32x4*)(Mb + p) = w; } }
    }
};

struct MergeOrder {
    int pm, pn;
    __device__ __forceinline__ bool next(int i, Unit& u) const { if (i >= 4) return false; u.pm = i * 32 + pm; u.pn = i * 8 + pn; return true; }
    __device__ __forceinline__ void a_ready(const Unit&) const {}
    __device__ __forceinline__ void done(const Unit&) const {}
};
struct EpiMergeAll {
    static constexpr bool PERM = true, AFTER_DRAIN = false; typedef NoPre Pre;
    __device__ __forceinline__ Pre pre(const Unit&, int) const { return {}; }
    const bf16_t* G; int ldg; float* Mf; bf16_t* Mb; int ldc;
    __device__ __forceinline__ void operator()(f32x4 (&acc)[2][2][4][2], const Unit& u, int wr, int wc, int fr, int fq, const Pre&) const {
        const int n = u.pm >> 5, row0 = (u.pm & 31) * BM + wr * 64 + fr, col0 = (u.pn & 7) * BM + wc * 32 + 8 * fq;
        const bf16_t* Gn = G + n * ldc;
#pragma unroll
        for (int ai = 0; ai < 2; ++ai)
#pragma unroll
            for (int m = 0; m < 4; ++m)
#pragma unroll
                for (int bj = 0; bj < 2; ++bj) { const int row = row0 + ai * HALF + m * 16, col = col0 + bj * HALF;
                    const u32x4 gz = *(const u32x4*)(Gn + (size_t)row * ldg + col);
                    f32x4 v0 = acc[ai][bj][m][0], v1 = acc[ai][bj][m][1];
                    v0[0] *= bf2f_lo(gz.x); v0[1] *= bf2f_hi(gz.x); v0[2] *= bf2f_lo(gz.y); v0[3] *= bf2f_hi(gz.y);
                    v1[0] *= bf2f_lo(gz.z); v1[1] *= bf2f_hi(gz.z); v1[2] *= bf2f_lo(gz.w); v1[3] *= bf2f_hi(gz.w);
                    acc[ai][bj][m][0] = v0; acc[ai][bj][m][1] = v1;
                    if (n == 3) { u32x4 w; w.x = cvt_pk_bf16(v0[0], v0[1]); w.y = cvt_pk_bf16(v0[2], v0[3]); w.z = cvt_pk_bf16(v1[0], v1[1]); w.w = cvt_pk_bf16(v1[2], v1[3]); *(u32x4*)(Mb + (size_t)row * ldc + col) = w; } }
    }
};
template <class T> struct KeepAcc { static constexpr bool v = false; };
template <> struct KeepAcc<EpiMergeAll> { static constexpr bool v = true; };
template <class Epi, class Sched, bool ALIGN_EPI = false, bool SP2 = false>
__device__ __forceinline__ void gemm_phase(PG8_LAS unsigned char* lds, const Gemm g, const Sched& S, const Epi& E) {
    int tid_ = threadIdx.x; asm volatile("; opaque tid (no hoisting of lane-derived values across phases)" : "+v"(tid_));
    const int tid = tid_, wid = __builtin_amdgcn_readfirstlane(tid >> 6), lane = tid & 63, wr = wid >> 2, wc = wid & 3, fr = lane & 15, fq = lane >> 4;
    const int K = g.K, nt = K / BK;
    unsigned voffA[2], voffB[2];
#pragma unroll
    for (int i = 0; i < 2; ++i) { int R, C; stage_rc(tid * 16 + i * 8192, R, C); const int Rb = Epi::PERM ? ((R & ~31) + perm32(R & 31)) : R;
        voffA[i] = (unsigned)(R * K + C) * 2u; voffB[i] = (unsigned)(Rb * K + C) * 2u; }
    const size_t kstep = (size_t)(BK * 2);
    const size_t hstep = (size_t)HALF * K * 2;
    const size_t tstep = 2 * hstep;
    const unsigned ldsw = (unsigned)wid * 1024u;
    const int aoff = lds_byte(wr * 64 + fr, fq * 8), boff = lds_byte(wc * 32 + fr, fq * 8);
#define PG8_SA(b, h) (((b) * 2 + (h)) * HTB)
#define PG8_SB(b, h) ((4 + (b) * 2 + (h)) * HTB)
#define PG8_STAGE(bufoff, gbase, voff) do { _Pragma("unroll") for (int _i = 0; _i < 2; ++_i) \
        __builtin_amdgcn_global_load_lds((const unsigned*)((const char*)(gbase) + (voff)[_i]), (PG8_LAS unsigned*)(lds + (bufoff) + ldsw + _i * 8192), 16, 0, 0); } while (0)
#define PG8_LDA(dst, b, h) do { _Pragma("unroll") for (int m = 0; m < 4; ++m) _Pragma("unroll") for (int k = 0; k < 2; ++k) dst[m][k] = *(const PG8_LAS bf16x8*)(lds + PG8_SA(b, h) + aoff + m * 2048 + k * 1024); } while (0)
#define PG8_LDB(dst, b, h) do { _Pragma("unroll") for (int n = 0; n < 2; ++n) _Pragma("unroll") for (int k = 0; k < 2; ++k) dst[n][k] = *(const PG8_LAS bf16x8*)(lds + PG8_SB(b, h) + boff + n * 2048 + k * 1024); } while (0)
#define PG8_MMA(ai, bj, At, Bt) do { __builtin_amdgcn_s_setprio(1); _Pragma("unroll") for (int m = 0; m < 4; ++m) _Pragma("unroll") for (int n = 0; n < 2; ++n) _Pragma("unroll") for (int k = 0; k < 2; ++k) \
        acc[ai][bj][m][n] = __builtin_amdgcn_mfma_f32_16x16x32_bf16(Bt[n][k], At[m][k], acc[ai][bj][m][n], 0, 0, 0); __builtin_amdgcn_s_setprio(0); } while (0)
#define PG8_WAIT_V(n) asm volatile("s_waitcnt vmcnt(" #n ")" ::: "memory")
#define PG8_WAIT_L(n) asm volatile("s_waitcnt lgkmcnt(" #n ")" ::: "memory")
#define PG8_BAR __builtin_amdgcn_s_barrier()
#define PG8_SCHED __builtin_amdgcn_sched_barrier(0)
    Unit cur, nxt; int ui = 0;
    if (!S.next(0, cur)) return;
    f32x4 acc[2][2][4][2];
#pragma unroll
    for (int a = 0; a < 2; ++a)
#pragma unroll
        for (int b = 0; b < 2; ++b)
#pragma unroll
            for (int m = 0; m < 4; ++m)
#pragma unroll
                for (int n = 0; n < 2; ++n) acc[a][b][m][n] = (f32x4){0.f, 0.f, 0.f, 0.f};
    bf16x8 At[4][2], B0[2][2], B1[2][2];
    const char* cA = (const char*)g.A + (size_t)cur.pm * tstep; const char* cB = (const char*)g.Bt + (size_t)cur.pn * tstep;
    S.a_ready(cur);
    if constexpr (SP2) {
        PG8_STAGE(PG8_SB(0, 0), cB, voffB); PG8_STAGE(PG8_SB(0, 1), cB + hstep, voffB); PG8_STAGE(PG8_SA(0, 0), cA, voffA); PG8_STAGE(PG8_SA(0, 1), cA + hstep, voffA);
        if (wr == 1) PG8_BAR;
        PG8_WAIT_V(2); PG8_BAR;
        PG8_STAGE(PG8_SB(1, 0), cB + kstep, voffB); PG8_STAGE(PG8_SA(1, 0), cA + kstep, voffA); PG8_STAGE(PG8_SB(1, 1), cB + hstep + kstep, voffB);
        PG8_WAIT_V(6); PG8_BAR;
    } else {
        PG8_STAGE(PG8_SB(0, 0), cB, voffB); PG8_STAGE(PG8_SA(0, 0), cA, voffA); PG8_STAGE(PG8_SB(0, 1), cB + hstep, voffB); PG8_STAGE(PG8_SA(0, 1), cA + hstep, voffA);
        if (wr == 1) PG8_BAR;
        PG8_WAIT_V(4); PG8_BAR;
        PG8_STAGE(PG8_SB(1, 0), cB + kstep, voffB); PG8_STAGE(PG8_SA(1, 0), cA + kstep, voffA); PG8_STAGE(PG8_SB(1, 1), cB + hstep + kstep, voffB);
        PG8_WAIT_V(6); PG8_BAR;
    }
    for (;;) {
        const bool has_next = S.next(ui + 1, nxt);
        const typename Epi::Pre epre = E.pre(cur, tid);
        const char* nA = has_next ? (const char*)g.A + (size_t)nxt.pm * tstep : cA; const char* nB = has_next ? (const char*)g.Bt + (size_t)nxt.pn * tstep : cB;
        for (int t = 0; t < nt; t += 2) {
            const bool last = (t == nt - 2);
            const char* a1 = cA + (size_t)(t + 1) * kstep;
            const char* a2 = last ? nA : cA + (size_t)(t + 2) * kstep; const char* b2 = last ? nB : cB + (size_t)(t + 2) * kstep;
            const char* a3 = a2 + kstep; const char* b3 = b2 + kstep;
            if (last && has_next) S.a_ready(nxt);
            if constexpr (SP2) {
            PG8_LDB(B0, 0, 0); PG8_LDB(B1, 0, 1); PG8_SCHED; PG8_LDA(At, 0, 0); PG8_STAGE(PG8_SA(1, 1), a1 + hstep, voffA);
            PG8_WAIT_V(8); PG8_WAIT_L(0); PG8_BAR; PG8_MMA(0, 0, At, B0); PG8_MMA(0, 1, At, B1); PG8_BAR; PG8_SCHED;
            PG8_LDA(At, 0, 1); PG8_STAGE(PG8_SB(0, 0), b2, voffB); PG8_STAGE(PG8_SB(0, 1), b2 + hstep, voffB); PG8_STAGE(PG8_SA(0, 0), a2, voffA);
            PG8_WAIT_V(8); PG8_WAIT_L(0); PG8_BAR; PG8_MMA(1, 0, At, B0); PG8_MMA(1, 1, At, B1); PG8_BAR; PG8_SCHED;
            PG8_LDB(B0, 1, 0); PG8_LDB(B1, 1, 1); PG8_SCHED; PG8_LDA(At, 1, 0); PG8_STAGE(PG8_SA(0, 1), a2 + hstep, voffA);
            PG8_WAIT_V(8); PG8_WAIT_L(0); PG8_BAR; PG8_MMA(0, 0, At, B0); PG8_MMA(0, 1, At, B1); PG8_BAR; PG8_SCHED;
            PG8_LDA(At, 1, 1); PG8_STAGE(PG8_SB(1, 0), b3, voffB); PG8_STAGE(PG8_SB(1, 1), b3 + hstep, voffB); PG8_STAGE(PG8_SA(1, 0), a3, voffA);
            PG8_WAIT_V(8); PG8_WAIT_L(0); PG8_BAR; PG8_MMA(1, 0, At, B0); PG8_MMA(1, 1, At, B1); PG8_BAR; PG8_SCHED;
            } else {
            PG8_LDB(B0, 0, 0); PG8_SCHED; PG8_LDA(At, 0, 0); PG8_STAGE(PG8_SA(1, 1), a1 + hstep, voffA);
            PG8_WAIT_L(8); PG8_BAR; PG8_WAIT_L(0); PG8_MMA(0, 0, At, B0); PG8_BAR; PG8_SCHED;
            PG8_LDB(B1, 0, 1); PG8_STAGE(PG8_SB(0, 0), b2, voffB);
            PG8_BAR; PG8_WAIT_L(0); PG8_MMA(0, 1, At, B1); PG8_BAR;
            PG8_LDA(At, 0, 1); PG8_STAGE(PG8_SA(0, 0), a2, voffA);
            PG8_BAR; PG8_WAIT_L(0); PG8_MMA(1, 0, At, B0); PG8_BAR; PG8_SCHED;
            PG8_STAGE(PG8_SB(0, 1), b2 + hstep, voffB);
            PG8_WAIT_V(6); PG8_BAR; PG8_MMA(1, 1, At, B1); PG8_BAR;
            PG8_LDB(B0, 1, 0); PG8_SCHED; PG8_LDA(At, 1, 0); PG8_STAGE(PG8_SA(0, 1), a2 + hstep, voffA);
            PG8_WAIT_L(8); PG8_BAR; PG8_WAIT_L(0); PG8_MMA(0, 0, At, B0); PG8_BAR; PG8_SCHED;
            PG8_LDB(B1, 1, 1); PG8_STAGE(PG8_SB(1, 0), b3, voffB);
            PG8_BAR; PG8_WAIT_L(0); PG8_MMA(0, 1, At, B1); PG8_BAR;
            PG8_LDA(At, 1, 1); PG8_STAGE(PG8_SA(1, 0), a3, voffA);
            PG8_BAR; PG8_WAIT_L(0); PG8_MMA(1, 0, At, B0); PG8_BAR; PG8_SCHED;
            PG8_STAGE(PG8_SB(1, 1), b3 + hstep, voffB);
            PG8_WAIT_V(6); PG8_BAR; PG8_MMA(1, 1, At, B1); PG8_BAR;
            }
        }
        if constexpr (ALIGN_EPI) { if (wr == 0) PG8_BAR; }
        if constexpr (!Epi::AFTER_DRAIN) { E(acc, cur, wr, wc, fr, fq, epre); S.done(cur); }
        if (!has_next) break;
        if constexpr (!KeepAcc<Epi>::v) {
#pragma unroll
        for (int a = 0; a < 2; ++a)
#pragma unroll
            for (int b = 0; b < 2; ++b)
#pragma unroll
                for (int m = 0; m < 4; ++m)
#pragma unroll
                    for (int n = 0; n < 2; ++n) acc[a][b][m][n] = (f32x4){0.f, 0.f, 0.f, 0.f};
        }
        cur = nxt; cA = nA; cB = nB; ++ui;
        if constexpr (ALIGN_EPI) { if (wr == 1) PG8_BAR; }
    }
    PG8_WAIT_V(0);
    if constexpr (!ALIGN_EPI) { if (wr == 0) PG8_BAR; }
    PG8_BAR;
    if constexpr (Epi::AFTER_DRAIN) { E.fused(acc, cur, wr, wc, fr, fq, lds, wid, lane); S.done(cur); }
#undef PG8_SA
#undef PG8_SB
#undef PG8_STAGE
#undef PG8_LDA
#undef PG8_LDB
#undef PG8_MMA
#undef PG8_WAIT_V
#undef PG8_WAIT_L
#undef PG8_BAR
#undef PG8_SCHED
}
}
namespace attn_body {
using bf16=__hip_bfloat16;
using bf16x8=__attribute__((ext_vector_type(8)))short;
using s16x4=__attribute__((ext_vector_type(4)))short;
using f32x16=__attribute__((ext_vector_type(16)))float;
using u32x4=__attribute__((ext_vector_type(4)))unsigned;
constexpr int BATCH=1,NHEAD=8,SEQ=8192,D=64,DM=NHEAD*D,VP=8192;
constexpr int NW=8,QBLK=32,QB=QBLK*NW,KVBLK=64,NQB=SEQ/QB;
constexpr int ATTN_PITCH=DM, ATTN_UNIT_ROWS=QB;
__device__ __forceinline__ int crow(int r,int hi){return (r&3)+8*(r>>2)+4*hi;}
#define SBAR() __builtin_amdgcn_sched_barrier(0)
__device__ __forceinline__ void cmask(f32x16&p0,f32x16&p1,int jb,int qrel,int hi){
  const float NEG=-INFINITY; int kb=64*jb+4*hi;
  #pragma unroll
  for(int r=0;r<16;++r){int kv=kb+(r&3)+8*(r>>2); if(kv>qrel)p0[r]=NEG; if(kv+32>qrel)p1[r]=NEG;}
}

constexpr int NSLOT=3, SLOTB=8192;
constexpr int LDS_K=0, LDS_V=NSLOT*SLOTB, LDS_WS=2*NSLOT*SLOTB, LDS_OST=LDS_WS+NW*64*4, LDS_BYTES0=LDS_OST+NW*4096, LDS_BT=LDS_BYTES0, LDS_E=LDS_BT+32768, LDS_SKP=LDS_E+512, LDS_BYTES=LDS_SKP+16;
constexpr float C2=0.125f*1.4426950408889634f;
__device__ __forceinline__ void glds16(const void*gsrc,unsigned lds_dst){unsigned keep;
  asm volatile("s_mov_b32 %0, m0\n\ts_mov_b32 m0, %2\n\ts_nop 0\n\tglobal_load_lds_dwordx4 %1, off\n\ts_mov_b32 m0, %0":"=&s"(keep):"v"(gsrc),"s"(lds_dst):"memory");}
__device__ __forceinline__ float max3f(float a,float b,float c){float r;asm("v_max3_f32 %0, %1, %2, %3":"=v"(r):"v"(a),"v"(b),"v"(c));return r;}
__device__ __forceinline__ float max2f(float a,float b){float r;asm("v_max_f32_e32 %0, %1, %2":"=v"(r):"v"(a),"v"(b));return r;}
__device__ __forceinline__ float fadd_s(float a,float b){float r;asm("v_add_f32_e32 %0, %1, %2":"=v"(r):"v"(a),"v"(b));return r;}
__device__ __forceinline__ float fsub_s(float a,float b){float r;asm("v_sub_f32_e32 %0, %1, %2":"=v"(r):"v"(a),"v"(b));return r;}
typedef float f32x2_t __attribute__((ext_vector_type(2))); typedef __bf16 bf16x2_t __attribute__((ext_vector_type(2)));
__device__ __forceinline__ unsigned cvtpk_s(float lo,float hi){f32x2_t v={lo,hi};bf16x2_t b=__builtin_convertvector(v,bf16x2_t);return __builtin_bit_cast(unsigned,b);}
typedef float f32x4_t __attribute__((ext_vector_type(4)));
__device__ __forceinline__ float sigm(float x){return __builtin_amdgcn_rcpf(1.f+__builtin_amdgcn_exp2f(-1.4426950408889634f*x));}
#define WAIT_BAR(N) asm volatile("s_waitcnt vmcnt(" #N ") lgkmcnt(0)\n\ts_barrier":::"memory")

__device__ __forceinline__ void qkt(f32x16&p0,f32x16&p1,const char*Kslot,const bf16x8*qr,const f32x16&negm,int r32,int hi){
  const char*kb=Kslot+hi*1024+r32*16;
  #pragma unroll
  for(int d0=0;d0<4;++d0){
    const bf16x8 b0=*reinterpret_cast<const bf16x8*>(kb+d0*2048);
    const bf16x8 b1=*reinterpret_cast<const bf16x8*>(kb+d0*2048+512);
    if(d0==0){p0=__builtin_amdgcn_mfma_f32_32x32x16_bf16(b0,qr[0],negm,0,0,0);p1=__builtin_amdgcn_mfma_f32_32x32x16_bf16(b1,qr[0],negm,0,0,0);}
    else{p0=__builtin_amdgcn_mfma_f32_32x32x16_bf16(b0,qr[d0],p0,0,0,0);p1=__builtin_amdgcn_mfma_f32_32x32x16_bf16(b1,qr[d0],p1,0,0,0);}}
}
typedef __attribute__((address_space(3))) const char* lds_cptr;
typedef short v4i16_t __attribute__((ext_vector_type(4)));
__device__ __forceinline__ void kload8(bf16x8*kf,lds_cptr kp){
  kf[0]=*(const __attribute__((address_space(3))) bf16x8*)(kp);      kf[1]=*(const __attribute__((address_space(3))) bf16x8*)(kp+512);
  kf[2]=*(const __attribute__((address_space(3))) bf16x8*)(kp+2048); kf[3]=*(const __attribute__((address_space(3))) bf16x8*)(kp+2560);
  kf[4]=*(const __attribute__((address_space(3))) bf16x8*)(kp+4096); kf[5]=*(const __attribute__((address_space(3))) bf16x8*)(kp+4608);
  kf[6]=*(const __attribute__((address_space(3))) bf16x8*)(kp+6144); kf[7]=*(const __attribute__((address_space(3))) bf16x8*)(kp+6656);
}
__device__ __forceinline__ void kload2(bf16x8*kf,lds_cptr kp,int j){ kf[2*j]=*(const __attribute__((address_space(3))) bf16x8*)(kp+j*2048); kf[2*j+1]=*(const __attribute__((address_space(3))) bf16x8*)(kp+j*2048+512); }
__device__ __forceinline__ s16x4 vtr(lds_cptr p){ return __builtin_bit_cast(s16x4,__builtin_amdgcn_ds_read_tr16_b64_v4i16((__attribute__((address_space(3))) v4i16_t*)p)); }
__device__ __forceinline__ float rowmax(const f32x16&p0,const f32x16&p1){
  float a=max3f(p0[0],p0[1],p1[0]),b=max3f(p0[2],p0[3],p1[1]);a=max3f(a,p1[2],p1[3]);
  #pragma unroll
  for(int r=4;r<16;r+=4){a=max3f(a,p0[r],p0[r+1]);b=max3f(b,p0[r+2],p0[r+3]);a=max3f(a,p1[r],p1[r+1]);b=max3f(b,p1[r+2],p1[r+3]);}
  const float m=max2f(a,b);
  auto rr=__builtin_amdgcn_permlane32_swap(__float_as_uint(m),__float_as_uint(m),false,false);
  return max2f(__uint_as_float(rr[0]),__uint_as_float(rr[1]));
}
__device__ __forceinline__ void pv(f32x16*o,int vb,bf16x8 pa0,bf16x8 pa1,bf16x8 pa2,bf16x8 pa3){
  #pragma unroll
  for(int d0=0;d0<2;++d0){s16x4 lo[4],hi[4];
    #pragma unroll
    for(int ks=0;ks<4;++ks){
      asm volatile("ds_read_b64_tr_b16 %0,%1 offset:%c2":"=&v"(lo[ks]):"v"(vb),"i"(d0*4096+ks*1024):"memory");
      asm volatile("ds_read_b64_tr_b16 %0,%1 offset:%c2":"=&v"(hi[ks]):"v"(vb),"i"(d0*4096+ks*1024+512):"memory");}
    asm volatile("s_waitcnt lgkmcnt(0)":::"memory");SBAR();
    #define PK(k) (bf16x8){lo[k][0],lo[k][1],lo[k][2],lo[k][3],hi[k][0],hi[k][1],hi[k][2],hi[k][3]}
    o[d0]=__builtin_amdgcn_mfma_f32_32x32x16_bf16(pa0,PK(0),o[d0],0,0,0);
    o[d0]=__builtin_amdgcn_mfma_f32_32x32x16_bf16(pa1,PK(1),o[d0],0,0,0);
    o[d0]=__builtin_amdgcn_mfma_f32_32x32x16_bf16(pa2,PK(2),o[d0],0,0,0);
    o[d0]=__builtin_amdgcn_mfma_f32_32x32x16_bf16(pa3,PK(3),o[d0],0,0,0);
    #undef PK
  }
}

#ifndef ATTN_STORE16
#define ATTN_STORE16(p,v) (*(u32x4*)(p)=(v))
#endif
template<int THRL> __device__ __forceinline__ void attn_unit(int b,int h,int qb,const bf16*Q,const bf16*__restrict__ K,const bf16*__restrict__ V,bf16*O,const float*__restrict__ FP,const float*__restrict__ FT,const bf16*__restrict__ GZ,char*shm){
  int tid_=threadIdx.x; asm volatile("; OPAQUE_TID":"+v"(tid_)); const int tid=tid_,lane=tid&63,r32=lane&31,hi=lane>>5; const int wid=__builtin_amdgcn_readfirstlane(tid>>6);
  const long rowbase=(long)b*SEQ; const int q0=qb*QB;
  const bf16*Qw=Q+(rowbase+q0+wid*QBLK)*DM+h*D;
  const bf16*Kh=K+rowbase*DM+h*D,*Vh=V+rowbase*VP+h*D;
  const unsigned lds0=(unsigned)(uintptr_t)shm;
  float*wsf=(float*)(shm+LDS_WS)+wid*64;
  const bf16*ksrc=Kh+(long)lane*DM+wid*8;
  const bf16*vsrc=Vh+(long)(16*(wid&3)+(lane>>2))*VP+(wid>>2)*32+(lane&3)*8;
  const unsigned kdst=lds0+LDS_K+wid*1024, vdst=lds0+LDS_V+wid*1024;
  #define DMA_K(t,slot) glds16(ksrc+(long)(t)*KVBLK*DM,(unsigned)__builtin_amdgcn_readfirstlane(kdst+(slot)))
  #define DMA_V(t,slot) glds16(vsrc+(long)(t)*KVBLK*VP,(unsigned)__builtin_amdgcn_readfirstlane(vdst+(slot)))
  const int vb0=(int)(lds0+LDS_V)+((lane>>4)&1)*32+(lane&3)*8+(4*hi+((lane&15)>>2))*64;
  const char*Kbase=shm+LDS_K; bf16x8 kf[8];
  const lds_cptr shm3=(lds_cptr)shm; const lds_cptr kp0=shm3+LDS_K+hi*1024+r32*16; const lds_cptr vp0=shm3+LDS_V+((lane>>4)&1)*32+(lane&3)*8+(4*hi+((lane&15)>>2))*64;
  int NT=(q0+QB)/KVBLK;
  int tskip=0;
  { float*Ef=(float*)(shm+LDS_E); float*bt=(float*)(shm+LDS_BT);
    if(wid==0){ const float a0=(2*lane<NT)?FT[h*128+2*lane]:0.f, a1=(2*lane+1<NT)?FT[h*128+2*lane+1]:0.f; float sc=a0+a1;
      _Pragma("unroll") for(int o=1;o<64;o<<=1){ const float u=__builtin_bit_cast(float,__builtin_amdgcn_ds_bpermute(((lane-o)&63)<<2,__builtin_bit_cast(int,sc))); if(lane>=o)sc+=u; }
      const float ex=sc-(a0+a1); Ef[2*lane]=ex; Ef[2*lane+1]=ex+a0; }
    asm volatile("s_waitcnt lgkmcnt(0)\n\ts_barrier":::"memory");
    const float fref=Ef[q0>>6];
    if(wid<2){ const bool fl=(tid<NT)&&((fref-(Ef[tid&127]+FP[h*SEQ+64*(tid&127)+63]))*1.4426950408889634f<-80.f);
      const unsigned long long bm=__ballot(fl); if(lane==0)((int*)(shm+LDS_SKP))[wid]=__popcll(bm); }
    for(int s=tid;s<q0+QB;s+=NW*64){ const float bv=(fref-(Ef[s>>6]+FP[h*SEQ+s]))*1.4426950408889634f; unsigned ub=__float_as_uint(bv); const unsigned hb=(ub+0x7fffu+((ub>>16)&1u))>>16;
      const float rr_=bv-__uint_as_float(hb<<16); unsigned ur=__float_as_uint(rr_); const unsigned lb=(ur+0x7fffu+((ur>>16)&1u))>>16; ((unsigned*)bt)[s]=hb|(lb<<16); }
    asm volatile("s_waitcnt vmcnt(0) lgkmcnt(0)\n\ts_barrier":::"memory"); }
  { int ts=(((const int*)(shm+LDS_SKP))[0]+((const int*)(shm+LDS_SKP))[1])&~1; ts=ts>NT-4?NT-4:ts; ts=__builtin_amdgcn_readfirstlane(ts);
    NT-=ts; ksrc+=(long)ts*KVBLK*DM; vsrc+=(long)ts*KVBLK*VP; tskip=ts; }
  const __attribute__((address_space(3))) unsigned* bt3=(const __attribute__((address_space(3))) unsigned*)(shm3+LDS_BT)+r32+64*tskip;
  #define BIAS(P0,P1,t) do{ const unsigned w0_=bt3[64*(t)], w1_=bt3[64*(t)+32]; \
    const u32x4 a0_={hi?0u:w0_,0u,0u,0u}, a1_={hi?0u:w1_,0u,0u,0u}; const u32x4 one_={0x3F803F80u,0u,0u,0u}; \
    P0=__builtin_amdgcn_mfma_f32_32x32x16_bf16(__builtin_bit_cast(bf16x8,a0_),__builtin_bit_cast(bf16x8,one_),P0,0,0,0); \
    P1=__builtin_amdgcn_mfma_f32_32x32x16_bf16(__builtin_bit_cast(bf16x8,a1_),__builtin_bit_cast(bf16x8,one_),P1,0,0,0); }while(0)
  DMA_K(0,0);DMA_V(0,0);DMA_K(1,SLOTB);
  bf16x8 qr[4];
  #pragma unroll
  for(int d0=0;d0<4;++d0)qr[d0]=*reinterpret_cast<const bf16x8*>(&Qw[(long)r32*DM+d0*16+hi*8]);
  float mhat=0.f,l_reg=0.f;f32x16 o[2];o[0]=f32x16{};o[1]=f32x16{};f32x16 negm=f32x16{};asm volatile("":"+v"(negm));
  const int qrel=wid*QBLK+r32;
  #define CMASK(P0,P1,t) do{int jb_=(t)-(NT-4); if(jb_>=0)cmask(P0,P1,jb_,qrel,hi);}while(0)
  bool resc=false;
  #define START(P0,P1) do{ const float rm=rowmax(P0,P1); resc=false; \
    { const float dl=rm; mhat=fadd_s(mhat,dl); \
      _Pragma("unroll") for(int r=0;r<16;++r){P0[r]=fsub_s(P0[r],dl);P1[r]=fsub_s(P1[r],dl);} \
      _Pragma("unroll") for(int r=0;r<16;++r)negm[r]=-mhat; asm volatile("":"+v"(negm)); } \
    _Pragma("unroll") for(int r=0;r<16;++r)P0[r]=__builtin_amdgcn_exp2f(P0[r]); }while(0)
  #define RESC() do{ if(resc){ asm volatile("s_waitcnt lgkmcnt(0)":::"memory"); \
      _Pragma("unroll") for(int d_=0;d_<2;++d_) _Pragma("unroll") for(int r=0;r<16;++r)o[d_][r]*=wsf[crow(r,hi)]; } }while(0)
  f32x16 pA0,pA1,pB0,pB1;
  int sl_prev=0,sl_cur=0,sl_next=SLOTB;
  #define ROT() do{sl_prev=sl_cur;sl_cur=sl_next;sl_next=(sl_next==(NSLOT-1)*SLOTB)?0:sl_next+SLOTB;}while(0)
  DMA_K(2,2*SLOTB);
  WAIT_BAR(3);
  qkt(pA0,pA1,Kbase,qr,negm,r32,hi);BIAS(pA0,pA1,0);asm volatile("s_nop 15\n\ts_nop 7":"+v"(pA0),"+v"(pA1));CMASK(pA0,pA1,0);
  START(pA0,pA1);
  _Pragma("unroll") for(int r=0;r<16;++r)pA1[r]=__builtin_amdgcn_exp2f(pA1[r]);
  WAIT_BAR(0);
  DMA_K(3,0);DMA_V(1,SLOTB);
  ROT();
  kload8(kf,kp0+sl_cur);
  WAIT_BAR(2);
  s16x4 vlo[8],vhi[8]; u32x4 pw0,pw1,pw2,pw3;
  #define PKW(P,B) cvtpk_s(P[B],P[B+1])
  #define PAF(k) __builtin_bit_cast(bf16x8,pw##k)
  #define VFR(i) (bf16x8){vlo[i][0],vlo[i][1],vlo[i][2],vlo[i][3],vhi[i][0],vhi[i][1],vhi[i][2],vhi[i][3]}
  #define PIN(x) asm volatile("":"+v"(x))
  #define MX3(a,b,c) __builtin_fmaxf(__builtin_fmaxf((a),(b)),(c))
  #define GAPA(MF,A0,A1,A2,A3,W0,W1,PW) do{ MF; sacc+=A0; sacc+=A1; sacc+=A2; sacc+=A3; PIN(sacc); W0; W1; PIN(PW); SBAR(); }while(0)
  #define EX(v) __builtin_amdgcn_exp2f(v)
  #define GAPB(MF,X,B) do{ MF; X[B]=EX(X[B]); X[B+1]=EX(X[B+1]); X[B+2]=EX(X[B+2]); X[B+3]=EX(X[B+3]); PIN(X); SBAR(); }while(0)
  #define VRD(i) do{ vlo[i]=vtr(vp_+(((i)>>2)*4096+((i)&3)*1024)); vhi[i]=vtr(vp_+(((i)>>2)*4096+((i)&3)*1024+512)); }while(0)
  #define KRD(G,j) do{ if(G){ kload2(kf,kp0+sl_next,j); SBAR(); } }while(0)
  #define STEP(C0,C1,P0,P1,t,GK,GV,GL) do{ SBAR(); \
    const lds_cptr vp_=vp0+sl_prev; \
    VRD(0); SBAR(); float sacc=(P0[0]+P0[1]); \
    GAPA(C0=__builtin_amdgcn_mfma_f32_32x32x16_bf16(kf[0],qr[0],negm,0,0,0), P0[2],P0[3],P0[4],P0[5],     pw0[0]=PKW(P0,0), pw0[1]=PKW(P0,2), pw0); \
    VRD(4); SBAR(); GAPA(C1=__builtin_amdgcn_mfma_f32_32x32x16_bf16(kf[1],qr[0],negm,0,0,0), P0[6],P0[7],P0[8],P0[9],     pw0[2]=PKW(P0,4), pw0[3]=PKW(P0,6), pw0); \
    VRD(1); SBAR(); GAPA(C0=__builtin_amdgcn_mfma_f32_32x32x16_bf16(kf[2],qr[1],C0,0,0,0),   P0[10],P0[11],P0[12],P0[13], pw1[0]=PKW(P0,8), pw1[1]=PKW(P0,10), pw1); \
    VRD(5); SBAR(); GAPA(C1=__builtin_amdgcn_mfma_f32_32x32x16_bf16(kf[3],qr[1],C1,0,0,0),   P0[14],P0[15],P1[0],P1[1],   pw1[2]=PKW(P0,12),pw1[3]=PKW(P0,14), pw1); \
    VRD(2); SBAR(); GAPA(C0=__builtin_amdgcn_mfma_f32_32x32x16_bf16(kf[4],qr[2],C0,0,0,0),   P1[2],P1[3],P1[4],P1[5],     pw2[0]=PKW(P1,0), pw2[1]=PKW(P1,2), pw2); \
    VRD(6); SBAR(); GAPA(C1=__builtin_amdgcn_mfma_f32_32x32x16_bf16(kf[5],qr[2],C1,0,0,0),   P1[6],P1[7],P1[8],P1[9],     pw2[2]=PKW(P1,4), pw2[3]=PKW(P1,6), pw2); \
    VRD(3); SBAR(); GAPA(C0=__builtin_amdgcn_mfma_f32_32x32x16_bf16(kf[6],qr[3],C0,0,0,0),   P1[10],P1[11],P1[12],P1[13], pw3[0]=PKW(P1,8), pw3[1]=PKW(P1,10), pw3); \
    VRD(7); SBAR(); GAPA(C1=__builtin_amdgcn_mfma_f32_32x32x16_bf16(kf[7],qr[3],C1,0,0,0),   P1[14],P1[15],0.f,0.f,       pw3[2]=PKW(P1,12),pw3[3]=PKW(P1,14), pw3); \
    l_reg+=sacc; \
    if(GK){DMA_K((t)+3,sl_cur);} if(GV){DMA_V((t)+1,sl_next);} \
    BIAS(C0,C1,t); CMASK(C0,C1,t); \
    { float a=MX3(C0[0],C0[1],C1[0]),b=MX3(C0[2],C0[3],C1[1]); a=MX3(a,C1[2],C1[3]); \
      _Pragma("unroll") for(int r=4;r<16;r+=4){a=MX3(a,C0[r],C0[r+1]);b=MX3(b,C0[r+2],C0[r+3]);a=MX3(a,C1[r],C1[r+1]);b=MX3(b,C1[r+2],C1[r+3]);} \
      float rm=__builtin_fmaxf(a,b); { auto rr=__builtin_amdgcn_permlane32_swap(__float_as_uint(rm),__float_as_uint(rm),false,false); rm=__builtin_fmaxf(__uint_as_float(rr[0]),__uint_as_float(rr[1])); } \
      resc=false; \
      if(__builtin_expect(__any(rm>(float)THRL),0)){ const float dl=__builtin_fmaxf(rm,0.f); mhat+=dl; \
        _Pragma("unroll") for(int r=0;r<16;++r){C0[r]-=dl;C1[r]-=dl;} \
        _Pragma("unroll") for(int r=0;r<16;++r)negm[r]=-mhat; asm volatile("":"+v"(negm)); \
        const float f=__builtin_amdgcn_exp2f(-dl); l_reg*=f; if(hi==0)wsf[r32]=f; resc=true; } } \
    SBAR(); \
    GAPB(o[0]=__builtin_amdgcn_mfma_f32_32x32x16_bf16(PAF(0),VFR(0),o[0],0,0,0), C0,0); \
    GAPB(o[1]=__builtin_amdgcn_mfma_f32_32x32x16_bf16(PAF(0),VFR(4),o[1],0,0,0), C0,4); \
    KRD(GL,0); GAPB(o[0]=__builtin_amdgcn_mfma_f32_32x32x16_bf16(PAF(1),VFR(1),o[0],0,0,0), C0,8); \
    KRD(GL,1); GAPB(o[1]=__builtin_amdgcn_mfma_f32_32x32x16_bf16(PAF(1),VFR(5),o[1],0,0,0), C0,12); \
    KRD(GL,2); GAPB(o[0]=__builtin_amdgcn_mfma_f32_32x32x16_bf16(PAF(2),VFR(2),o[0],0,0,0), C1,0); \
    KRD(GL,3); GAPB(o[1]=__builtin_amdgcn_mfma_f32_32x32x16_bf16(PAF(2),VFR(6),o[1],0,0,0), C1,4); \
    GAPB(o[0]=__builtin_amdgcn_mfma_f32_32x32x16_bf16(PAF(3),VFR(3),o[0],0,0,0), C1,8); \
    GAPB(o[1]=__builtin_amdgcn_mfma_f32_32x32x16_bf16(PAF(3),VFR(7),o[1],0,0,0), C1,12); \
    }while(0)
  int t=1;
  #undef CMASK
  #define CMASK(P0,P1,t) do{}while(0)
  for(;t+5<NT;t+=2){
    STEP(pB0,pB1,pA0,pA1,t,true,true,true);     WAIT_BAR(2); RESC(); ROT();
    STEP(pA0,pA1,pB0,pB1,t+1,true,true,true);   WAIT_BAR(2); RESC(); ROT();
  }
  #undef CMASK
  #define CMASK(P0,P1,t) do{int jb_=(t)-(NT-4); if(jb_>=0)cmask(P0,P1,jb_,qrel,hi);}while(0)
  #define ENDW(tt) do{ if((tt)+3<NT){WAIT_BAR(2);} else if((tt)+2<NT){WAIT_BAR(1);} else {WAIT_BAR(0);} }while(0)
  for(;t+1<NT;t+=2){
    STEP(pB0,pB1,pA0,pA1,t,(t+3<NT),(t+1<NT),(t+1<NT));       ENDW(t);   RESC(); ROT();
    STEP(pA0,pA1,pB0,pB1,t+1,(t+4<NT),(t+2<NT),(t+2<NT));     ENDW(t+1); RESC(); ROT();
  }
  STEP(pB0,pB1,pA0,pA1,NT-1,false,false,false); RESC();
  { float sacc=pB0[0]+pB0[1]; _Pragma("unroll") for(int r=2;r<16;++r)sacc+=pB0[r]; _Pragma("unroll") for(int r=0;r<16;++r)sacc+=pB1[r]; l_reg+=sacc;
    pw0=(u32x4){PKW(pB0,0),PKW(pB0,2),PKW(pB0,4),PKW(pB0,6)};pw1=(u32x4){PKW(pB0,8),PKW(pB0,10),PKW(pB0,12),PKW(pB0,14)};pw2=(u32x4){PKW(pB1,0),PKW(pB1,2),PKW(pB1,4),PKW(pB1,6)};pw3=(u32x4){PKW(pB1,8),PKW(pB1,10),PKW(pB1,12),PKW(pB1,14)};
    SBAR(); pv(o,vb0+sl_cur,PAF(0),PAF(1),PAF(2),PAF(3)); }
  #undef PKW
  #undef PAF
  #undef VFR
  #undef PIN
  #undef MX3
  #undef GAPA
  #undef GAPB
  #undef EX
  #undef VRD
  #undef KRD
  #undef STEP
  #undef ENDW
  {auto rr=__builtin_amdgcn_permlane32_swap(__float_as_uint(l_reg),__float_as_uint(l_reg),false,false);l_reg=__uint_as_float(rr[0])+__uint_as_float(rr[1]);}
  if(hi==0)wsf[32+r32]=l_reg;asm volatile("s_waitcnt lgkmcnt(0)":::"memory");
  float rli[16];
  #pragma unroll
  for(int r=0;r<16;++r)rli[r]=__builtin_amdgcn_rcpf(wsf[32+crow(r,hi)]);
  bf16*Ow=O+(rowbase+q0+wid*QBLK)*DM+h*D;
  { bf16*stg=(bf16*)(shm+LDS_OST)+wid*2048;
    #pragma unroll
    for(int r=0;r<16;++r){const int orow=crow(r,hi);
      #pragma unroll
      for(int d0=0;d0<2;++d0)stg[orow*64+d0*32+r32]=__float2bfloat16(o[d0][r]*rli[r]);}
    asm volatile("s_waitcnt lgkmcnt(0)":::"memory");
    #pragma unroll
    for(int i=0;i<4;++i){const int row=i*8+(lane>>3),ch=lane&7; const u32x4 v=*(const u32x4*)(stg+row*64+ch*8);
      const u32x4 gz=*(const u32x4*)(GZ+(rowbase+q0+wid*QBLK+row)*VP+h*D+ch*8); u32x4 w;
      #define GM(a,g) cvtpk_s(__uint_as_float((a)<<16)*sigm(__uint_as_float((g)<<16)), __uint_as_float((a)&0xffff0000u)*sigm(__uint_as_float((g)&0xffff0000u)))
      w.x=GM(v.x,gz.x); w.y=GM(v.y,gz.y); w.z=GM(v.z,gz.z); w.w=GM(v.w,gz.w);
      #undef GM
      ATTN_STORE16(Ow+(long)row*DM+ch*8,w);} }
  asm volatile("s_waitcnt lgkmcnt(0)\n\ts_barrier":::"memory");
  #undef DMA_K
  #undef DMA_V
  #undef BIAS
  #undef CMASK
  #undef START
  #undef RESC
  #undef ROT
}
constexpr int ATTN_LDS_BYTES=LDS_BYTES;
#undef SBAR
#undef WAIT_BAR
}
#define GAS __attribute__((address_space(1)))
#define LAS __attribute__((address_space(3)))
typedef unsigned short bf16;
typedef unsigned v4u __attribute__((ext_vector_type(4)));
typedef float f32x4 __attribute__((ext_vector_type(4)));
typedef short bf16x8 __attribute__((ext_vector_type(8)));
typedef GAS unsigned gu32;
typedef GAS unsigned long long gu64;
#define RLX_AGENT __ATOMIC_RELAXED, __HIP_MEMORY_SCOPE_AGENT
#define LDS_WAIT() asm volatile("s_waitcnt lgkmcnt(0)" ::: "memory")
#define VM_WAIT() asm volatile("s_waitcnt vmcnt(0)" ::: "memory")
__device__ __forceinline__ unsigned long long rt() { return __builtin_amdgcn_s_memrealtime(); }
__device__ __forceinline__ unsigned f2bf(float f) { unsigned u = __builtin_bit_cast(unsigned, f); return (u + 0x7fffu + ((u >> 16) & 1u)) >> 16; }
__device__ __forceinline__ unsigned pk2(float lo, float hi) { return f2bf(lo) | (f2bf(hi) << 16); }

#define XB_TMO      128
#define XB_XCNT(j)  (256  + 64 * (j))
#define XB_XSUB(j)  (1280 + 64 * (j))
#define XB_XGEN(j)  (2304 + 64 * (j))
#define XB_TOP      3328
#define XB_TOPGEN   3392
#define XCD_BAR_WORDS 3456
#define XB_SPIN_CAP (1u << 18)

__device__ __forceinline__ unsigned xb_ld(unsigned* p)              { return __hip_atomic_load(p, __ATOMIC_RELAXED, __HIP_MEMORY_SCOPE_AGENT); }
__device__ __forceinline__ unsigned xb_add(unsigned* p, unsigned v) { return __hip_atomic_fetch_add(p, v, __ATOMIC_RELAXED, __HIP_MEMORY_SCOPE_AGENT); }
__device__ __forceinline__ unsigned xb_xcc_id() { return (unsigned)__builtin_amdgcn_s_getreg((3 << 11) | 20) & 0xFu; }
#define XB_SPIN(cond, bar) do { unsigned _sp = 0; while (cond) { __builtin_amdgcn_s_sleep(1); \
    if ((++_sp & 255u) == 0u) { if (xb_ld(&(bar)[XB_TMO])) break; if (_sp > XB_SPIN_CAP) { atomicAdd(&(bar)[XB_TMO], 1u); break; } } } } while (0)

struct XcdBarrier {
    unsigned* bar; unsigned x;
    volatile LAS unsigned* st;
};

__device__ __forceinline__ XcdBarrier xcd_barrier_post(unsigned* bar, volatile LAS unsigned* st) {
    XcdBarrier b; b.bar = bar; b.x = xb_xcc_id(); b.st = st;
    if (threadIdx.x == 0) (void)xb_add(&bar[XB_XCNT(b.x)], 1u);
    return b;
}
__device__ __forceinline__ void xcd_barrier_complete(unsigned* bar, unsigned x, unsigned& nloc, unsigned& nx) {
    const unsigned G = gridDim.x * gridDim.y * gridDim.z;
    unsigned sum, cnt, mine, sp = 0u;
    for (;;) {
        sum = 0u; cnt = 0u; mine = 0u;
#pragma unroll
        for (unsigned j = 0; j < 16; ++j) { const unsigned c = xb_ld(&bar[XB_XCNT(j)]); sum += c; cnt += (c > 0u) ? 1u : 0u; mine = (j == x) ? c : mine; }
        if (sum == G) break;
        __builtin_amdgcn_s_sleep(1);
        if ((++sp & 255u) == 0u) { if (xb_ld(&bar[XB_TMO])) break; if (sp > XB_SPIN_CAP) { atomicAdd(&bar[XB_TMO], 1u); break; } }
    }
    nloc = mine > 0u ? mine : 1u; nx = cnt > 0u ? cnt : 1u;
}

__device__ __forceinline__ void xcd_barrier(const XcdBarrier& b) {
    asm volatile("s_waitcnt vmcnt(0)" ::: "memory");
    __syncthreads();
    if (threadIdx.x == 0) {
        unsigned* bar = b.bar;
        __builtin_amdgcn_s_waitcnt(0);
        unsigned nloc = b.st[0], nx = b.st[1];
        if (nloc == 0u) { xcd_barrier_complete(bar, b.x, nloc, nx); b.st[0] = nloc; b.st[1] = nx; }
        const unsigned old = xb_add(&bar[XB_XSUB(b.x)], 1u);
        const unsigned gen = old / nloc;
        if (old + 1u == (gen + 1u) * nloc) {
            __builtin_amdgcn_fence(__ATOMIC_RELEASE, "agent");
            asm volatile("s_waitcnt vmcnt(0)" ::: "memory");
            const unsigned og = xb_add(&bar[XB_TOP], 1u);
            const unsigned tg = og / nx;
            if (og + 1u == (tg + 1u) * nx) xb_add(&bar[XB_TOPGEN], 1u);
            else XB_SPIN(xb_ld(&bar[XB_TOPGEN]) == tg, bar);
            __builtin_amdgcn_fence(__ATOMIC_ACQUIRE, "agent");
            xb_add(&bar[XB_XGEN(b.x)], 1u);
            asm volatile("s_waitcnt vmcnt(0)" ::: "memory");
        } else {
            XB_SPIN(xb_ld(&bar[XB_XGEN(b.x)]) == gen, bar);
            __builtin_amdgcn_fence(__ATOMIC_ACQUIRE, "agent");
            asm volatile("s_waitcnt vmcnt(0)" ::: "memory");
        }
    }
    __syncthreads();
}
struct Args { const float* in[N_IN]; float* out; unsigned char* ws; int ph_lo, ph_hi, li, pad; };
struct Frame {
    LAS unsigned char* lds; volatile LAS unsigned* MISC; gu32* ctl;
    int tid, lane, wave, vcu, G, bx;
    unsigned char* ws;
};
template <int CTRL> __device__ __forceinline__ float dpp_add(float v) {
    return v + __builtin_bit_cast(float, __builtin_amdgcn_update_dpp(0, __builtin_bit_cast(int, v), CTRL, 0xf, 0xf, true));
}
__device__ __forceinline__ float row16_sum(float v) {
    v = dpp_add<0xB1>(v);
    v = dpp_add<0x4E>(v);
    v = dpp_add<0x141>(v);
    v = dpp_add<0x140>(v);
    return v;
}
__device__ __forceinline__ float bperm(int srclane, float v) { return __builtin_bit_cast(float, __builtin_amdgcn_ds_bpermute(srclane << 2, __builtin_bit_cast(int, v))); }
template <int M> __device__ __forceinline__ float shx(float v) {
    constexpr int ctrl = (M == 1) ? 0xB1 : ((M == 2) ? 0x4E : 0x141);
    return __builtin_bit_cast(float, __builtin_amdgcn_update_dpp(0, __builtin_bit_cast(int, v), ctrl, 0xf, 0xf, true));
}
__device__ __forceinline__ float sum8(float v) { v += shx<1>(v); v += shx<2>(v); v += shx<4>(v); return v; }
__device__ __forceinline__ float rdlane(float v, int l) { return __builtin_bit_cast(float, __builtin_amdgcn_readlane(__builtin_bit_cast(int, v), l)); }
__device__ __forceinline__ float wave_sum(float v) { v = row16_sum(v); return (rdlane(v, 0) + rdlane(v, 16)) + (rdlane(v, 32) + rdlane(v, 48)); }
__device__ __forceinline__ float wave_incl_scan(float v, int lane) {
#pragma unroll
    for (int o = 1; o < 64; o <<= 1) { const float u = bperm((lane - o) & 63, v); if (lane >= o) v += u; }
    return v;
}
__device__ __forceinline__ float wave_incl_max(float v, int lane) {
#pragma unroll
    for (int o = 1; o < 64; o <<= 1) { const float u = bperm((lane - o) & 63, v); if (lane >= o) v = fmaxf(v, u); }
    return v;
}
__device__ __forceinline__ float lo16(unsigned p) { return __builtin_bit_cast(float, p << 16); }
__device__ __forceinline__ float hi16(unsigned p) { return __builtin_bit_cast(float, p & 0xffff0000u); }
__device__ __forceinline__ void unpack8(const v4u p, float (&f)[8]) { f[0] = lo16(p.x); f[1] = hi16(p.x); f[2] = lo16(p.y); f[3] = hi16(p.y); f[4] = lo16(p.z); f[5] = hi16(p.z); f[6] = lo16(p.w); f[7] = hi16(p.w); }
__device__ __forceinline__ unsigned cvtpk(float lo, float hi) { return pg8::cvt_pk_bf16(lo, hi); }
__device__ __forceinline__ v4u pack8(const float (&f)[8]) { v4u o; o.x = cvtpk(f[0], f[1]); o.y = cvtpk(f[2], f[3]); o.z = cvtpk(f[4], f[5]); o.w = cvtpk(f[6], f[7]); return o; }
__device__ __forceinline__ float bf1(const bf16* p) { return __builtin_bit_cast(float, (unsigned)(*p) << 16); }
__device__ __forceinline__ float sigmoidf_(float x) { return __builtin_amdgcn_rcpf(1.f + __builtin_amdgcn_exp2f(-1.4426950408889634f * x)); }
__device__ __forceinline__ float logsigf_(float x) { return fminf(x, 0.f) - log1pf(__expf(-fabsf(x))); }
__device__ __forceinline__ float siluf_(float x) { return x * sigmoidf_(x); }

__device__ __forceinline__ int win_src(int n) { return n < 2048 ? n : (n < 7936 ? n + 8 : (n < 7944 ? n - 5888 : (n < 7960 ? n : -1))); }
template <bool SPREAD = false>
__device__ __forceinline__ void tr_item64(const float* W, int Nsrc, int sc0, bf16* WT, int K, int k0, int drow0, LAS bf16* T, int lane, const float* gk = nullptr) {
    const int kr = lane >> 4, c4 = lane & 15;
    f32x4 v[16];
#pragma unroll
    for (int j = 0; j < 16; ++j) v[j] = *(const f32x4*)(W + (size_t)(k0 + 4 * j + kr) * Nsrc + sc0 + 4 * c4);
    if (gk) {
#pragma unroll
        for (int j = 0; j < 16; ++j) v[j] = v[j] * gk[k0 + 4 * j + kr]; }
#pragma unroll
    for (int j = 0; j < 16; ++j) { const unsigned p0 = cvtpk(v[j][0], v[j][1]), p1 = cvtpk(v[j][2], v[j][3]); const int kk = 4 * j + kr;
        const int col = ((((kk >> 3) ^ (c4 >> 1)) & 7) << 3) + (kk & 7);
        T[(4 * c4 + 0) * LDT + col] = (bf16)(p0 & 0xffffu); T[(4 * c4 + 1) * LDT + col] = (bf16)(p0 >> 16); T[(4 * c4 + 2) * LDT + col] = (bf16)(p1 & 0xffffu); T[(4 * c4 + 3) * LDT + col] = (bf16)(p1 >> 16); }
    LDS_WAIT(); asm volatile("" ::: "memory");
#pragma unroll
    for (int p = 0; p < 8; ++p) { const int n = (lane >> 3) + 8 * p, kc = lane & 7; const int dr = SPREAD ? 8 * (n >> 2) + (n & 3) : n; *(GAS v4u*)(WT + (size_t)(drow0 + dr) * K + k0 + 8 * kc) = *(const LAS v4u*)(T + n * LDT + (((kc ^ (n >> 3)) & 7) << 3)); }
    LDS_WAIT(); asm volatile("" ::: "memory");
}
__device__ __forceinline__ void tr_item64_win_special(const float* W, bf16* WT, int k0, LAS bf16* T, int lane, const float* gk) {
    const int sc = win_src(7936 + lane);
    for (int kk = 0; kk < 64; ++kk) T[lane * LDT + kk] = (bf16)f2bf(sc >= 0 ? gk[k0 + kk] * W[(size_t)(k0 + kk) * 7960 + sc] : 0.f);
    LDS_WAIT(); asm volatile("" ::: "memory");
#pragma unroll
    for (int p = 0; p < 8; ++p) { const int n = (lane >> 3) + 8 * p, kc = lane & 7; *(GAS v4u*)(WT + (size_t)(7936 + n) * DM + k0 + 8 * kc) = *(const LAS v4u*)(T + n * LDT + 8 * kc); }
    LDS_WAIT(); asm volatile("" ::: "memory");
}
template <class InT> __device__ __forceinline__ void p0_prologue(Frame& F, const InT& in) {
    LAS bf16* T = (LAS bf16*)(F.lds + RING_OFF + F.wave * 16384);
    const int gw = F.vcu * NWAVES + F.wave, NGW = F.G * NWAVES, lane = F.lane;
    constexpr int I_13 = (DM / 64) * (2 * DFF / 64), I_2 = (DFF / 64) * (DM / 64), I_IN = (DM / 64) * (ZW / 64), I_G = (DM / 64) * (4 * DM / 64), I_B = 4 * (MW / 64) * (DM / 64), I_O = (DM / 64) * (DM / 64);
    constexpr int I_LR = 32;
    constexpr int PER_L = 2 * (I_13 + I_2) + I_IN + I_G + I_B + I_O + I_LR;
    for (int it = gw; it < DEPTH * PER_L; it += NGW) {
        const int l = it / PER_L; int r = it % PER_L;
        unsigned char* wl = F.ws + WS_W + (size_t)l * WL_BYTES;
        if (r < 2 * (I_13 + I_2)) {
            const int ffn = r / (I_13 + I_2); r %= (I_13 + I_2);
            if (r < I_13) { const int kblk = DM / 64, kb = r % kblk, nb = r / kblk, n0 = nb * 64, tile = n0 >> 8, within = n0 & 255;
                const float* w = in[within < 128 ? (ffn ? I_F2W1 : I_F1W1) : (ffn ? I_F2W3 : I_F1W3)] + (size_t)l * DM * DFF;
                tr_item64(w, DFF, tile * 128 + (within & 127), (bf16*)(wl + (ffn ? WL_W13B : WL_W13A)), DM, kb * 64, n0, T, lane, in[ffn ? I_F2N : I_F1N] + (size_t)l * DM); }
            else { r -= I_13; const int kblk = DFF / 64, kb = r % kblk, nb = r / kblk; tr_item64(in[ffn ? I_F2W2 : I_F1W2] + (size_t)l * DFF * DM, DM, nb * 64, (bf16*)(wl + (ffn ? WL_W2B : WL_W2A)), DFF, kb * 64, nb * 64, T, lane); }
            continue; }
        r -= 2 * (I_13 + I_2);
        if (r < I_IN) { const int kblk = DM / 64, kb = r % kblk, nb = r / kblk, n0 = nb * 64; const float* w = in[I_WIN] + (size_t)l * DM * 7960;
            if (n0 < 7936) tr_item64(w, 7960, n0 < 2048 ? n0 : n0 + 8, (bf16*)(wl + WL_WIN), DM, kb * 64, n0, T, lane, in[I_MIXN] + (size_t)l * DM);
            else if (n0 == 7936) tr_item64_win_special(w, (bf16*)(wl + WL_WIN), kb * 64, T, lane, in[I_MIXN] + (size_t)l * DM);
            else { const v4u z = {0u, 0u, 0u, 0u};
#pragma unroll
                for (int p = 0; p < 8; ++p) { const int n = (lane >> 3) + 8 * p, kc = lane & 7; *(GAS v4u*)((bf16*)(wl + WL_WIN) + (size_t)(n0 + n) * DM + kb * 64 + 8 * kc) = z; } }
            continue; }
        r -= I_IN;
        if (r < I_G) { const int kblk = DM / 64, kb = r % kblk, nb = r / kblk, gn = nb >> 5, gt = nb & 31;
            tr_item64<true>(in[I_WG] + (size_t)l * DM * 4 * DM, 4 * DM, nb * 64, (bf16*)(wl + WL_WG), DM, kb * 64, 256 * gt + 128 * (gn >> 1) + 4 * (gn & 1), T, lane, in[I_MIXN] + (size_t)l * DM); continue; }
        r -= I_G;
        if (r < I_B) { const int per = (MW / 64) * (DM / 64), n = r / per; r %= per; const int kblk = MW / 64, kb = r % kblk, nb = r / kblk;
            tr_item64(in[I_WB] + ((size_t)l * 4 + n) * MW * DM, DM, nb * 64, (bf16*)(wl + WL_WB) + (size_t)n * DM * MW, MW, kb * 64, nb * 64, T, lane); continue; }
        r -= I_B;
        if (r < I_O) { const int kblk = DM / 64, kb = r % kblk, nb = r / kblk; tr_item64(in[I_WO] + (size_t)l * DM * DM, DM, nb * 64, (bf16*)(wl + WL_WO), DM, kb * 64, nb * 64, T, lane); continue; }
        r -= I_O;
        { bf16* lr = (bf16*)(F.ws + WS_LORA) + (size_t)l * 131072;
          if (r < 8) tr_item64(in[I_RW2] + (size_t)l * 64 * MW, MW, r * 64, lr, 64, 0, r * 64, T, lane);
          else if (r < 16) tr_item64(in[I_RA2] + (size_t)l * 64 * MW, MW, (r - 8) * 64, lr + 32768, 64, 0, (r - 8) * 64, T, lane);
          else { const int q = r - 16; tr_item64(in[I_RG2] + (size_t)l * 128 * MW, MW, (q >> 1) * 64, lr + 65536, 128, (q & 1) * 64, (q >> 1) * 64, T, lane); } }
    }
}
__device__ __forceinline__ void xin_phase(Frame& F, const float* x, bf16* xb, float* ssp) {
    const int gw = F.vcu * NWAVES + F.wave, NGW = F.G * NWAVES;
    for (int m = gw; m < SEQ; m += NGW) {
        const GAS f32x4* xr = (const GAS f32x4*)(x + (size_t)m * DM) + F.lane; f32x4 v[8]; float s = 0.f;
#pragma unroll
        for (int j = 0; j < 8; ++j) { v[j] = xr[64 * j]; s += (v[j].x * v[j].x + v[j].y * v[j].y) + (v[j].z * v[j].z + v[j].w * v[j].w); }
        s = wave_sum(s); if (F.lane < 8) ssp[(size_t)F.lane * SEQ + m] = (F.lane == 0) ? s : 0.f;
        GAS unsigned long long* o8 = (GAS unsigned long long*)(xb + (size_t)m * DM) + F.lane;
#pragma unroll
        for (int j = 0; j < 8; ++j) o8[64 * j] = (unsigned long long)cvtpk(v[j].x, v[j].y) | ((unsigned long long)cvtpk(v[j].z, v[j].w) << 32);
    }
}
struct PrepP {
    const bf16* Z; const int* pos; const bf16 *w2t, *a2t, *g2t;
    const float *fox_fb, *fox_qg, *fox_kg, *mu, *w0, *w2, *a0, *a2, *g2, *k_k, *k_a, *r_k, *conv_w, *conv_b, *mib, *mfb;
    bf16 *FQ, *FK, *RQ, *RK, *MQ, *MK, *RG, *FV, *FO, *TV, *TG, *MV, *MO; float *RW, *RBON, *FP, *FT, *MBC, *MA, *MAX, *MBL;
};
__device__ __forceinline__ void prep_phase(Frame& F, const PrepP& P, int pmask) {
    const int gw = F.vcu * NWAVES + F.wave, NGW = F.G * NWAVES, lane = F.lane;
    if (pmask & 1) for (int it = gw; it < 128 * NH; it += NGW) {
        const int j = it >> 3, h = it & 7, t = 64 * j + lane; const bf16* zr = P.Z + (size_t)t * ZW;
        const float lf = logsigf_(bf1(zr + ZC_FF + h) + P.fox_fb[h]);
        const float inc = wave_incl_scan(lf, lane);
        P.FP[h * SEQ + t] = inc; if (lane == 63) P.FT[h * 128 + j] = inc;
        const float li = bf1(zr + ZC_MI + h) + P.mib[h];
        const float lfm = logsigf_(bf1(zr + ZC_MF + h) + P.mfb[h]);
        const float bc = wave_incl_scan(lfm, lane);
        P.MBC[h * SEQ + t] = bc; P.MA[h * SEQ + t] = li - bc;
        const float amax = wave_incl_max(li - bc, lane); if (lane == 63) { P.MAX[h * 128 + j] = amax; P.MBL[h * 128 + j] = bc; }
    }
    if (pmask & 2) {
        const int o8 = 8 * (lane & 7);
        float qg[8], kg[8], ifr[8];
#pragma unroll
        for (int i = 0; i < 8; ++i) { qg[i] = P.fox_qg[o8 + i] * (0.125f * 1.4426950408889634f); kg[i] = P.fox_kg[o8 + i];
            const int f = (o8 + i) & 31; ifr[i] = powf(10000.f, -(float)(2 * f) / 64.f); }
        const bool first = (lane & 7) < 4;
        for (int t = gw; t < SEQ; t += NGW) {
            const bf16* zr = P.Z + (size_t)t * ZW;
            {
                float q[8], k[8]; unpack8(*(const v4u*)(zr + ZC_FQ + 8 * lane), q); unpack8(*(const v4u*)(zr + ZC_FK + 8 * lane), k);
                float sq = 0.f, sk = 0.f;
#pragma unroll
                for (int i = 0; i < 8; ++i) { sq += q[i] * q[i]; sk += k[i] * k[i]; }
                sq += shx<1>(sq); sk += shx<1>(sk); sq += shx<2>(sq); sk += shx<2>(sk); sq += shx<4>(sq); sk += shx<4>(sk);
                const float rq = __builtin_amdgcn_rsqf(sq * (1.f / 64.f) + 1e-6f), rk = __builtin_amdgcn_rsqf(sk * (1.f / 64.f) + 1e-6f);
#pragma unroll
                for (int i = 0; i < 8; ++i) { q[i] = q[i] * rq * qg[i]; k[i] = k[i] * rk * kg[i]; }
                *(v4u*)(P.FQ + (size_t)t * MW + 8 * lane) = pack8(q); *(v4u*)(P.FK + (size_t)t * MW + 8 * lane) = pack8(k);
            }
            {
                const float pf = (float)P.pos[t];
                float cs[8], sn[8];
#pragma unroll
                for (int i = 0; i < 8; ++i) { const float ang = pf * ifr[i]; const double rev = (double)ang * 0.15915494309189535; const float fr = (float)(rev - rint(rev));
                    sn[i] = __builtin_amdgcn_sinf(fr); cs[i] = __builtin_amdgcn_cosf(fr); }
                float q[8], k[8], qo[8], ko[8]; unpack8(*(const v4u*)(zr + ZC_TQ + 8 * lane), q); unpack8(*(const v4u*)(zr + ZC_TK + 8 * lane), k);
#pragma unroll
                for (int i = 0; i < 8; ++i) { const float qp = bperm(lane ^ 4, q[i]), kp = bperm(lane ^ 4, k[i]);
                    qo[i] = first ? (q[i] * cs[i] - qp * sn[i]) : (qp * sn[i] + q[i] * cs[i]);
                    ko[i] = 0.125f * (first ? (k[i] * cs[i] - kp * sn[i]) : (kp * sn[i] + k[i] * cs[i])); }
                *(v4u*)(P.RQ + (size_t)t * MW + 8 * lane) = pack8(qo); *(v4u*)(P.RK + (size_t)t * MW + 8 * lane) = pack8(ko);
            }
#pragma unroll
            for (int p = 0; p < 2; ++p) {
                const int ch = 512 * p + 8 * lane; float acc[8];
#pragma unroll
                for (int i = 0; i < 8; ++i) acc[i] = P.conv_b[ch + i];
#pragma unroll
                for (int j = 0; j < 4; ++j) { const int tt = t - 3 + j; if (tt >= 0) { float x[8]; unpack8(*(const v4u*)(P.Z + (size_t)tt * ZW + ZC_MQK + ch), x);
#pragma unroll
                        for (int i = 0; i < 8; ++i) acc[i] += P.conv_w[j * 1024 + ch + i] * x[i]; } }
#pragma unroll
                for (int i = 0; i < 8; ++i) acc[i] = siluf_(acc[i]) * (p ? 0.125f : 1.f);
                *(v4u*)((p ? P.MK : P.MQ) + (size_t)t * MW + 8 * lane) = pack8(acc);
            }
        }
    }
    if (pmask & 4) {
        constexpr int XS = 264, OS = 520;
        LAS bf16* Xb = (LAS bf16*)(F.lds + RING_OFF); LAS bf16* OW = Xb + 32 * XS; LAS bf16* OA = OW + 32 * OS; LAS bf16* OG = OA + 32 * OS;
        const int hh = lane >> 3, c0 = 8 * lane, wave = F.wave;
        {
            const int tb = gw, t0 = 4 * tb;
            if (lane < 32) {
                float m8[8];
#pragma unroll
                for (int i = 0; i < 8; ++i) m8[i] = P.mu[1536 + 8 * lane + i];
                float prev[8];
                if (t0 > 0) unpack8(*(const v4u*)(P.Z + (size_t)(t0 - 1) * ZW + ZC_RL + 8 * lane), prev);
                else {
#pragma unroll
                    for (int i = 0; i < 8; ++i) prev[i] = 0.f; }
#pragma unroll
                for (int tk = 0; tk < 4; ++tk) { float cur[8], xv[8]; unpack8(*(const v4u*)(P.Z + (size_t)(t0 + tk) * ZW + ZC_RL + 8 * lane), cur);
#pragma unroll
                    for (int i = 0; i < 8; ++i) { float v = cur[i] + m8[i] * (prev[i] - cur[i]); v = (lane < 8) ? tanhf(v) : ((lane < 16) ? v : sigmoidf_(v)); xv[i] = v; prev[i] = cur[i]; }
                    *(LAS v4u*)(Xb + (4 * wave + tk) * XS + 8 * lane) = pack8(xv); }
            }
            __syncthreads();
            {
                typedef float f32x16_t __attribute__((ext_vector_type(16)));
                const int n = lane & 31, h = lane >> 5;
#pragma unroll
                for (int mat = 0; mat < 3; ++mat) { const int K = (mat == 2) ? 128 : 64, koff = (mat == 0) ? 0 : ((mat == 1) ? 64 : 128); const bf16* wt = (mat == 0) ? P.w2t : ((mat == 1) ? P.a2t : P.g2t); LAS bf16* O = (mat == 0) ? OW : ((mat == 1) ? OA : OG);
#pragma unroll
                    for (int ct = 0; ct < 2; ++ct) { f32x16_t acc = {0.f, 0.f, 0.f, 0.f, 0.f, 0.f, 0.f, 0.f, 0.f, 0.f, 0.f, 0.f, 0.f, 0.f, 0.f, 0.f};
                        const bf16* wrow = wt + (size_t)(64 * wave + 32 * ct + n) * K + 8 * h;
#pragma unroll
                        for (int ks = 0; ks < ((mat == 2) ? 8 : 4); ++ks) { const bf16x8 a = *(const LAS bf16x8*)(Xb + n * XS + koff + 16 * ks + 8 * h), b = *(const bf16x8*)(wrow + 16 * ks);
                            acc = __builtin_amdgcn_mfma_f32_32x32x16_bf16(a, b, acc, 0, 0, 0); }
#pragma unroll
                        for (int r_ = 0; r_ < 16; ++r_) O[((r_ & 3) + 8 * (r_ >> 2) + 4 * h) * OS + 64 * wave + 32 * ct + n] = (bf16)f2bf(acc[r_]); } }
            }
            __syncthreads();
            float aw[4][8], aa[4][8];
#pragma unroll
            for (int tk = 0; tk < 4; ++tk) { unpack8(*(const LAS v4u*)(OW + (4 * wave + tk) * OS + c0), aw[tk]); unpack8(*(const LAS v4u*)(OA + (4 * wave + tk) * OS + c0), aa[tk]); }
            float pr[8], pk[8], pv[8];
            if (t0 > 0) { const bf16* zp = P.Z + (size_t)(t0 - 1) * ZW; unpack8(*(const v4u*)(zp + ZC_RR + c0), pr); unpack8(*(const v4u*)(zp + ZC_RK + c0), pk); unpack8(*(const v4u*)(zp + ZC_RV + c0), pv); }
            else {
#pragma unroll
                for (int i = 0; i < 8; ++i) { pr[i] = 0.f; pk[i] = 0.f; pv[i] = 0.f; } }
#pragma unroll
            for (int tk = 0; tk < 4; ++tk) {
                asm volatile("" ::: "memory");
                const int t = t0 + tk; const bf16* zc = P.Z + (size_t)t * ZW;
                unsigned char* recb = (unsigned char*)(P.RW + ((size_t)hh * SEQ + t) * RREC) + 16 * (lane & 7);
                float r[8], k[8];
                { float cr[8], cv[8], v[8]; unpack8(*(const v4u*)(zc + ZC_RR + c0), cr); unpack8(*(const v4u*)(zc + ZC_RV + c0), cv);
#pragma unroll
                  for (int i = 0; i < 8; ++i) { r[i] = cr[i] + P.mu[c0 + i] * (pr[i] - cr[i]); v[i] = cv[i] + P.mu[1024 + c0 + i] * (pv[i] - cv[i]); pr[i] = cr[i]; pv[i] = cv[i]; }
                  *(v4u*)(recb + 512) = pack8(v); }
                { float w[8], wr[8];
#pragma unroll
                  for (int i = 0; i < 8; ++i) { const float u = P.w0[c0 + i] + aw[tk][i]; w[i] = -0.6065306597126334f * sigmoidf_(u); wr[i] = r[i]; }
                  float* lwp = (float*)(recb + 640 + 16 * (lane & 7)); *(f32x4*)lwp = (f32x4){w[0], w[1], w[2], w[3]}; *(f32x4*)(lwp + 4) = (f32x4){w[4], w[5], w[6], w[7]};
                  *(v4u*)(recb + 384) = pack8(wr); }
                { float ck[8]; unpack8(*(const v4u*)(zc + ZC_RK + c0), ck);
#pragma unroll
                  for (int i = 0; i < 8; ++i) { k[i] = ck[i] + P.mu[512 + c0 + i] * (pk[i] - ck[i]); pk[i] = ck[i]; } }
                float a[8], kk[8]; float ss = 0.f;
#pragma unroll
                for (int i = 0; i < 8; ++i) { a[i] = sigmoidf_(P.a0[c0 + i] + aa[tk][i]); kk[i] = k[i] * P.k_k[c0 + i]; ss += kk[i] * kk[i]; }
                ss += shx<1>(ss); ss += shx<2>(ss); ss += shx<4>(ss);
                const float rn = __builtin_amdgcn_rsqf(fmaxf(ss, 1e-12f));
                float c1 = 0.f, c2 = 0.f, bo = 0.f; float kp[8], b[8];
#pragma unroll
                for (int i = 0; i < 8; ++i) { kk[i] *= rn; kp[i] = k[i] * (1.f + (a[i] - 1.f) * P.k_a[c0 + i]); b[i] = kk[i] * a[i]; c1 += b[i] * r[i]; c2 += kp[i] * r[i]; bo += r[i] * kp[i] * P.r_k[c0 + i]; }
                c1 += shx<1>(c1); c2 += shx<1>(c2); bo += shx<1>(bo); c1 += shx<2>(c1); c2 += shx<2>(c2); bo += shx<2>(bo); c1 += shx<4>(c1); c2 += shx<4>(c2); bo += shx<4>(bo);
                *(v4u*)(recb) = pack8(kk); *(v4u*)(recb + 128) = pack8(b); *(v4u*)(recb + 256) = pack8(kp);
                if ((lane & 7) == 0) P.RBON[t * 8 + hh] = bo;
            }
#pragma unroll
            for (int tk = 0; tk < 4; ++tk) *(v4u*)(P.RG + (size_t)(t0 + tk) * MW + c0) = *(const LAS v4u*)(OG + (4 * wave + tk) * OS + c0);
            __syncthreads();
        }
    }
}
constexpr int SC_STEPS = 32, SC_BUF = SC_STEPS * RREC * 4;
__device__ __forceinline__ void rwkv_scan_role(Frame& F, const float* RW, float* YRAW, int head, int quarter) {
    const int tid = F.tid, lane = F.lane, j16 = lane & 15, rr = lane >> 4;
    const int row = 16 * quarter + 4 * (F.wave & 3) + rr;
    const bool active = F.wave < 4;
    const float* src = RW + (size_t)head * SEQ * RREC;
    LAS unsigned char* buf0 = F.lds + RING_OFF;
    constexpr int NPIECE = SC_BUF / 16, NIT = (NPIECE + 511) / 512;
    f32x4 st[NIT];
#pragma unroll
    for (int i = 0; i < NIT; ++i) { const int p = tid + 512 * i; if (p < NPIECE) *(LAS f32x4*)(buf0 + 16 * p) = *(const f32x4*)(src + 4 * p); }
    __syncthreads();
    float s0 = 0.f, s1 = 0.f, s2 = 0.f, s3 = 0.f, ybuf = 0.f;
    constexpr int NCH = SEQ / SC_STEPS;
    for (int c = 0; c < NCH; ++c) {
        const LAS unsigned char* cur = buf0 + (c & 1) * SC_BUF; LAS unsigned char* nxt = buf0 + ((c + 1) & 1) * SC_BUF;
        if (c + 1 < NCH) {
#pragma unroll
            for (int i = 0; i < NIT; ++i) { const int p = tid + 512 * i; if (p < NPIECE) st[i] = *(const f32x4*)(src + (size_t)(c + 1) * (SC_BUF / 4) + 4 * p); }
        }
        if (active) {
        const LAS unsigned char* rp = cur + 16 * j16;
        f32x4 kk = *(const LAS f32x4*)(rp), bb = *(const LAS f32x4*)(rp + 256), ww = *(const LAS f32x4*)(rp + 512), kp = *(const LAS f32x4*)(rp + 768), wr = *(const LAS f32x4*)(rp + 1024);
        float vv = *(const LAS float*)(cur + 1280 + 4 * row); float c1 = *(const LAS float*)(cur + 1536), c2 = *(const LAS float*)(cur + 1540);
#pragma unroll 4
        for (int s = 0; s < SC_STEPS; ++s) {
            const LAS unsigned char* np_ = cur + ((s + 1) & (SC_STEPS - 1)) * (RREC * 4) + 16 * j16; const LAS unsigned char* nb_ = cur + ((s + 1) & (SC_STEPS - 1)) * (RREC * 4);
            const f32x4 nkk = *(const LAS f32x4*)(np_), nbb = *(const LAS f32x4*)(np_ + 256), nww = *(const LAS f32x4*)(np_ + 512), nkp = *(const LAS f32x4*)(np_ + 768), nwr = *(const LAS f32x4*)(np_ + 1024);
            const float nvv = *(const LAS float*)(nb_ + 1280 + 4 * row), nc1 = *(const LAS float*)(nb_ + 1536), nc2 = *(const LAS float*)(nb_ + 1540);
            float d1 = s0 * kk[0] + s1 * kk[1] + (s2 * kk[2] + s3 * kk[3]);
            float d2 = s0 * wr[0] + s1 * wr[1] + (s2 * wr[2] + s3 * wr[3]);
            d1 = row16_sum(d1); d2 = row16_sum(d2);
            const float sa = -d1;
            s0 = fmaf(sa, bb[0], fmaf(s0, ww[0], vv * kp[0])); s1 = fmaf(sa, bb[1], fmaf(s1, ww[1], vv * kp[1]));
            s2 = fmaf(sa, bb[2], fmaf(s2, ww[2], vv * kp[2])); s3 = fmaf(sa, bb[3], fmaf(s3, ww[3], vv * kp[3]));
            const float y = d2 + sa * c1 + vv * c2;
            ybuf = (j16 == (s & 15)) ? y : ybuf;
            if ((s & 15) == 15) YRAW[(size_t)(c * SC_STEPS + (s & ~15) + j16) * MW + head * 64 + row] = ybuf;
            kk = nkk; bb = nbb; ww = nww; kp = nkp; wr = nwr; vv = nvv; c1 = nc1; c2 = nc2;
        }
        }
        if (c + 1 < NCH) {
#pragma unroll
            for (int i = 0; i < NIT; ++i) { const int p = tid + 512 * i; if (p < NPIECE) *(LAS f32x4*)(nxt + 16 * p) = st[i]; }
        }
        __syncthreads();
    }
}
constexpr int CK_TILE = 64 * LDT * 2;
constexpr int CK_Q = 0, CK_K = 2 * CK_TILE, CK_VT = 4 * CK_TILE, CK_KT = 6 * CK_TILE, CK_S = 8 * CK_TILE, CK_STB = 9 * CK_TILE, CK_OF = 10 * CK_TILE, CK_G = CK_OF + 64 * 68 * 4, CK_NV = CK_G + 2 * 1280, CK_END = CK_NV + 512;
__device__ __forceinline__ f32x4 mma64(f32x4 acc, const LAS bf16* A, const LAS bf16* B, int fr, int fq) {
#pragma unroll
    for (int ks = 0; ks < 2; ++ks) { const bf16x8 a = *(const LAS bf16x8*)(A + fr * LDT + ks * 32 + fq * 8), b = *(const LAS bf16x8*)(B + fr * LDT + ks * 32 + fq * 8);
        acc = __builtin_amdgcn_mfma_f32_16x16x32_bf16(a, b, acc, 0, 0, 0); }
    return acc;
}
__device__ __forceinline__ int swz(int row, int chunk) { return row * LDT + ((chunk ^ ((row >> 3) & 7)) << 3); }
template <bool SA, bool SB> __device__ __forceinline__ f32x4 mma64s(f32x4 acc, const LAS bf16* A, int ra, const LAS bf16* B, int rbw, int fr, int fq) {
#pragma unroll
    for (int ks = 0; ks < 2; ++ks) { const int ch = ks * 4 + fq;
        const bf16x8 a = *(const LAS bf16x8*)(A + (SA ? swz(ra + fr, ch) : (ra + fr) * LDT + ch * 8)), b = *(const LAS bf16x8*)(B + (SB ? swz(rbw + fr, ch) : (rbw + fr) * LDT + ch * 8));
        acc = __builtin_amdgcn_mfma_f32_16x16x32_bf16(a, b, acc, 0, 0, 0); }
    return acc;
}
template <int MODE> __device__ __forceinline__ void chunk_role(Frame& F, const bf16* Qp, const bf16* Kp, const bf16* Vp, const bf16* Gp, const float* gain, bf16* Y, int head, const float* MBC, const float* MA) {
    const int tid = F.tid, lane = F.lane, wave = F.wave, row = tid >> 3, seg = tid & 7, rb = wave >> 1, cb0 = 2 * (wave & 1), fr = lane & 15, fq = lane >> 4;
    LAS unsigned char* L = F.lds + RING_OFF;
    LAS bf16* Ss = (LAS bf16*)(L + CK_S); LAS bf16* STb = (LAS bf16*)(L + CK_STB); LAS float* Of = (LAS float*)(L + CK_OF); LAS float* NV = (LAS float*)(L + CK_NV);
    const float log2g = (MODE == 0) ? log2f(1.f - exp2f(-5.f - (float)head)) : 0.f;
    for (int i = tid; i < 64 * LDT / 2; i += 512) ((LAS unsigned*)STb)[i] = 0u;
    if (tid < 128) NV[tid] = 0.f;
    if (MODE == 0 && tid < 128) { LAS float* G = (LAS float*)(L + CK_G) + (tid >> 6) * 320; G[192 + (tid & 63)] = exp2f((float)(63 - (tid & 63)) * log2g); }
    f32x4 st0 = {0.f, 0.f, 0.f, 0.f}, st1 = {0.f, 0.f, 0.f, 0.f};
    const size_t gofs = (size_t)head * 64 + 8 * seg;
    v4u q8, k8, v8, g8;
    { const size_t t = row; q8 = *(const v4u*)(Qp + t * MW + gofs); k8 = *(const v4u*)(Kp + t * MW + gofs); v8 = *(const v4u*)(Vp + t * ZW + gofs); g8 = *(const v4u*)(Gp + t * ZW + gofs); }
    float gn[8];
#pragma unroll
    for (int i = 0; i < 8; ++i) gn[i] = gain[gofs + i];
    float a_n = 0.f, bc_n = 0.f;
    if (MODE == 1 && wave == 0) { a_n = MA[(size_t)head * SEQ + lane]; bc_n = MBC[(size_t)head * SEQ + lane]; }
    for (int c = 0; c < 128; ++c) {
        const int bsel = c & 1;
        { LAS bf16* Qs = (LAS bf16*)(L + CK_Q + bsel * CK_TILE); LAS bf16* Ks = (LAS bf16*)(L + CK_K + bsel * CK_TILE); LAS bf16* VT = (LAS bf16*)(L + CK_VT + bsel * CK_TILE); LAS bf16* KT = (LAS bf16*)(L + CK_KT + bsel * CK_TILE);
          *(LAS v4u*)(Qs + row * LDT + 8 * seg) = q8; *(LAS v4u*)(Ks + row * LDT + 8 * seg) = k8;
          const unsigned kw[4] = {k8.x, k8.y, k8.z, k8.w}, vw[4] = {v8.x, v8.y, v8.z, v8.w};
#pragma unroll
          for (int i = 0; i < 4; ++i) { const int c_ = ((((row >> 3) ^ seg) & 7) << 3) + (row & 7), r0 = (8 * seg + 2 * i) * LDT + c_, r1 = r0 + LDT;
              KT[r0] = (bf16)(kw[i] & 0xffffu); KT[r1] = (bf16)(kw[i] >> 16); VT[r0] = (bf16)(vw[i] & 0xffffu); VT[r1] = (bf16)(vw[i] >> 16); }
          if (MODE == 1 && wave == 0) { LAS float* G = (LAS float*)(L + CK_G) + bsel * 320; const LAS float* Gp_ = (const LAS float*)(L + CK_G) + (bsel ^ 1) * 320;
              const float a = a_n, bc = bc_n; if (c + 1 < 128) { a_n = MA[(size_t)head * SEQ + 64 * (c + 1) + lane]; bc_n = MBC[(size_t)head * SEQ + 64 * (c + 1) + lane]; }
              const float mp = (c == 0) ? 0.f : Gp_[256];
              const float Mi = fmaxf(mp, wave_incl_max(a, lane)); const float M63 = rdlane(Mi, 63);
              G[lane] = a; G[64 + lane] = Mi; G[128 + lane] = bc; G[192 + lane] = __expf(a - M63);
              if (lane == 63) { G[256] = bc + Mi; G[257] = mp; } }
        }
        const v4u gcur = g8;
        if (c + 1 < 128) { const size_t t = (size_t)64 * (c + 1) + row; q8 = *(const v4u*)(Qp + t * MW + gofs); k8 = *(const v4u*)(Kp + t * MW + gofs); v8 = *(const v4u*)(Vp + t * ZW + gofs); g8 = *(const v4u*)(Gp + t * ZW + gofs); }
        asm volatile("s_waitcnt lgkmcnt(0)\n\ts_barrier" ::: "memory");
        const LAS bf16* Qs = (const LAS bf16*)(L + CK_Q + bsel * CK_TILE); const LAS bf16* Ks = (const LAS bf16*)(L + CK_K + bsel * CK_TILE); const LAS bf16* VT = (const LAS bf16*)(L + CK_VT + bsel * CK_TILE); const LAS bf16* KT = (const LAS bf16*)(L + CK_KT + bsel * CK_TILE);
        const LAS float* G = (const LAS float*)(L + CK_G) + bsel * 320;
        const float mp = (MODE == 1) ? G[257] : 0.f;
        f32x4 o0, o1;
        {
            const f32x4 z4 = {0.f, 0.f, 0.f, 0.f};
#pragma unroll
            for (int ct = 0; ct < 2; ++ct) { const int cb = cb0 + ct; f32x4 sc = mma64(z4, Qs + 16 * rb * LDT, Ks + 16 * cb * LDT, fr, fq);
                const int j = 16 * cb + fr; const float aj = (MODE == 1) ? G[j] : 0.f;
#pragma unroll
                for (int e = 0; e < 4; ++e) { const int i = 16 * rb + 4 * fq + e; float d;
                    if (MODE == 0) d = exp2f((float)(i > j ? i - j : j - i) * log2g); else d = (j <= i) ? __expf(aj - G[64 + i]) : 0.f;
                    Ss[i * LDT + j] = (bf16)f2bf(sc[e] * d); } }
            o0 = mma64(z4, Qs + 16 * rb * LDT, STb + 16 * cb0 * LDT, fr, fq); o1 = mma64(z4, Qs + 16 * rb * LDT, STb + 16 * (cb0 + 1) * LDT, fr, fq);
#pragma unroll
            for (int e = 0; e < 4; ++e) { const int i = 16 * rb + 4 * fq + e; const float sc = (MODE == 0) ? exp2f((float)(i + 1) * log2g) : __expf(mp - G[64 + i]); o0[e] *= sc; o1[e] *= sc; }
            const float dec = (MODE == 0) ? exp2f(64.f * log2g) : __expf(mp - G[64 + 63]);
            st0 *= dec; st1 *= dec;
#pragma unroll
            for (int ks = 0; ks < 2; ++ks) { float a8[8]; unpack8(*(const LAS v4u*)(VT + swz(16 * rb + fr, ks * 4 + fq)), a8);
                const f32x4 w0 = *(const LAS f32x4*)(G + 192 + ks * 32 + fq * 8), w1 = *(const LAS f32x4*)(G + 192 + ks * 32 + fq * 8 + 4);
                a8[0] *= w0[0]; a8[1] *= w0[1]; a8[2] *= w0[2]; a8[3] *= w0[3]; a8[4] *= w1[0]; a8[5] *= w1[1]; a8[6] *= w1[2]; a8[7] *= w1[3];
                const bf16x8 a = __builtin_bit_cast(bf16x8, pack8(a8));
                const bf16x8 b0 = *(const LAS bf16x8*)(KT + swz(16 * cb0 + fr, ks * 4 + fq)), b1 = *(const LAS bf16x8*)(KT + swz(16 * (cb0 + 1) + fr, ks * 4 + fq));
                st0 = __builtin_amdgcn_mfma_f32_16x16x32_bf16(a, b0, st0, 0, 0, 0); st1 = __builtin_amdgcn_mfma_f32_16x16x32_bf16(a, b1, st1, 0, 0, 0); }
        }
        asm volatile("s_waitcnt lgkmcnt(0)\n\ts_barrier" ::: "memory");
        o0 = mma64s<false, true>(o0, Ss, 16 * rb, VT, 16 * cb0, fr, fq); o1 = mma64s<false, true>(o1, Ss, 16 * rb, VT, 16 * (cb0 + 1), fr, fq);
#pragma unroll
        for (int e = 0; e < 4; ++e) { const int r_ = 16 * rb + 4 * fq + e;
            STb[r_ * LDT + 16 * cb0 + fr] = (bf16)f2bf(st0[e]); STb[r_ * LDT + 16 * (cb0 + 1) + fr] = (bf16)f2bf(st1[e]);
            Of[r_ * 68 + 16 * cb0 + fr] = o0[e]; Of[r_ * 68 + 16 * (cb0 + 1) + fr] = o1[e]; }
        asm volatile("s_waitcnt lgkmcnt(0)\n\ts_barrier" ::: "memory");
        {
            float o[8]; { const f32x4 a = *(const LAS f32x4*)(Of + row * 68 + 8 * seg), b = *(const LAS f32x4*)(Of + row * 68 + 8 * seg + 4); o[0] = a[0]; o[1] = a[1]; o[2] = a[2]; o[3] = a[3]; o[4] = b[0]; o[5] = b[1]; o[6] = b[2]; o[7] = b[3]; }
            float gz[8]; unpack8(gcur, gz);
            if (MODE == 1) {
                float s8[8], q8f[8]; unpack8(*(const LAS v4u*)(Ss + row * LDT + 8 * seg), s8); unpack8(*(const LAS v4u*)(Qs + row * LDT + 8 * seg), q8f);
                const LAS float* nv = NV + bsel * 64 + 8 * seg; float ds = 0.f, nq = 0.f;
#pragma unroll
                for (int i = 0; i < 8; ++i) { ds += s8[i]; nq += nv[i] * q8f[i]; }
                ds += shx<1>(ds); nq += shx<1>(nq); ds += shx<2>(ds); nq += shx<2>(nq); ds += shx<4>(ds); nq += shx<4>(nq);
                const float Mi = G[64 + row], den = ds + __expf(mp - Mi) * nq, dn = fmaxf(fabsf(den), __expf(-(G[128 + row] + Mi))), inv = 1.f / dn;
#pragma unroll
                for (int i = 0; i < 8; ++i) o[i] = o[i] * inv * sigmoidf_(gz[i]);
                float k8f[8]; unpack8(*(const LAS v4u*)(KT + swz(row, seg)), k8f); float ns = 0.f;
#pragma unroll
                for (int i = 0; i < 8; ++i) ns += k8f[i] * G[192 + 8 * seg + i];
                ns += shx<1>(ns); ns += shx<2>(ns); ns += shx<4>(ns);
                if (seg == 0) NV[(bsel ^ 1) * 64 + row] = __expf(mp - G[64 + 63]) * NV[bsel * 64 + row] + ns;
            }
            float ss = 0.f;
#pragma unroll
            for (int i = 0; i < 8; ++i) ss += o[i] * o[i];
            ss += shx<1>(ss); ss += shx<2>(ss); ss += shx<4>(ss);
            const float rs = 1.f / sqrtf(ss * (1.f / 64.f) + 1e-6f);
#pragma unroll
            for (int i = 0; i < 8; ++i) { o[i] = o[i] * rs * gn[i]; if (MODE == 0) o[i] *= siluf_(gz[i]); }
            *(v4u*)(Y + ((size_t)64 * c + row) * MW + gofs) = pack8(o);
        }
    }
    __syncthreads();
}
constexpr int RC_B = 64 * LDT * 2;
constexpr int RC_KT = 0, RC_KH = RC_B, RC_BH = 2 * RC_B, RC_RT = 3 * RC_B, RC_KTT = 4 * RC_B, RC_KHT = 5 * RC_B, RC_BHT = 6 * RC_B, RC_VT = 7 * RC_B, RC_M = 8 * RC_B, RC_QKT = 9 * RC_B, RC_QBT = 10 * RC_B, RC_UL = 11 * RC_B;
constexpr int RC_NF = 12 * RC_B, RC_GC = RC_NF + 64 * 68 * 4, RC_END = RC_GC + 256;
constexpr int RC_TT = RC_KT, RC_MTT = RC_KH, RC_W1 = RC_BH, RC_RQS = RC_M, RC_PCS = RC_KT;
static_assert(RC_END <= RING_BYTES, "chunked rwkv LDS map");
struct RwkvC { const float* RW; bf16* RQT; bf16* PCT; float* YLT; float* SL; float* GCV; bf16* SALL; };
__device__ __forceinline__ f32x4 mma64g(f32x4 acc, const LAS bf16* A, const bf16* Bg, int ldb, int fr, int fq) {
#pragma unroll
    for (int ks = 0; ks < 2; ++ks) { const bf16x8 a = *(const LAS bf16x8*)(A + fr * LDT + ks * 32 + fq * 8), b = *(const bf16x8*)(Bg + (size_t)fr * ldb + ks * 32 + fq * 8);
        acc = __builtin_amdgcn_mfma_f32_16x16x32_bf16(a, b, acc, 0, 0, 0); }
    return acc;
}
__device__ __forceinline__ void rwkv_r1(Frame& F, const RwkvC& R) {
    const int tid = F.tid, lane = F.lane, wave = F.wave, fr = lane & 15, fq = lane >> 4, rb = wave >> 1, cb0 = 2 * (wave & 1);
    LAS unsigned char* L = F.lds + RING_OFF;
    LAS float* NF = (LAS float*)(L + RC_NF); LAS float* GC = (LAS float*)(L + RC_GC);
    const f32x4 z4 = {0.f, 0.f, 0.f, 0.f};
    v4u nkk, nb_, nkp, nr, nv; f32x4 nl0, nl1;
#define R1_LOAD(PI) do { const unsigned char* rb_ = (const unsigned char*)(R.RW + ((size_t)((PI) >> 7) * SEQ + 64 * ((PI) & 127) + lane) * RREC) + 16 * wave; \
        nkk = *(const v4u*)(rb_); nb_ = *(const v4u*)(rb_ + 128); nkp = *(const v4u*)(rb_ + 256); nr = *(const v4u*)(rb_ + 384); nv = *(const v4u*)(rb_ + 512); \
        nl0 = *(const f32x4*)(rb_ + 640 + 16 * wave); nl1 = *(const f32x4*)(rb_ + 656 + 16 * wave); } while (0)
    if (F.vcu < NH * 128) R1_LOAD(F.vcu);
    for (int pi = F.vcu; pi < NH * 128; pi += F.G) {
        const int h = pi >> 7, c = pi & 127;
        {
            float kk[8], b[8], lw[8], kp[8], r[8], v[8];
            unpack8(nkk, kk); unpack8(nb_, b); unpack8(nkp, kp); unpack8(nr, r); unpack8(nv, v);
            lw[0] = nl0[0]; lw[1] = nl0[1]; lw[2] = nl0[2]; lw[3] = nl0[3]; lw[4] = nl1[0]; lw[5] = nl1[1]; lw[6] = nl1[2]; lw[7] = nl1[3];
            if (pi + F.G < NH * 128) R1_LOAD(pi + F.G);
            float kt[8], kh[8], bh[8], rt[8];
#pragma unroll
            for (int e = 0; e < 8; ++e) { const float g = wave_incl_scan(lw[e], lane); const float eg = __expf(g), egi = __expf(-g), ege = __expf(g - lw[e]);
                kt[e] = kk[e] * ege; kh[e] = kp[e] * egi; bh[e] = b[e] * egi; rt[e] = r[e] * eg; if (lane == 63) GC[8 * wave + e] = eg; }
            const v4u pkt = pack8(kt), pkh = pack8(kh), pbh = pack8(bh), prt = pack8(rt), pv = pack8(v);
            *(LAS v4u*)(L + RC_KT + (lane * LDT + 8 * wave) * 2) = pkt; *(LAS v4u*)(L + RC_KH + (lane * LDT + 8 * wave) * 2) = pkh;
            *(LAS v4u*)(L + RC_BH + (lane * LDT + 8 * wave) * 2) = pbh; *(LAS v4u*)(L + RC_RT + (lane * LDT + 8 * wave) * 2) = prt;
            const unsigned wkt[4] = {pkt.x, pkt.y, pkt.z, pkt.w}, wkh[4] = {pkh.x, pkh.y, pkh.z, pkh.w}, wbh[4] = {pbh.x, pbh.y, pbh.z, pbh.w}, wv[4] = {pv.x, pv.y, pv.z, pv.w};
#pragma unroll
            for (int i = 0; i < 4; ++i) { const int k0 = (8 * wave + 2 * i) * LDT + lane, k1 = k0 + LDT;
                ((LAS bf16*)(L + RC_KTT))[k0] = (bf16)(wkt[i] & 0xffffu); ((LAS bf16*)(L + RC_KTT))[k1] = (bf16)(wkt[i] >> 16);
                ((LAS bf16*)(L + RC_KHT))[k0] = (bf16)(wkh[i] & 0xffffu); ((LAS bf16*)(L + RC_KHT))[k1] = (bf16)(wkh[i] >> 16);
                ((LAS bf16*)(L + RC_BHT))[k0] = (bf16)(wbh[i] & 0xffffu); ((LAS bf16*)(L + RC_BHT))[k1] = (bf16)(wbh[i] >> 16);
                ((LAS bf16*)(L + RC_VT))[k0] = (bf16)(wv[i] & 0xffffu); ((LAS bf16*)(L + RC_VT))[k1] = (bf16)(wv[i] >> 16); }
        }
        __syncthreads();
        {
            const LAS bf16* Kt = (const LAS bf16*)(L + RC_KT); const LAS bf16* Kh = (const LAS bf16*)(L + RC_KH); const LAS bf16* Bh = (const LAS bf16*)(L + RC_BH); const LAS bf16* Rt = (const LAS bf16*)(L + RC_RT);
#pragma unroll
            for (int ct = 0; ct < 2; ++ct) { const int cb = cb0 + ct;
                const f32x4 n4 = mma64(z4, Bh + 16 * rb * LDT, Kt + 16 * cb * LDT, fr, fq), m4 = mma64(z4, Kh + 16 * rb * LDT, Kt + 16 * cb * LDT, fr, fq);
                const f32x4 qk4 = mma64(z4, Kh + 16 * rb * LDT, Rt + 16 * cb * LDT, fr, fq), qb4 = mma64(z4, Bh + 16 * rb * LDT, Rt + 16 * cb * LDT, fr, fq);
                const int i = 16 * cb + fr;
#pragma unroll
                for (int e = 0; e < 4; ++e) { const int j = 16 * rb + 4 * fq + e;
                    NF[j * 68 + i] = (j < i) ? n4[e] : 0.f;
                    ((LAS bf16*)(L + RC_M))[j * LDT + i] = (bf16)f2bf((j < i) ? m4[e] : 0.f);
                    ((LAS bf16*)(L + RC_QKT))[i * LDT + j] = (bf16)f2bf((j <= i) ? qk4[e] : 0.f);
                    ((LAS bf16*)(L + RC_QBT))[i * LDT + j] = (bf16)f2bf((j <= i) ? qb4[e] : 0.f); } }
        }
        __syncthreads();
        {
            const int r = tid >> 3, p = tid & 7; float t[8];
#pragma unroll
            for (int m = 0; m < 8; ++m) t[m] = 0.f;
#pragma unroll
            for (int io = 0; io < 8; ++io)
#pragma unroll
                for (int ii = 0; ii < 8; ++ii) { const int i = 8 * io + ii; float a = 0.f;
#pragma unroll
                    for (int m = 0; m <= io; ++m) a += t[m] * NF[(8 * m + p) * 68 + i];
                    a = dpp_add<0xB1>(a); a = dpp_add<0x4E>(a); a = dpp_add<0x141>(a);
                    const float val = ((i == r) ? 1.f : 0.f) - a; if (p == ii) t[io] = val; }
#pragma unroll
            for (int m = 0; m < 8; ++m) ((LAS bf16*)(L + RC_TT))[(8 * m + p) * LDT + r] = (bf16)f2bf(t[m]);
        }
        __syncthreads();
        {
            const LAS bf16* KtT = (const LAS bf16*)(L + RC_KTT); const LAS bf16* Tt = (const LAS bf16*)(L + RC_TT); const LAS bf16* Mm = (const LAS bf16*)(L + RC_M);
#pragma unroll
            for (int ct = 0; ct < 2; ++ct) { const int cb = cb0 + ct; const f32x4 w4 = mma64(z4, KtT + 16 * rb * LDT, Tt + 16 * cb * LDT, fr, fq), mt4 = mma64(z4, Mm + 16 * rb * LDT, Tt + 16 * cb * LDT, fr, fq);
                const int i = 16 * cb + fr;
#pragma unroll
                for (int e = 0; e < 4; ++e) { const int j = 16 * rb + 4 * fq + e; ((LAS bf16*)(L + RC_W1))[j * LDT + i] = (bf16)f2bf(w4[e]); ((LAS bf16*)(L + RC_MTT))[i * LDT + j] = (bf16)f2bf(mt4[e]); } }
        }
        __syncthreads();
        {
            const LAS bf16* VT = (const LAS bf16*)(L + RC_VT); const LAS bf16* MTt = (const LAS bf16*)(L + RC_MTT);
#pragma unroll
            for (int ct = 0; ct < 2; ++ct) { const int cb = cb0 + ct; const f32x4 u4 = mma64(z4, VT + 16 * rb * LDT, MTt + 16 * cb * LDT, fr, fq); const int i = 16 * cb + fr;
#pragma unroll
                for (int e = 0; e < 4; ++e) ((LAS bf16*)(L + RC_UL))[(16 * rb + 4 * fq + e) * LDT + i] = (bf16)f2bf(u4[e]); }
        }
        __syncthreads();
        {
            const LAS bf16* W1 = (const LAS bf16*)(L + RC_W1); const LAS bf16* Qbt = (const LAS bf16*)(L + RC_QBT); const LAS bf16* Qkt = (const LAS bf16*)(L + RC_QKT); const LAS bf16* Ul = (const LAS bf16*)(L + RC_UL);
            const LAS bf16* VT = (const LAS bf16*)(L + RC_VT); const LAS bf16* KhT = (const LAS bf16*)(L + RC_KHT); const LAS bf16* BhT = (const LAS bf16*)(L + RC_BHT); const LAS bf16* Rt = (const LAS bf16*)(L + RC_RT);
            float* slg = R.SL + (size_t)pi * 4096;
#pragma unroll
            for (int ct = 0; ct < 2; ++ct) { const int cb = cb0 + ct, cc = 16 * cb + fr;
                const f32x4 a_rq = mma64(z4, W1 + 16 * rb * LDT, Qbt + 16 * cb * LDT, fr, fq);
                const f32x4 a_y1 = mma64(z4, VT + 16 * rb * LDT, Qkt + 16 * cb * LDT, fr, fq), a_y2 = mma64(z4, Ul + 16 * rb * LDT, Qbt + 16 * cb * LDT, fr, fq);
                const f32x4 a_pc = mma64(z4, W1 + 16 * rb * LDT, BhT + 16 * cb * LDT, fr, fq);
                const f32x4 a_s1 = mma64(z4, VT + 16 * rb * LDT, KhT + 16 * cb * LDT, fr, fq), a_s2 = mma64(z4, Ul + 16 * rb * LDT, BhT + 16 * cb * LDT, fr, fq);
                const float gc = GC[cc];
#pragma unroll
                for (int e = 0; e < 4; ++e) { const int rr = 16 * rb + 4 * fq + e;
                    const float rtv = __builtin_bit_cast(float, (unsigned)Rt[cc * LDT + rr] << 16);
                    ((LAS bf16*)(L + RC_RQS))[cc * LDT + rr] = (bf16)f2bf(rtv - a_rq[e]);
                    NF[cc * 68 + rr] = a_y1[e] - a_y2[e];
                    ((LAS bf16*)(L + RC_PCS))[cc * LDT + rr] = (bf16)f2bf(a_pc[e] * gc);
                    slg[rr * 64 + cc] = (a_s1[e] - a_s2[e]) * gc; }
            }
        }
        __syncthreads();
        {
            const int row = tid >> 3, seg = tid & 7;
            *(v4u*)(R.RQT + (size_t)pi * 4096 + row * 64 + 8 * seg) = *(const LAS v4u*)(L + RC_RQS + (row * LDT + 8 * seg) * 2);
            *(v4u*)(R.PCT + (size_t)pi * 4096 + row * 64 + 8 * seg) = *(const LAS v4u*)(L + RC_PCS + (row * LDT + 8 * seg) * 2);
            *(f32x4*)(R.YLT + (size_t)pi * 4096 + row * 64 + 8 * seg) = *(const LAS f32x4*)(NF + row * 68 + 8 * seg);
            *(f32x4*)(R.YLT + (size_t)pi * 4096 + row * 64 + 8 * seg + 4) = *(const LAS f32x4*)(NF + row * 68 + 8 * seg + 4);
            if (tid < 64) R.GCV[pi * 64 + tid] = GC[tid];
        }
        __syncthreads();
    }
}
__device__ __forceinline__ void rwkv_r2(Frame& F, const RwkvC& R, int head) {
    const int lane = F.lane, wave = F.wave, fr = lane & 15, fq = lane >> 4, rb = wave >> 1, cb0 = 2 * (wave & 1);
    LAS bf16* Sb = (LAS bf16*)(F.lds + RING_OFF);
    f32x4 s0 = {0.f, 0.f, 0.f, 0.f}, s1 = {0.f, 0.f, 0.f, 0.f};
    for (int c = 0; c < 128; ++c) {
        const int pi = head * 128 + c; LAS bf16* sb = Sb + (c & 1) * 64 * LDT; bf16* sg = R.SALL + (size_t)pi * 4096;
        const bf16* pc = R.PCT + (size_t)pi * 4096; const float* sl = R.SL + (size_t)pi * 4096; const float* gcv = R.GCV + pi * 64;
        bf16x8 b0[2], b1[2];
#pragma unroll
        for (int ks = 0; ks < 2; ++ks) { b0[ks] = *(const bf16x8*)(pc + (size_t)(16 * cb0 + fr) * 64 + ks * 32 + fq * 8); b1[ks] = *(const bf16x8*)(pc + (size_t)(16 * (cb0 + 1) + fr) * 64 + ks * 32 + fq * 8); }
        float l0[4], l1[4]; const float g0 = gcv[16 * cb0 + fr], g1 = gcv[16 * (cb0 + 1) + fr];
#pragma unroll
        for (int e = 0; e < 4; ++e) { const int d = 16 * rb + 4 * fq + e; l0[e] = sl[d * 64 + 16 * cb0 + fr]; l1[e] = sl[d * 64 + 16 * (cb0 + 1) + fr]; }
#pragma unroll
        for (int e = 0; e < 4; ++e) { const int d = 16 * rb + 4 * fq + e; const bf16 h0 = (bf16)f2bf(s0[e]), h1 = (bf16)f2bf(s1[e]);
            sb[d * LDT + 16 * cb0 + fr] = h0; sb[d * LDT + 16 * (cb0 + 1) + fr] = h1; sg[d * 64 + 16 * cb0 + fr] = h0; sg[d * 64 + 16 * (cb0 + 1) + fr] = h1; }
        __syncthreads();
        f32x4 p0 = {0.f, 0.f, 0.f, 0.f}, p1 = {0.f, 0.f, 0.f, 0.f};
#pragma unroll
        for (int ks = 0; ks < 2; ++ks) { const bf16x8 a = *(const LAS bf16x8*)(sb + (16 * rb + fr) * LDT + ks * 32 + fq * 8);
            p0 = __builtin_amdgcn_mfma_f32_16x16x32_bf16(a, b0[ks], p0, 0, 0, 0); p1 = __builtin_amdgcn_mfma_f32_16x16x32_bf16(a, b1[ks], p1, 0, 0, 0); }
#pragma unroll
        for (int e = 0; e < 4; ++e) { s0[e] = s0[e] * g0 - p0[e] + l0[e]; s1[e] = s1[e] * g1 - p1[e] + l1[e]; }
    }
    __syncthreads();
}
__device__ __forceinline__ void rwkv_r3(Frame& F, const RwkvC& R, const float* RBON, const bf16* RG, const float* gnw, const float* gnb, bf16* YB) {
    const int tid = F.tid, lane = F.lane, wave = F.wave, fr = lane & 15, fq = lane >> 4, rb = wave >> 1, cb0 = 2 * (wave & 1), row = tid >> 3, seg = tid & 7;
    LAS float* Of = (LAS float*)(F.lds + RING_OFF);
    for (int pi = F.vcu; pi < NH * 128; pi += F.G) {
        const int h = pi >> 7, c = pi & 127; const bf16* rq = R.RQT + (size_t)pi * 4096; const bf16* sa = R.SALL + (size_t)pi * 4096; const float* yl = R.YLT + (size_t)pi * 4096;
        f32x4 y0 = {0.f, 0.f, 0.f, 0.f}, y1 = {0.f, 0.f, 0.f, 0.f};
#pragma unroll
        for (int ks = 0; ks < 2; ++ks) { const bf16x8 a = *(const bf16x8*)(rq + (size_t)(16 * rb + fr) * 64 + ks * 32 + fq * 8);
            const bf16x8 b0 = *(const bf16x8*)(sa + (size_t)(16 * cb0 + fr) * 64 + ks * 32 + fq * 8), b1 = *(const bf16x8*)(sa + (size_t)(16 * (cb0 + 1) + fr) * 64 + ks * 32 + fq * 8);
            y0 = __builtin_amdgcn_mfma_f32_16x16x32_bf16(a, b0, y0, 0, 0, 0); y1 = __builtin_amdgcn_mfma_f32_16x16x32_bf16(a, b1, y1, 0, 0, 0); }
#pragma unroll
        for (int e = 0; e < 4; ++e) { const int i = 16 * rb + 4 * fq + e; Of[i * 68 + 16 * cb0 + fr] = y0[e] + yl[i * 64 + 16 * cb0 + fr]; Of[i * 68 + 16 * (cb0 + 1) + fr] = y1[e] + yl[i * 64 + 16 * (cb0 + 1) + fr]; }
        __syncthreads();
        {   const int t = 64 * c + row, c0 = h * 64 + 8 * seg;
            const f32x4 ya = *(const LAS f32x4*)(Of + row * 68 + 8 * seg), yb = *(const LAS f32x4*)(Of + row * 68 + 8 * seg + 4);
            float y[8] = {ya[0], ya[1], ya[2], ya[3], yb[0], yb[1], yb[2], yb[3]};
            float s = 0.f;
#pragma unroll
            for (int i = 0; i < 8; ++i) s += y[i];
            s += shx<1>(s); s += shx<2>(s); s += shx<4>(s);
            const float mu = s * (1.f / 64.f); float q = 0.f;
#pragma unroll
            for (int i = 0; i < 8; ++i) { y[i] -= mu; q += y[i] * y[i]; }
            q += shx<1>(q); q += shx<2>(q); q += shx<4>(q);
            const float rs = __builtin_amdgcn_rsqf(q * (1.f / 64.f) + 64e-5f);
            float v[8]; unpack8(*(const v4u*)((const unsigned char*)(R.RW + ((size_t)h * SEQ + t) * RREC) + 512 + 16 * seg), v);
            const float bon = RBON[t * 8 + h];
            float g[8]; unpack8(*(const v4u*)(RG + (size_t)t * MW + c0), g);
            float o[8];
#pragma unroll
            for (int i = 0; i < 8; ++i) o[i] = (y[i] * rs * gnw[c0 + i] + gnb[c0 + i] + bon * v[i]) * g[i];
            *(v4u*)(YB + (size_t)t * MW + c0) = pack8(o);
        }
        __syncthreads();
    }
}
struct ChunkG {
    const bf16 *Qr, *Kr, *Qm, *Km, *Z; const float *gr, *gm; bf16 *Yr, *Ym;
    const float *MBC, *MA, *MAX, *MBL; float *MCG, *KV, *NVC, *NB; bf16* SB;
};
__device__ __forceinline__ void mc_scan(Frame& F, const ChunkG& G, LAS float* MC, bool write_global) {
    const int h = F.wave, lane = F.lane;
    const float b0 = G.MBL[h * 128 + 2 * lane], b1 = G.MBL[h * 128 + 2 * lane + 1], d0 = G.MAX[h * 128 + 2 * lane] + b0, d1 = G.MAX[h * 128 + 2 * lane + 1] + b1;
    float B = b0 + b1, D = fmaxf(d0 + b1, d1);
#pragma unroll
    for (int o = 1; o < 64; o <<= 1) { const float pb = bperm((lane - o) & 63, B), pd = bperm((lane - o) & 63, D); if (lane >= o) { D = fmaxf(pd + B, D); B = pb + B; } }
    const float m_after = fmaxf(B, D);
    const float up = bperm((lane - 1) & 63, m_after); const float m_even = (lane == 0) ? 0.f : up, m_odd = fmaxf(m_even + b0, d0);
    MC[h * 128 + 2 * lane] = m_even; MC[h * 128 + 2 * lane + 1] = m_odd;
    if (write_global) { G.MCG[h * 128 + 2 * lane] = m_even; G.MCG[h * 128 + 2 * lane + 1] = m_odd; }
}
__device__ __forceinline__ void chunk_x1(Frame& F, const ChunkG& G) {
    const int tid = F.tid, lane = F.lane, wave = F.wave, row = tid >> 3, seg = tid & 7, rb = wave >> 1, cb0 = 2 * (wave & 1), fr = lane & 15, fq = lane >> 4;
    LAS unsigned char* L = F.lds + RING_OFF;
    LAS bf16* VT = (LAS bf16*)(L + CK_VT); LAS bf16* KT = (LAS bf16*)(L + CK_KT); LAS float* WJ = (LAS float*)(L + CK_G); LAS float* MC = (LAS float*)(L + CK_OF);
    mc_scan(F, G, MC, F.vcu == 0);
    __syncthreads();
    for (int p2 = F.vcu; p2 < 2 * NH * 128; p2 += F.G) {
        const int br = p2 >> 10, pi = p2 & 1023, h = pi >> 7, c = pi & 127; const size_t t = (size_t)64 * c + row, gofs = (size_t)h * 64 + 8 * seg;
        const v4u k8 = *(const v4u*)((br ? G.Km : G.Kr) + t * MW + gofs), v8 = *(const v4u*)(G.Z + t * ZW + (br ? ZC_MV : ZC_TV) + gofs);
        if (tid < 64) { float w;
            if (br == 0) w = exp2f((float)(63 - tid) * log2f(1.f - exp2f(-5.f - (float)h)));
            else w = __expf(G.MA[(size_t)h * SEQ + 64 * c + tid] - fmaxf(MC[h * 128 + c], G.MAX[h * 128 + c]));
            WJ[tid] = w; }
        const unsigned kw[4] = {k8.x, k8.y, k8.z, k8.w}, vw[4] = {v8.x, v8.y, v8.z, v8.w};
#pragma unroll
        for (int i = 0; i < 4; ++i) { const int c_ = ((((row >> 3) ^ seg) & 7) << 3) + (row & 7), r0 = (8 * seg + 2 * i) * LDT + c_, r1 = r0 + LDT;
            KT[r0] = (bf16)(kw[i] & 0xffffu); KT[r1] = (bf16)(kw[i] >> 16); VT[r0] = (bf16)(vw[i] & 0xffffu); VT[r1] = (bf16)(vw[i] >> 16); }
        asm volatile("s_waitcnt lgkmcnt(0)\n\ts_barrier" ::: "memory");
        f32x4 st0 = {0.f, 0.f, 0.f, 0.f}, st1 = {0.f, 0.f, 0.f, 0.f};
#pragma unroll
        for (int ks = 0; ks < 2; ++ks) { float a8[8]; unpack8(*(const LAS v4u*)(VT + swz(16 * rb + fr, ks * 4 + fq)), a8);
            const f32x4 w0 = *(const LAS f32x4*)(WJ + ks * 32 + fq * 8), w1 = *(const LAS f32x4*)(WJ + ks * 32 + fq * 8 + 4);
            a8[0] *= w0[0]; a8[1] *= w0[1]; a8[2] *= w0[2]; a8[3] *= w0[3]; a8[4] *= w1[0]; a8[5] *= w1[1]; a8[6] *= w1[2]; a8[7] *= w1[3];
            const bf16x8 a = __builtin_bit_cast(bf16x8, pack8(a8));
            const bf16x8 b0 = *(const LAS bf16x8*)(KT + swz(16 * cb0 + fr, ks * 4 + fq)), b1 = *(const LAS bf16x8*)(KT + swz(16 * (cb0 + 1) + fr, ks * 4 + fq));
            st0 = __builtin_amdgcn_mfma_f32_16x16x32_bf16(a, b0, st0, 0, 0, 0); st1 = __builtin_amdgcn_mfma_f32_16x16x32_bf16(a, b1, st1, 0, 0, 0); }
        float* kv = G.KV + (size_t)p2 * 4096;
#pragma unroll
        for (int e = 0; e < 4; ++e) { const int v = 16 * rb + 4 * fq + e; kv[v * 64 + 16 * cb0 + fr] = st0[e]; kv[v * 64 + 16 * (cb0 + 1) + fr] = st1[e]; }
        if (br == 1) { float k8f[8]; unpack8(*(const LAS v4u*)(KT + swz(row, seg)), k8f); float ns = 0.f;
#pragma unroll
            for (int i = 0; i < 8; ++i) ns += k8f[i] * WJ[8 * seg + i];
            ns += shx<1>(ns); ns += shx<2>(ns); ns += shx<4>(ns);
            if (seg == 0) G.NVC[pi * 64 + row] = ns; }
        asm volatile("s_waitcnt lgkmcnt(0)\n\ts_barrier" ::: "memory");
    }
}
__device__ __forceinline__ void chunk_x2(Frame& F, const ChunkG& G, int br, int h) {
    const int tid = F.tid; LAS float* DEC = (LAS float*)(F.lds + RING_OFF);
    if (tid < 128) DEC[tid] = br ? __expf(G.MCG[h * 128 + tid] - fmaxf(G.MCG[h * 128 + tid], G.MAX[h * 128 + tid])) : exp2f(64.f * log2f(1.f - exp2f(-5.f - (float)h)));
    __syncthreads();
    float S[8] = {0.f, 0.f, 0.f, 0.f, 0.f, 0.f, 0.f, 0.f}; float N = 0.f;
    const size_t base = ((size_t)br * 1024 + h * 128) * 4096 + 8 * tid;
#pragma unroll 4
    for (int c = 0; c < 128; ++c) {
        const float* kv = G.KV + base + (size_t)c * 4096; const f32x4 a = *(const f32x4*)kv, b = *(const f32x4*)(kv + 4); const float dec = DEC[c];
        *(v4u*)(G.SB + base + (size_t)c * 4096) = pack8(S);
        S[0] = dec * S[0] + a[0]; S[1] = dec * S[1] + a[1]; S[2] = dec * S[2] + a[2]; S[3] = dec * S[3] + a[3]; S[4] = dec * S[4] + b[0]; S[5] = dec * S[5] + b[1]; S[6] = dec * S[6] + b[2]; S[7] = dec * S[7] + b[3];
        if (br == 1 && tid < 64) { const int pi = h * 128 + c; G.NB[pi * 64 + tid] = N; N = dec * N + G.NVC[pi * 64 + tid]; }
    }
    __syncthreads();
}
__device__ __forceinline__ void chunk_x3(Frame& F, const ChunkG& G) {
    const int tid = F.tid, lane = F.lane, wave = F.wave, row = tid >> 3, seg = tid & 7, rb = wave >> 1, cb0 = 2 * (wave & 1), fr = lane & 15, fq = lane >> 4;
    LAS unsigned char* L = F.lds + RING_OFF;
    LAS bf16* Qs = (LAS bf16*)(L + CK_Q); LAS bf16* Ks = (LAS bf16*)(L + CK_K); LAS bf16* VT = (LAS bf16*)(L + CK_VT);
    LAS bf16* Ss = (LAS bf16*)(L + CK_S); LAS bf16* STb = (LAS bf16*)(L + CK_STB); LAS float* Of = (LAS float*)(L + CK_OF); LAS float* Gt = (LAS float*)(L + CK_G); LAS float* NV = (LAS float*)(L + CK_NV);
    const f32x4 z4 = {0.f, 0.f, 0.f, 0.f};
    v4u q8n, k8n, v8n, s8n, g8n; float an = 0.f, bcn = 0.f, mpn = 0.f, nbn = 0.f;
#define X3_LOAD(P2) do { const int br_ = (P2) >> 10, pi_ = (P2) & 1023, h_ = pi_ >> 7, c_ = pi_ & 127; const size_t t_ = (size_t)64 * c_ + row, go_ = (size_t)h_ * 64 + 8 * seg; \
        q8n = *(const v4u*)((br_ ? G.Qm : G.Qr) + t_ * MW + go_); k8n = *(const v4u*)((br_ ? G.Km : G.Kr) + t_ * MW + go_); v8n = *(const v4u*)(G.Z + t_ * ZW + (br_ ? ZC_MV : ZC_TV) + go_); \
        s8n = *(const v4u*)(G.SB + (size_t)(P2) * 4096 + row * 64 + 8 * seg); g8n = *(const v4u*)(G.Z + t_ * ZW + (br_ ? ZC_MO : ZC_TG) + go_); \
        if (br_ == 1 && wave == 0) { an = G.MA[(size_t)h_ * SEQ + 64 * c_ + lane]; bcn = G.MBC[(size_t)h_ * SEQ + 64 * c_ + lane]; mpn = G.MCG[h_ * 128 + c_]; } \
        if (br_ == 1 && wave == 1) nbn = G.NB[pi_ * 64 + lane]; } while (0)
    if (F.vcu < 2 * NH * 128) X3_LOAD(F.vcu);
    for (int p2 = F.vcu; p2 < 2 * NH * 128; p2 += F.G) {
        const int br = p2 >> 10, pi = p2 & 1023, h = pi >> 7, c = pi & 127; const size_t t = (size_t)64 * c + row, gofs = (size_t)h * 64 + 8 * seg;
        const float log2g = log2f(1.f - exp2f(-5.f - (float)h));
        {
            const v4u q8 = q8n, k8 = k8n, v8 = v8n, s8 = s8n;
            *(LAS v4u*)(Qs + row * LDT + 8 * seg) = q8; *(LAS v4u*)(Ks + row * LDT + 8 * seg) = k8; *(LAS v4u*)(STb + row * LDT + 8 * seg) = s8;
            const unsigned vw[4] = {v8.x, v8.y, v8.z, v8.w};
#pragma unroll
            for (int i = 0; i < 4; ++i) { const int c_ = ((((row >> 3) ^ seg) & 7) << 3) + (row & 7), r0 = (8 * seg + 2 * i) * LDT + c_; VT[r0] = (bf16)(vw[i] & 0xffffu); VT[r0 + LDT] = (bf16)(vw[i] >> 16); }
            if (br == 1 && wave == 0) { const float a = an, bc = bcn, mp = mpn;
                const float Mi = fmaxf(mp, wave_incl_max(a, lane)); Gt[lane] = a; Gt[64 + lane] = Mi; Gt[128 + lane] = bc; if (lane == 0) Gt[257] = mp; }
            if (br == 1 && wave == 1) NV[lane] = nbn;
        }
        const v4u gcur = g8n;
        if (p2 + F.G < 2 * NH * 128) X3_LOAD(p2 + F.G);
        asm volatile("s_waitcnt lgkmcnt(0)\n\ts_barrier" ::: "memory");
        const float mp = br ? Gt[257] : 0.f;
        f32x4 o0, o1;
        {
#pragma unroll
            for (int ct = 0; ct < 2; ++ct) { const int cb = cb0 + ct; f32x4 sc = mma64(z4, Qs + 16 * rb * LDT, Ks + 16 * cb * LDT, fr, fq);
                const int j = 16 * cb + fr; const float aj = br ? Gt[j] : 0.f;
#pragma unroll
                for (int e = 0; e < 4; ++e) { const int i = 16 * rb + 4 * fq + e; float d;
                    if (br == 0) d = exp2f((float)(i > j ? i - j : j - i) * log2g); else d = (j <= i) ? __expf(aj - Gt[64 + i]) : 0.f;
                    Ss[i * LDT + j] = (bf16)f2bf(sc[e] * d); } }
            o0 = mma64(z4, Qs + 16 * rb * LDT, STb + 16 * cb0 * LDT, fr, fq); o1 = mma64(z4, Qs + 16 * rb * LDT, STb + 16 * (cb0 + 1) * LDT, fr, fq);
#pragma unroll
            for (int e = 0; e < 4; ++e) { const int i = 16 * rb + 4 * fq + e; const float sc = (br == 0) ? exp2f((float)(i + 1) * log2g) : __expf(mp - Gt[64 + i]); o0[e] *= sc; o1[e] *= sc; }
        }
        asm volatile("s_waitcnt lgkmcnt(0)\n\ts_barrier" ::: "memory");
        o0 = mma64s<false, true>(o0, Ss, 16 * rb, VT, 16 * cb0, fr, fq); o1 = mma64s<false, true>(o1, Ss, 16 * rb, VT, 16 * (cb0 + 1), fr, fq);
#pragma unroll
        for (int e = 0; e < 4; ++e) { const int r_ = 16 * rb + 4 * fq + e; Of[r_ * 68 + 16 * cb0 + fr] = o0[e]; Of[r_ * 68 + 16 * (cb0 + 1) + fr] = o1[e]; }
        asm volatile("s_waitcnt lgkmcnt(0)\n\ts_barrier" ::: "memory");
        {
            float o[8]; { const f32x4 a = *(const LAS f32x4*)(Of + row * 68 + 8 * seg), b = *(const LAS f32x4*)(Of + row * 68 + 8 * seg + 4); o[0] = a[0]; o[1] = a[1]; o[2] = a[2]; o[3] = a[3]; o[4] = b[0]; o[5] = b[1]; o[6] = b[2]; o[7] = b[3]; }
            float gz[8]; unpack8(gcur, gz);
            if (br == 1) {
                float s8f[8], q8f[8]; unpack8(*(const LAS v4u*)(Ss + row * LDT + 8 * seg), s8f); unpack8(*(const LAS v4u*)(Qs + row * LDT + 8 * seg), q8f);
                float ds = 0.f, nq = 0.f;
#pragma unroll
                for (int i = 0; i < 8; ++i) { ds += s8f[i]; nq += NV[8 * seg + i] * q8f[i]; }
                ds += shx<1>(ds); nq += shx<1>(nq); ds += shx<2>(ds); nq += shx<2>(nq); ds += shx<4>(ds); nq += shx<4>(nq);
                const float Mi = Gt[64 + row], den = ds + __expf(mp - Mi) * nq, dn = fmaxf(fabsf(den), __expf(-(Gt[128 + row] + Mi))), inv = __builtin_amdgcn_rcpf(dn);
#pragma unroll
                for (int i = 0; i < 8; ++i) o[i] = o[i] * inv * sigmoidf_(gz[i]);
            }
            float ss = 0.f;
#pragma unroll
            for (int i = 0; i < 8; ++i) ss += o[i] * o[i];
            ss += shx<1>(ss); ss += shx<2>(ss); ss += shx<4>(ss);
            const float rs = __builtin_amdgcn_rsqf(ss * (1.f / 64.f) + 1e-6f); const float* gn = (br ? G.gm : G.gr) + gofs;
#pragma unroll
            for (int i = 0; i < 8; ++i) { o[i] = o[i] * rs * gn[i]; if (br == 0) o[i] *= siluf_(gz[i]); }
            *(v4u*)((br ? G.Ym : G.Yr) + t * MW + gofs) = pack8(o);
        }
        asm volatile("s_waitcnt lgkmcnt(0)\n\ts_barrier" ::: "memory");
    }
#undef X3_LOAD
}
#if DBG
__device__ __forceinline__ unsigned dh(unsigned x) { x ^= x >> 16; x *= 0x7feb352du; x ^= x >> 15; x *= 0x846ca68bu; x ^= x >> 16; return x; }
__device__ __forceinline__ float b2f(bf16 v) { return __builtin_bit_cast(float, (unsigned)v << 16); }
__device__ __forceinline__ float rbf(float f) { return __builtin_bit_cast(float, f2bf(f) << 16); }
__device__ __forceinline__ void dflag(unsigned* flags, int idx, float err, float tol) { if (!(err <= tol)) { atomicOr(&flags[idx], 1u); atomicMax(&flags[32 + idx], __float_as_uint(fminf(fabsf(err), 1e30f))); } }
__device__ __forceinline__ float ddot(const bf16* a, const bf16* b, int K) { float s = 0.f; for (int k = 0; k < K; ++k) s += b2f(a[k]) * b2f(b[k]); return s; }
__global__ void k_check(Args args, int which, int l) {
    const int sid = blockIdx.x * blockDim.x + threadIdx.x; unsigned char* ws = args.ws; unsigned* flags = (unsigned*)(ws + WS_CTL) + 2048;
    const unsigned h1 = dh(sid * 2654435761u + which * 97u), h2 = dh(h1 + 12345u);
    const int row = h1 % SEQ; unsigned char* wl = ws + WS_W + (size_t)l * WL_BYTES;
    const bf16* XN = (const bf16*)(ws + WS_XN); const bf16* Z = (const bf16*)(ws + WS_Z); const bf16* HID = (const bf16*)(ws + WS_HID); const bf16* GATES = (const bf16*)(ws + WS_GATES);
    const float* SNAP = (const float*)(ws + WS_END);
    if (which == 1) {
        const int n = h1 % (2 * DFF), k = h2 % DM, tile = n >> 8, within = n & 255; const float* w = args.in[within < 128 ? I_F1W1 : I_F1W3] + (size_t)l * DM * DFF;
        const float ref = rbf(w[(size_t)k * DFF + tile * 128 + (within & 127)]); const float got = b2f(((const bf16*)(wl + WL_W13A))[(size_t)n * DM + k]);
        dflag(flags, which, fabsf(ref - got), 0.f);
        const int n2 = h1 % ZW; const int sc = win_src(n2); const float r2 = sc >= 0 ? rbf((args.in[I_WIN] + (size_t)l * DM * 7960)[(size_t)k * 7960 + sc]) : 0.f; dflag(flags, which, fabsf(r2 - b2f(((const bf16*)(wl + WL_WIN))[(size_t)n2 * DM + k])), 0.f);
        const int k2 = h2 % DFF, n3 = h1 % DM; dflag(flags, which, fabsf(rbf((args.in[I_F1W2] + (size_t)l * DFF * DM)[(size_t)k2 * DM + n3]) - b2f(((const bf16*)(wl + WL_W2A))[(size_t)n3 * DFF + k2])), 0.f);
        const int nb = h2 % 4, kb = h1 % MW; dflag(flags, which, fabsf(rbf((args.in[I_WB] + ((size_t)l * 4 + nb) * MW * DM)[(size_t)kb * DM + n3]) - b2f(((const bf16*)(wl + WL_WB))[((size_t)nb * DM + n3) * MW + kb])), 0.f);
        dflag(flags, which, fabsf(rbf((args.in[I_WO] + (size_t)l * DM * DM)[(size_t)k * DM + n3]) - b2f(((const bf16*)(wl + WL_WO))[(size_t)n3 * DM + k])), 0.f);
        const int n4 = h1 % (4 * DM); dflag(flags, which, fabsf(rbf((args.in[I_WG] + (size_t)l * DM * 4 * DM)[(size_t)k * 4 * DM + n4]) - b2f(((const bf16*)(wl + WL_WG))[(size_t)n4 * DM + k])), 0.f);
    }
    if (which == 2 || which == 5) {
        const float* x = (which == 2) ? args.in[I_X] : args.out; const float* g = args.in[which == 2 ? I_F1N : I_MIXN] + (size_t)l * DM;
        float ss = 0.f; for (int k = 0; k < DM; ++k) { const float v = x[(size_t)row * DM + k]; ss += v * v; }
        const float rs = 1.f / sqrtf(ss / DM + 1e-6f); const int c = h2 % DM; const float ref = x[(size_t)row * DM + c] * rs * g[c];
        dflag(flags, which, fabsf(ref - b2f(XN[(size_t)row * DM + c])), 0.02f * fabsf(ref) + 0.01f);
    }
    if (which == 3) {
        const int c = h2 % DFF, tile = c >> 7, w_ = c & 127; const bf16* B = (const bf16*)(wl + WL_W13A);
        const float a = ddot(XN + (size_t)row * DM, B + (size_t)(tile * 256 + w_) * DM, DM), b = ddot(XN + (size_t)row * DM, B + (size_t)(tile * 256 + 128 + w_) * DM, DM);
        const float ref = a / (1.f + expf(-a)) * b; dflag(flags, which, fabsf(ref - b2f(HID[(size_t)row * DFF + c])), 0.02f * fabsf(ref) + 0.02f);
    }
    if (which == 4) {
        const int c = h2 % DM; const float ref = args.in[I_X][(size_t)row * DM + c] + 0.5f * ddot(HID + (size_t)row * DFF, (const bf16*)(wl + WL_W2A) + (size_t)c * DFF, DFF);
        dflag(flags, which, fabsf(ref - args.out[(size_t)row * DM + c]), 0.01f * fabsf(ref) + 0.01f);
    }
    if (which == 6) {
        const int c = (sid & 1) ? (7936 + h2 % 24) : (h2 % ZW); const float ref = ddot(XN + (size_t)row * DM, (const bf16*)(wl + WL_WIN) + (size_t)c * DM, DM);
        dflag(flags, which, fabsf(ref - b2f(Z[(size_t)row * ZW + c])), 0.02f * fabsf(ref) + 0.02f);
    }
    if (which == 7) {
        const int c = h2 % (4 * DM); const float a = ddot(XN + (size_t)row * DM, (const bf16*)(wl + WL_WG) + (size_t)c * DM, DM) + (args.in[I_WGB] + (size_t)l * 4 * DM)[c];
#if DBG_RAWGATE
        const float ref = a - ((DBG_RAWGATE == 2) ? 0.f : (args.in[I_WGB] + (size_t)l * 4 * DM)[c]); dflag(flags, which, fabsf(ref - b2f(GATES[(size_t)row * 4 * DM + c])), 0.02f * fabsf(ref) + 0.02f);
#else
        const float ref = 1.f / (1.f + expf(-a)); dflag(flags, which, fabsf(ref - b2f(GATES[(size_t)row * 4 * DM + c])), 0.02f);
#endif
    }
    if (which == 8) {
        const int c = h2 % DM; float ref = 0.f;
        const bf16* Y[4] = {(const bf16*)(ws + WS_YF), (const bf16*)(ws + WS_YB), (const bf16*)(ws + WS_YR), (const bf16*)(ws + WS_YM)};
        for (int n = 0; n < 4; ++n) ref += b2f(GATES[(size_t)row * 4 * DM + n * DM + c]) * ddot(Y[n] + (size_t)row * MW, (const bf16*)(wl + WL_WB) + ((size_t)n * DM + c) * MW, MW);
        dflag(flags, which, fabsf(ref - b2f(((const bf16*)(ws + WS_MRGB))[(size_t)row * DM + c])), 0.02f * fabsf(ref) + 0.03f);
    }
    if (which == 9) {
        const int c = h2 % DM; const float ref = SNAP[(size_t)row * DM + c] + ddot((const bf16*)(ws + WS_MRGB) + (size_t)row * DM, (const bf16*)(wl + WL_WO) + (size_t)c * DM, DM);
        dflag(flags, which, fabsf(ref - args.out[(size_t)row * DM + c]), 0.01f * fabsf(ref) + 0.01f);
    }
}
__global__ void k_report(Args args) {
    const size_t i = (size_t)blockIdx.x * blockDim.x + threadIdx.x; const unsigned* flags = (const unsigned*)(args.ws + WS_CTL) + 2048;
    if (i < (size_t)SEQ * DM) { float v = args.in[I_X][i];
        if (i == 0) { int first = 0; for (int k = 31; k >= 1; --k) if (flags[k]) first = k; float me = __uint_as_float(flags[32 + first]); int d = (int)(me * 10.f); d = d > 9 ? 9 : (d < 0 ? 0 : d); v += 1000.f * first + (first ? 100.f * d : 0.f); }
        args.out[i] = v; }
}
#endif
__device__ __forceinline__ void post_phase(Frame& F, const float* YRAW, const float* RW, const float* RBON, const bf16* RG, const float* gnw, const float* gnb, bf16* YB) {
    const int gw = F.vcu * NWAVES + F.wave, NGW = F.G * NWAVES, lane = F.lane, hh = lane >> 3, c0 = 8 * lane;
    float gw8[8], gb8[8];
#pragma unroll
    for (int i = 0; i < 8; ++i) { gw8[i] = gnw[c0 + i]; gb8[i] = gnb[c0 + i]; }
    for (int t = gw; t < SEQ; t += NGW) {
        const f32x4 ya = *(const f32x4*)(YRAW + (size_t)t * MW + c0), yb = *(const f32x4*)(YRAW + (size_t)t * MW + c0 + 4);
        float y[8] = {ya[0], ya[1], ya[2], ya[3], yb[0], yb[1], yb[2], yb[3]};
        float s = 0.f;
#pragma unroll
        for (int i = 0; i < 8; ++i) s += y[i];
        s += shx<1>(s); s += shx<2>(s); s += shx<4>(s);
        const float mu = s * (1.f / 64.f); float q = 0.f;
#pragma unroll
        for (int i = 0; i < 8; ++i) { y[i] -= mu; q += y[i] * y[i]; }
        q += shx<1>(q); q += shx<2>(q); q += shx<4>(q);
        const float rs = 1.f / sqrtf(q * (1.f / 64.f) + 64e-5f);
        const float* rec = RW + ((size_t)hh * SEQ + t) * RREC + 320 + 8 * (lane & 7);
        const f32x4 va = *(const f32x4*)rec, vb = *(const f32x4*)(rec + 4); const float v[8] = {va[0], va[1], va[2], va[3], vb[0], vb[1], vb[2], vb[3]};
        const float bon = RBON[t * 8 + hh];
        float g[8]; unpack8(*(const v4u*)(RG + (size_t)t * MW + c0), g);
        float o[8];
#pragma unroll
        for (int i = 0; i < 8; ++i) o[i] = (y[i] * rs * gw8[i] + gb8[i] + bon * v[i]) * g[i];
        *(v4u*)(YB + (size_t)t * MW + c0) = pack8(o);
    }
}


#ifndef MIX_PRE_R2
#define MIX_PRE_R2 2300
#endif
#ifndef MIX_PRE_CHUNK
#define MIX_PRE_CHUNK 300
#endif
#ifndef MIX_ATT_STEP
#define MIX_ATT_STEP 54
#endif
#ifndef MIX_GATE_UNIT
#define MIX_GATE_UNIT 500
#endif
constexpr int kFoxTiles[8] = {999, 999, 999, 999, 999, 999, 999, 999};
constexpr int att_cost(int r) { const int h = r & 7, qb = 31 - (r >> 3); int tiles = 4 * (qb + 1); const int cap = kFoxTiles[h] + 4; if (tiles > cap) tiles = cap; return MIX_ATT_STEP * tiles / 4; }
constexpr int mix_pre(int j) {
    if (j < 8) return MIX_PRE_R2; if (j < 24) return MIX_PRE_CHUNK;
    const int a = j - 24; int pre = att_cost(a); if (a >= 208) pre += att_cost(463 - a); return pre;
}
constexpr int mix_cnt(int j, int T) { const int x = T - mix_pre(j) + MIX_GATE_UNIT / 2; return x <= 0 ? 0 : x / MIX_GATE_UNIT; }
struct GAssign { short first[257]; };
constexpr GAssign make_gassign() {
    GAssign g{}; int lo = 0, hi = 40000;
    while (lo < hi) { const int mid = (lo + hi + 1) / 2; int s = 0; for (int j = 0; j < 256; ++j) s += mix_cnt(j, mid); if (s <= 1024) lo = mid; else hi = mid - 1; }
    int cnt[256] = {}; int s = 0; for (int j = 0; j < 256; ++j) { cnt[j] = mix_cnt(j, lo); s += cnt[j]; }
    for (int j = 255; s < 1024; j = (j == 24) ? 255 : j - 1) { cnt[j] += 1; s += 1; }
    int acc = 0; for (int j = 0; j < 256; ++j) { g.first[j] = (short)acc; acc += cnt[j]; } g.first[256] = (short)acc;
    return g;
}
__device__ const GAssign kGAssign = make_gassign();
static_assert(make_gassign().first[256] == 1024, "gate units");
#ifndef PHMASK
#define PHMASK 1023
#endif
#ifndef YMASK
#define YMASK 0
#endif
#ifndef GATES_IN_ZG
#define GATES_IN_ZG 0
#endif
enum { K_PRO = 0, K_NORM, K_UP, K_DOWN, K_ZG, K_PREP, K_MIX, K_POST, K_MERGE, K_OUTP, K_R1, K_NKIND };
__host__ __device__ __forceinline__ void phase_decode(int p, int& kind, int& l, int& sel) {
    if (p == 0) { kind = K_PRO; l = 0; sel = 0; return; }
    const int q = (p - 1) % PH_PER_LAYER; l = (p - 1) / PH_PER_LAYER;
    switch (q) {
        case 0: kind = K_UP; sel = 0; break; case 1: kind = K_DOWN; sel = 0; break;
        case 2: kind = K_ZG; sel = 0; break; case 3: kind = K_PREP; sel = 0; break; case 4: kind = K_R1; sel = 0; break; case 5: kind = K_MIX; sel = 0; break;
        case 6: kind = K_POST; sel = 0; break; case 7: kind = K_MERGE; sel = 0; break; case 8: kind = K_OUTP; sel = 0; break;
        case 9: kind = K_UP; sel = 1; break; default: kind = K_DOWN; sel = 1; break;
    }
}
static_assert(offsetof(Args, ws) == KARG_WS_OFF, "Args::ws offset");
typedef const __attribute__((address_space(4))) Args* ArgP;
struct ArgsView { ArgP p; __device__ __forceinline__ const float* operator[](int i) const { return p->in[i]; } };
__device__ __forceinline__ void frame_fill(Frame& F, unsigned char* lds, unsigned char* ws) {
    int tid_ = threadIdx.x; asm volatile("; opaque tid" : "+v"(tid_));
    F.lds = (LAS unsigned char*)lds; F.MISC = (volatile LAS unsigned*)(F.lds + MISC_OFF);
    F.tid = tid_; F.lane = F.tid & 63; F.wave = __builtin_amdgcn_readfirstlane(F.tid >> 6);
    int bx = blockIdx.x, G = gridDim.x; asm volatile("; opaque bx" : "+s"(bx), "+s"(G));
    F.G = G; F.vcu = (G % 8 == 0) ? (bx % 8) * (G / 8) + bx / 8 : bx; F.bx = bx;
    F.ws = ws; F.ctl = (gu32*)(ws + WS_CTL);
}
template <int KIND> __device__ __forceinline__ void run_phase(unsigned char* lds_, int l_, int sel_) {
    ArgP pa = (ArgP)__builtin_amdgcn_kernarg_segment_ptr(); asm volatile("; opaque kernarg" : "+s"(pa));
    int l = l_, sel = sel_; asm volatile("; opaque l" : "+s"(l), "+s"(sel));
    struct { ArgsView in; float* out; unsigned char* ws; } args; args.in.p = pa; args.out = pa->out; args.ws = pa->ws;
    Frame F; frame_fill(F, lds_, args.ws);
    unsigned char* ws = args.ws; float* OUT = args.out; const int bx = F.bx;
    bf16* XN = (bf16*)(ws + WS_XN); bf16* Z = (bf16*)(ws + WS_Z); bf16* HID = (bf16*)(ws + WS_HID); bf16* GATES = (bf16*)(ws + WS_GATES);
    unsigned char* wl = ws + WS_W + (size_t)l * WL_BYTES;
    bf16 *FQ = (bf16*)(ws + WS_FQ), *FK = (bf16*)(ws + WS_FK), *YF = (bf16*)(ws + WS_YF), *RQ = (bf16*)(ws + WS_RQ), *RK = (bf16*)(ws + WS_RK), *YR = (bf16*)(ws + WS_YR);
    bf16 *FV = (bf16*)(ws + WS_FV), *FO = (bf16*)(ws + WS_FO), *TV = (bf16*)(ws + WS_TV), *TG = (bf16*)(ws + WS_TG), *MV = (bf16*)(ws + WS_MV), *MO = (bf16*)(ws + WS_MO);
    bf16 *MQ = (bf16*)(ws + WS_MQ), *MK = (bf16*)(ws + WS_MK), *YM = (bf16*)(ws + WS_YM), *YB = (bf16*)(ws + WS_YB), *RG = (bf16*)(ws + WS_RG), *MRGB = (bf16*)(ws + WS_MRGB);
    float *RW = (float*)(ws + WS_RW), *YRAW = (float*)(ws + WS_YRAW), *MRGF = (float*)(ws + WS_MRGF);
    RwkvC RC; RC.RW = RW; RC.RQT = (bf16*)(ws + WS_RQT); RC.PCT = (bf16*)(ws + WS_PCT); RC.YLT = (float*)(ws + WS_YLT); RC.SL = (float*)(ws + WS_SL); RC.GCV = (float*)(ws + WS_GCV); RC.SALL = (bf16*)(ws + WS_SALL);
    ChunkG CG; CG.Qr = RQ; CG.Kr = RK; CG.Qm = MQ; CG.Km = MK; CG.Z = Z; CG.gr = args.in[I_TGN] + l * 512; CG.gm = args.in[I_MGN] + l * 512; CG.Yr = YR; CG.Ym = YM;
    CG.MBC = (float*)(ws + WS_SM + SM_MBC); CG.MA = (float*)(ws + WS_SM + SM_MA); CG.MAX = (float*)(ws + WS_SM + SM_MAX); CG.MBL = (float*)(ws + WS_SM + SM_MBL); CG.MCG = (float*)(ws + WS_SM + SM_MCG);
    CG.KV = (float*)(ws + WS_KV); CG.NVC = (float*)(ws + WS_NVC); CG.NB = (float*)(ws + WS_NB); CG.SB = (bf16*)(ws + WS_SB);
    float *RBON = (float*)(ws + WS_SM + SM_RBON), *FP = (float*)(ws + WS_SM + SM_FP), *FT = (float*)(ws + WS_SM + SM_FT), *MBC = (float*)(ws + WS_SM + SM_MBC), *MA = (float*)(ws + WS_SM + SM_MA);
    float* SSB = (float*)(ws + WS_SSP);
    if constexpr (KIND == K_PRO && ((PHMASK >> K_PRO) & 1)) { p0_prologue(F, args.in); xin_phase(F, args.in[I_X], XN, SSB); }
    if constexpr (KIND == K_UP && ((PHMASK >> K_UP) & 1)) { pg8::Gemm g{XN, (const bf16*)(wl + (sel ? WL_W13B : WL_W13A)), SEQ, 2 * DFF, DM}; pg8::StaticOrder S; S.init(SEQ, 2 * DFF, F.G, bx);
        pg8::EpiSwiglu E{HID, DFF, SSB + (size_t)(3 * l + (sel ? 2 : 0)) * 8 * SEQ}; pg8::gemm_phase<pg8::EpiSwiglu, pg8::StaticOrder, true, true>(F.lds + RING_OFF, g, S, E); }
    if constexpr (KIND == K_DOWN && ((PHMASK >> K_DOWN) & 1)) { const float* xcur = (l == 0 && sel == 0) ? args.in[I_X] : OUT;
        pg8::Gemm g{HID, (const bf16*)(wl + (sel ? WL_W2B : WL_W2A)), SEQ, DM, DFF}; pg8::StaticOrder S; S.init(SEQ, DM, F.G, bx);
        pg8::EpiResid E{(l == DEPTH - 1 && sel == 1) ? OUT : nullptr, 3 * l + (sel ? 3 : 1), 0.5f, 0}; pg8::gemm_phase<pg8::EpiResid, pg8::StaticOrder, true, true>(F.lds + RING_OFF, g, S, E); }
    if constexpr (KIND == K_ZG && ((PHMASK >> K_ZG) & 1)) { pg8::Gemm g{XN, (const bf16*)(wl + WL_WIN), SEQ, ZW, DM}; pg8::StaticOrder S; S.init(SEQ, ZW, F.G, bx);
        pg8::EpiStore<0> E{Z, ZW, nullptr, SSB + (size_t)(3 * l + 1) * 8 * SEQ}; pg8::gemm_phase<pg8::EpiStore<0>, pg8::StaticOrder, true, true>(F.lds + RING_OFF, g, S, E);
#if GATES_IN_ZG
        { pg8::Gemm g2{XN, (const bf16*)(wl + WL_WG), SEQ, 4 * DM, DM}; pg8::StaticOrder S2; S2.init(SEQ, 4 * DM, F.G, bx);
          #if DBG_RAWGATE
          pg8::EpiStore<0> E2{GATES, 4 * DM, (DBG_RAWGATE == 2) ? args.in[I_WGB] + (size_t)l * 4 * DM : nullptr, SSB + (size_t)(3 * l + 1) * 8 * SEQ}; pg8::gemm_phase<pg8::EpiStore<0>, pg8::StaticOrder, true, true>(F.lds + RING_OFF, g2, S2, E2); }
#else
          pg8::EpiStore<1> E2{GATES, 4 * DM, args.in[I_WGB] + (size_t)l * 4 * DM, SSB + (size_t)(3 * l + 1) * 8 * SEQ}; pg8::gemm_phase<pg8::EpiStore<1>, pg8::StaticOrder, true, true>(F.lds + RING_OFF, g2, S2, E2); }
#endif
#endif
    }
    if constexpr (KIND == K_PREP && ((PHMASK >> K_PREP) & 1)) {
        PrepP P; P.Z = Z; P.pos = (const int*)args.in[I_POS]; P.w2t = (const bf16*)(ws + WS_LORA) + (size_t)l * 131072; P.a2t = P.w2t + 32768; P.g2t = P.w2t + 65536;
        P.fox_fb = args.in[I_FOXFB] + l * 8; P.fox_qg = args.in[I_FOXQG] + l * 64; P.fox_kg = args.in[I_FOXKG] + l * 64; P.mu = args.in[I_RMU] + l * 1792; P.w0 = args.in[I_RW0] + l * 512;
        P.w2 = args.in[I_RW2] + (size_t)l * 64 * 512; P.a0 = args.in[I_RA0] + l * 512; P.a2 = args.in[I_RA2] + (size_t)l * 64 * 512; P.g2 = args.in[I_RG2] + (size_t)l * 128 * 512;
        P.k_k = args.in[I_RKK] + l * 512; P.k_a = args.in[I_RKA] + l * 512; P.r_k = args.in[I_RRK] + l * 512; P.conv_w = args.in[I_MCW] + l * 4096; P.conv_b = args.in[I_MCB] + l * 1024;
        P.mib = args.in[I_MIB] + l * 8; P.mfb = args.in[I_MFB] + l * 8;
        P.FV = FV; P.FO = FO; P.TV = TV; P.TG = TG; P.MV = MV; P.MO = MO; P.FQ = FQ; P.FK = FK; P.RQ = RQ; P.RK = RK; P.MQ = MQ; P.MK = MK; P.RG = RG; P.RW = RW; P.RBON = RBON; P.FP = FP; P.FT = FT; P.MBC = MBC; P.MA = MA; P.MAX = (float*)(ws + WS_SM + SM_MAX); P.MBL = (float*)(ws + WS_SM + SM_MBL);
        prep_phase(F, P, sel ? sel : 7); }
    if constexpr (KIND == K_MIX && ((PHMASK >> K_MIX) & 1)) {
#ifndef MIXSEL
#define MIXSEL 31
#endif
        const int rm = sel ? sel : 31;
        if (bx < 8) { if (rm & 1) rwkv_r2(F, RC, bx); }
        else if (bx < 24) { if (rm & 6) chunk_x2(F, CG, (bx - 8) >> 3, (bx - 8) & 7); }
        if ((rm & 16) && !GATES_IN_ZG) {
            const int gfirst = kGAssign.first[bx], gcount = kGAssign.first[bx + 1] - gfirst;
            pg8::Gemm g{XN, (const bf16*)(wl + WL_WG), SEQ, 4 * DM, DM}; pg8::RangeOrder S; S.init(SEQ, 4 * DM, gfirst, gcount);
            pg8::EpiGates E{GATES, 4 * DM, args.in[I_WGB] + (size_t)l * 4 * DM, SSB + (size_t)(3 * l + 1) * 8 * SEQ}; pg8::gemm_phase<pg8::EpiGates, pg8::RangeOrder, true, true>(F.lds + RING_OFF, g, S, E);
        }
        if (bx >= 24) {
            const int a = bx - 24; char* shm = (char*)(LAS char*)(F.lds + RING_OFF);
            const int nun = (a >= 208) ? 2 : 1;
            if (rm & 8) for (int ui = 0; ui < nun; ++ui) { const int r = ui ? 463 - a : a;
                attn_body::attn_unit<8>(0, r & 7, 31 - (r >> 3), (const attn_body::bf16*)FQ, (const attn_body::bf16*)FK, (const attn_body::bf16*)(Z + ZC_FV), (attn_body::bf16*)YF, FP, FT, (const attn_body::bf16*)(Z + ZC_FO), shm); }
        }
 }
    if constexpr (KIND == K_POST && ((PHMASK >> K_POST) & 1)) { rwkv_r3(F, RC, RBON, RG, args.in[I_RGNW] + l * 512, args.in[I_RGNB] + l * 512, YB); chunk_x3(F, CG); }
    if constexpr (KIND == K_R1) { rwkv_r1(F, RC); chunk_x1(F, CG); }
    if constexpr (KIND == K_MERGE && ((PHMASK >> K_MERGE) & 1)) {
        pg8::StaticOrder S0; S0.init(SEQ, DM, F.G, bx); pg8::Unit u0; S0.next(0, u0);
        pg8::MergeOrder S{u0.pm, u0.pn}; pg8::Gemm g{YF, (const bf16*)(wl + WL_WB), 4 * SEQ, 4 * DM, MW};
        pg8::EpiMergeAll E{GATES, 4 * DM, MRGF, MRGB, DM}; pg8::gemm_phase<pg8::EpiMergeAll, pg8::MergeOrder, true, true>(F.lds + RING_OFF, g, S, E); }
    if constexpr (KIND == K_OUTP && ((PHMASK >> K_OUTP) & 1)) { pg8::Gemm g{MRGB, (const bf16*)(wl + WL_WO), SEQ, DM, DM}; pg8::StaticOrder S; S.init(SEQ, DM, F.G, bx);
        pg8::EpiResid E{nullptr, 3 * l + 2, 1.0f, 0}; pg8::gemm_phase<pg8::EpiResid, pg8::StaticOrder, true, true>(F.lds + RING_OFF, g, S, E); }
}
__device__ __forceinline__ void lds_ctl_zero(unsigned char* lds) {
    for (int u = threadIdx.x; u < (LDS_BYTES - LDSCTL_OFF) / 4; u += NWAVES * 64) ((LAS unsigned*)((LAS unsigned char*)lds + LDSCTL_OFF))[u] = 0u;
    __syncthreads();
}
template <int KIND> __global__ void __launch_bounds__(NWAVES * 64, 2) k_phase(Args args) {
    extern __shared__ __attribute__((aligned(16))) unsigned char lds[];
    lds_ctl_zero(lds);
    run_phase<KIND>(lds, args.ph_lo, args.ph_hi);
}
#if !MK_PER_PHASE
__device__ __forceinline__ void grid_bar(unsigned char* lds) {
    ArgP pa = (ArgP)__builtin_amdgcn_kernarg_segment_ptr(); asm volatile("; opaque kernarg (barrier)" : "+s"(pa));
    XcdBarrier b; b.bar = (unsigned*)((gu32*)(pa->ws + WS_CTL) + CW_BAR); b.x = xb_xcc_id(); b.st = (volatile LAS unsigned*)((LAS unsigned char*)lds + MISC_OFF) + 8;
    xcd_barrier(b);
}
#if DBG_STAMP
#define STAMP_PH(kind) do { if (blockIdx.x == STAMP_BLK && threadIdx.x == 0) { gu32* c_ = (gu32*)(args.ws + WS_CTL); const unsigned now_ = (unsigned)__builtin_amdgcn_s_memrealtime(); c_[3000 + (kind)] += now_ - c_[3040]; c_[3040] = now_; } } while (0)
#define STAMP_BAR(kind) do { if (blockIdx.x == STAMP_BLK && threadIdx.x == 0) { gu32* c_ = (gu32*)(args.ws + WS_CTL); const unsigned now_ = (unsigned)__builtin_amdgcn_s_memrealtime(); c_[3016 + (kind)] += now_ - c_[3040]; c_[3040] = now_; } } while (0)
#else
#define STAMP_PH(kind) do { } while (0)
#define STAMP_BAR(kind) do { } while (0)
#endif
#define PHASE(K, l, s) do { run_phase<K>(lds, l, s); STAMP_PH(K); grid_bar(lds); STAMP_BAR(K); } while (0)
__global__ void __launch_bounds__(NWAVES * 64, 2) mega_fwd(Args args) {
    extern __shared__ __attribute__((aligned(16))) unsigned char lds[];
    lds_ctl_zero(lds);
    (void)xcd_barrier_post((unsigned*)((gu32*)(args.ws + WS_CTL) + CW_BAR), (volatile LAS unsigned*)((LAS unsigned char*)lds + MISC_OFF) + 8);
#if DBG_STAMP
    if (blockIdx.x == STAMP_BLK && threadIdx.x == 0) ((gu32*)(args.ws + WS_CTL))[3040] = (unsigned)__builtin_amdgcn_s_memrealtime();
#endif
    PHASE(K_PRO, 0, 0);
#if PROBE_DUP == 10
    PHASE(K_PRO, 0, 0);
#endif
    for (int l = 0; l < DEPTH; ++l) {
        for (int f = 0; f < 2; ++f) {
            PHASE(K_UP, l, f);
#if PROBE_DUP == 2
            PHASE(K_UP, l, f);
#endif
            PHASE(K_DOWN, l, f);
            if (f == 0) {
                PHASE(K_ZG, l, 0);
#if PROBE_DUP == 4
                PHASE(K_ZG, l, 0);
#endif
                PHASE(K_PREP, l, 0);
#if PROBE_DUP == 5
                PHASE(K_PREP, l, PROBE_ROLE);
#endif
                PHASE(K_R1, l, 0);
#if PROBE_DUP == 11
                PHASE(K_R1, l, 0);
#endif
                PHASE(K_MIX, l, 0);
#if PROBE_DUP == 6
                PHASE(K_MIX, l, PROBE_ROLE);
#endif
                PHASE(K_POST, l, 0);
#if PROBE_DUP == 7
                PHASE(K_POST, l, 0);
#endif
                PHASE(K_MERGE, l, 0);
#if PROBE_DUP == 8
                PHASE(K_MERGE, l, 0);
#endif
                PHASE(K_OUTP, l, 0);
            }
        }
    }
#if DBG_STAMP
    if (blockIdx.x == STAMP_BLK && threadIdx.x == 0) { const gu32* c_ = (const gu32*)(args.ws + WS_CTL); unsigned v_ = 0;
        if (STAMP_SEL < 32) v_ = c_[3000 + STAMP_SEL]; else if (STAMP_SEL == 32) { for (int q = 0; q < 16; ++q) v_ += c_[3000 + q]; } else { for (int q = 16; q < 32; ++q) v_ += c_[3000 + q]; }
        __builtin_amdgcn_s_sleep(10); __threadfence(); args.out[0] = (float)v_; }
#endif
}
#endif

template <int KIND> static void launch_kind(int grid, hipStream_t stream, Args& a) { hipLaunchKernelGGL(k_phase<KIND>, dim3(grid), dim3(NWAVES * 64), LDS_BYTES, stream, a); }
template <int KIND> static bool set_attr() { return hipFuncSetAttribute((const void*)k_phase<KIND>, hipFuncAttributeMaxDynamicSharedMemorySize, LDS_BYTES) == hipSuccess; }
extern "C" void kernel_launch(void* const* d_in, const int* in_sizes, int n_in, void* d_out, int out_size, void* d_ws, size_t ws_size, hipStream_t stream) {
    static int grid = 0;
    if (grid == 0) {
        if (n_in != N_IN || out_size != SEQ * DM || ws_size < WS_END) { fprintf(stderr, "kernel_launch: unexpected shapes: n_in %d out %d ws %zu (need %zu)\n", n_in, out_size, ws_size, (size_t)WS_END); grid = -1; return; }
        int dev = 0, cus = 0;
        if (hipGetDevice(&dev) != hipSuccess || hipDeviceGetAttribute(&cus, hipDeviceAttributeMultiprocessorCount, dev) != hipSuccess) { grid = -1; return; }
#if MK_PER_PHASE
        const bool ok = set_attr<K_PRO>() && set_attr<K_NORM>() && set_attr<K_UP>() && set_attr<K_DOWN>() && set_attr<K_ZG>() && set_attr<K_PREP>() && set_attr<K_MIX>() && set_attr<K_POST>() && set_attr<K_MERGE>() && set_attr<K_OUTP>();
#else
        const bool ok = hipFuncSetAttribute((const void*)mega_fwd, hipFuncAttributeMaxDynamicSharedMemorySize, LDS_BYTES) == hipSuccess;
#endif
        if (!ok) { fprintf(stderr, "kernel_launch: hipFuncSetAttribute failed\n"); grid = -1; return; }
        (void)hipGetLastError();
        if (cus != 256) { fprintf(stderr, "kernel_launch: built for 256 CUs, device has %d\n", cus); grid = -1; return; }
        grid = cus;
    }
    if (grid < 0) return;
    if (hipMemsetAsync((char*)d_ws + WS_CTL, 0, CTL_ZERO_BYTES, stream) != hipSuccess) return;
    Args a{};
    for (int i = 0; i < N_IN; ++i) a.in[i] = (const float*)d_in[i];
    a.out = (float*)d_out; a.ws = (unsigned char*)d_ws;
#if MK_PER_PHASE
#if DBG
    const int dbg_last = DBG_LAST_PHASE;
#else
    const int dbg_last = N_PHASES - 1;
#endif
    for (int p = 0; p <= dbg_last; ++p) { int kind, l, sel; phase_decode(p, kind, l, sel); a.ph_lo = l; a.ph_hi = sel;
#if DBG
        if (kind == K_OUTP) hipMemcpyAsync((char*)d_ws + WS_END, d_out, (size_t)SEQ * DM * 4, hipMemcpyDeviceToDevice, stream);
#endif
        switch (kind) { case K_PRO: launch_kind<K_PRO>(grid, stream, a); break; case K_NORM: launch_kind<K_NORM>(grid, stream, a); break; case K_UP: launch_kind<K_UP>(grid, stream, a); break;
            case K_DOWN: launch_kind<K_DOWN>(grid, stream, a); break; case K_ZG: launch_kind<K_ZG>(grid, stream, a); break; case K_PREP: launch_kind<K_PREP>(grid, stream, a); break;
            case K_MIX: launch_kind<K_MIX>(grid, stream, a); break; case K_POST: launch_kind<K_POST>(grid, stream, a); break; case K_MERGE: launch_kind<K_MERGE>(grid, stream, a); break;
            default: launch_kind<K_OUTP>(grid, stream, a); break; }
#if DBG
        { int chk = 0; const int q = (p == 0) ? -1 : (p - 1) % PH_PER_LAYER;
          if (p == 0) chk = 1; else if (q == 0) chk = 2; else if (q == 1) chk = 3; else if (q == 2) chk = 4; else if (q == 3) chk = 5; else if (q == 4) chk = 6; else if (q == 6) chk = 7; else if (q == 8) chk = 8; else if (q == 9) chk = 9;
          if (chk && l == DBG_LAYER) hipLaunchKernelGGL(k_check, dim3(64), dim3(256), 0, stream, a, chk, l); }
#endif
    }
#if DBG
    hipLaunchKernelGGL(k_report, dim3((SEQ * DM + 255) / 256), dim3(256), 0, stream, a);
#endif
#else
    a.ph_lo = 0; a.ph_hi = N_PHASES;
    hipLaunchKernelGGL(mega_fwd, dim3(grid), dim3(NWAVES * 64), LDS_BYTES, stream, a);
#endif
    const hipError_t le = hipPeekAtLastError();
    if (le != hipSuccess) fprintf(stderr, "kernel_launch: launch failed: %s\n", hipGetErrorName(le));
}
```
